# Optimizing an MI355X kernel written in HIP

```python
import jax
import jax.numpy as jnp
from jax import lax
import numpy as np

D_MODEL = 1024
BATCH = 16
SEQ = 2048
DEPTH = 2

N_AB = (DEPTH + 1) // 2
N_CD = DEPTH // 2
D_FF = 4 * D_MODEL
EPS = 1e-5
SHORT_CONV = 3

RW_HEADS = 8
RW_HEAD = 64
RW_DIM = RW_HEADS * RW_HEAD
RW_DECAY_RANK = 64
RW_AAA_RANK = 64
RW_GATE_RANK = 128
RW_COLS = 3 * RW_DIM + RW_DECAY_RANK + RW_AAA_RANK + RW_GATE_RANK
RW_GN_EPS = 64e-5

MB_HEADDIM = 64
MB_HEADS = 16
MB_DIM = MB_HEADS * MB_HEADDIM
MB_GROUPS = 2
MB_HPG = MB_HEADS // MB_GROUPS
MB_STATE = 128
MB_CHUNK = 128
MB_XBC = MB_DIM + 2 * MB_GROUPS * MB_STATE
MB_COLS = MB_DIM + MB_XBC + 2 * MB_HEADS

AB_IN = RW_COLS + MB_COLS
AB_OUT = RW_DIM + MB_DIM

S5_GROUP = 16
S5_GROUPS = 32
S5_DIM = S5_GROUP * S5_GROUPS
S5_STATE = 64

ML_HEADS = 8
ML_HEAD = 128
ML_DIM = ML_HEADS * ML_HEAD
ML_BLOCK = 4
ML_CHUNK = 64
ML_COLS = 2 * ML_DIM + 4 * ML_HEADS

CD_IN = S5_DIM + ML_COLS
CD_OUT = S5_DIM + ML_DIM

kernel_name = "hybrid_bidir_rwkv7_mamba2_s5_mlstm"


def _split(t, sizes):
    return jnp.split(t, np.cumsum(sizes)[:-1].tolist(), axis=-1)


def rmsnorm(x, w):
    xf = x.astype(jnp.float32)
    y = xf * lax.rsqrt(jnp.mean(xf * xf, axis=-1, keepdims=True) + EPS)
    return (y * w.astype(jnp.float32)).astype(x.dtype)


def head_norm(x, w, eps):
    xf = x.astype(jnp.float32)
    xc = xf - jnp.mean(xf, axis=-1, keepdims=True)
    y = xc * lax.rsqrt(jnp.mean(xc * xc, axis=-1, keepdims=True) + eps)
    return y.reshape(x.shape[:-2] + (-1,)) * w.astype(jnp.float32)


def to_dirs(t):
    return jnp.stack([t, jnp.flip(t, axis=1)])


def flip_dir1(t):
    return jnp.stack([t[0], jnp.flip(t[1], axis=1)])


def merge_dirs(t):
    return t.reshape((-1,) + t.shape[2:])


def centred_shift(y, mu):
    prev = jnp.pad(y[:, :-1], ((0, 0), (1, 0), (0, 0)))
    nxt = jnp.pad(y[:, 1:], ((0, 0), (0, 1), (0, 0)))
    return y + mu[0] * (prev - y) + mu[1] * (nxt - y)


def centred_dwconv(x, w, b):
    K, C = w.shape
    out = lax.conv_general_dilated(
        x, w[:, None, :], window_strides=(1,), padding=[((K - 1) // 2, (K - 1) // 2)],
        dimension_numbers=("NWC", "WIO", "NWC"), feature_group_count=C)
    return out + b


def rwkv7_scan(r, w, k, v, a, b):
    n, H, K = r.shape[1], r.shape[2], r.shape[3]

    def step(state, inp):
        r_t, w_t, k_t, v_t, a_t, b_t = inp
        sa = jnp.einsum("nhvk,nhk->nhv", state, a_t)
        state = (state * w_t[:, :, None, :] + sa[..., None] * b_t[:, :, None, :]
                 + v_t[..., None] * k_t[:, :, None, :])
        return state, jnp.einsum("nhvk,nhk->nhv", state, r_t)

    _, y = lax.scan(step, jnp.zeros((n, H, K, K), r.dtype), (r, w, k, v, a, b))
    return y


def rwkv7_mixer(cols, mu, w0, w2, a0, a2, g2, k_k, k_a, r_k, ln_w):
    bsz, seq, _ = cols.shape
    cols = centred_shift(cols, mu).astype(jnp.float32)
    r, k, v, w_lr, a_lr, g_lr = _split(
        cols, [RW_DIM, RW_DIM, RW_DIM, RW_DECAY_RANK, RW_AAA_RANK, RW_GATE_RANK])
    heads = lambda t: t.reshape(t.shape[:-1] + (RW_HEADS, RW_HEAD))
    w_log = -jax.nn.softplus(-(w0[:, None, None, :]
                               + jnp.einsum("bsr,drc->dbsc", jnp.tanh(w_lr), w2))) - 0.5
    decay = jnp.exp(-jnp.exp(w_log))
    a = jax.nn.sigmoid(a0 + a_lr @ a2)
    g = jax.nn.sigmoid(g_lr) @ g2
    kk = heads(k * k_k)
    kk = kk * lax.rsqrt(jnp.maximum(jnp.sum(kk * kk, axis=-1, keepdims=True), 1e-12))
    k = k * (1.0 + (a - 1.0) * k_a)
    r_h, k_h, v_h, a_h = heads(r), heads(k), heads(v), heads(a)
    tm = lambda t: jnp.swapaxes(merge_dirs(t), 0, 1)
    y = rwkv7_scan(tm(to_dirs(r_h)), tm(flip_dir1(heads(decay))), tm(to_dirs(k_h)),
                   tm(to_dirs(v_h)), tm(to_dirs(-kk)), tm(to_dirs(kk * a_h)))
    y = flip_dir1(jnp.swapaxes(y, 0, 1).reshape(2, bsz, seq, RW_HEADS, RW_HEAD)).sum(0)
    y = head_norm(y, ln_w, RW_GN_EPS)
    bonus = (jnp.sum(r_h * k_h * r_k, axis=-1, keepdims=True) * v_h).reshape(bsz, seq, RW_DIM)
    return (y + bonus) * g


def segsum_exp(a):
    T = a.shape[-1]
    cs = jnp.cumsum(a, axis=-1)
    tri = jnp.tril(jnp.ones((T, T), bool))
    return jnp.exp(jnp.where(tri, cs[..., :, None] - cs[..., None, :], -jnp.inf))


def ssd_chunked(xdt, la, bm, cm, chunk):
    n, S, G, E, P = xdt.shape
    N = bm.shape[-1]
    nc = S // chunk
    xdt = xdt.reshape(n, nc, chunk, G, E, P)
    bm = bm.reshape(n, nc, chunk, G, N)
    cm = cm.reshape(n, nc, chunk, G, N)
    la = jnp.moveaxis(la.reshape(n, nc, chunk, G, E), (3, 4), (1, 2))
    a_cs = jnp.cumsum(la, axis=-1)
    scores = jnp.einsum("nclgd,ncsgd->ngcls", cm, bm)
    m = scores[:, :, None] * segsum_exp(la)
    y_diag = jnp.einsum("ngecls,ncsgep->nclgep", m, xdt)
    decay_states = jnp.exp(a_cs[..., -1:] - a_cs)
    states = jnp.einsum("nclgd,ngecl,nclgep->ncgepd", bm, decay_states, xdt)
    states = jnp.concatenate([jnp.zeros_like(states[:, :1]), states], axis=1)
    chunk_decay = segsum_exp(jnp.pad(a_cs[..., -1], ((0, 0), (0, 0), (0, 0), (1, 0))))
    states = jnp.einsum("ngezc,ncgepd->nzgepd", chunk_decay, states)[:, :-1]
    y_off = jnp.einsum("nclgd,ncgepd,ngecl->nclgep", cm, states, jnp.exp(a_cs))
    return (y_diag + y_off).reshape(n, S, G, E, P)


def mamba2_mixer(cols, conv_w, conv_b, dt_bias, A_log, Dskip, norm_w):
    bsz, seq, _ = cols.shape
    f32 = jnp.float32
    z, xbc, dt = _split(cols, [MB_DIM, MB_XBC, 2 * MB_HEADS])
    xbc = jax.nn.silu(centred_dwconv(xbc, conv_w, conv_b))
    xs, bm, cm = _split(xbc, [MB_DIM, MB_GROUPS * MB_STATE, MB_GROUPS * MB_STATE])
    xs = xs.reshape(bsz, seq, MB_GROUPS, MB_HPG, MB_HEADDIM).astype(f32)
    bm = bm.reshape(bsz, seq, MB_GROUPS, MB_STATE).astype(f32)
    cm = cm.reshape(bsz, seq, MB_GROUPS, MB_STATE).astype(f32)
    dt = jax.nn.softplus(dt.reshape(bsz, seq, 2, MB_HEADS).astype(f32) + dt_bias.astype(f32))
    dt = flip_dir1(jnp.moveaxis(dt, 2, 0)).reshape(2, bsz, seq, MB_GROUPS, MB_HPG)
    A = -jnp.exp(A_log.astype(f32)).reshape(2, 1, 1, MB_GROUPS, MB_HPG)
    xdt = to_dirs(xs) * dt[..., None]
    y = ssd_chunked(merge_dirs(xdt), merge_dirs(dt * A), merge_dirs(to_dirs(bm)),
                    merge_dirs(to_dirs(cm)), MB_CHUNK)
    y = flip_dir1(y.reshape((2, bsz) + y.shape[1:])).sum(0)
    y = y + Dskip.reshape(MB_GROUPS, MB_HPG, 1) * xs
    y = (y.reshape(bsz, seq, MB_DIM) * jax.nn.silu(z.astype(f32)))
    y = y.reshape(bsz, seq, MB_GROUPS, MB_DIM // MB_GROUPS)
    y = y * lax.rsqrt(jnp.mean(y * y, axis=-1, keepdims=True) + EPS)
    return y.reshape(bsz, seq, MB_DIM) * norm_w


def _s5_combine(e1, e2):
    a1r, a1i, b1r, b1i = e1
    a2r, a2i, b2r, b2i = e2
    return (a2r * a1r - a2i * a1i, a2r * a1i + a2i * a1r,
            a2r * b1r - a2i * b1i + b2r, a2r * b1i + a2i * b1r + b2i)


def s5_mixer(u, A_re, A_im, log_dt, B_re, B_im, C_re, C_im, Dskip, glu_w, glu_b):
    bsz, seq, _ = u.shape
    f32 = jnp.float32
    uf = u.astype(f32)
    ug = uf.reshape(bsz, seq, S5_GROUPS, S5_GROUP)
    Bre, Bim = B_re.astype(f32), B_im.astype(f32)
    y = Dskip * uf
    for d in range(2):
        dt = jnp.exp(log_dt[d].astype(f32))[:, None]
        ar = jnp.minimum(A_re[d].astype(f32), -1e-4)
        ai = A_im[d].astype(f32)
        mag = jnp.exp(dt * ar)
        abr, abi = mag * jnp.cos(dt * ai), mag * jnp.sin(dt * ai)
        den = ar * ar + ai * ai
        fr = ((abr - 1.0) * ar + abi * ai) / den
        fi = (abi * ar - (abr - 1.0) * ai) / den
        bbr = fr[..., None] * Bre - fi[..., None] * Bim
        bbi = fr[..., None] * Bim + fi[..., None] * Bre
        ud = ug if d == 0 else jnp.flip(ug, axis=1)
        bur = jnp.einsum("bsgm,gpm->bsgp", ud, bbr)
        bui = jnp.einsum("bsgm,gpm->bsgp", ud, bbi)
        a_shape = (1, seq, S5_GROUPS, S5_STATE)
        _, _, xr, xi = lax.associative_scan(
            _s5_combine, (jnp.broadcast_to(abr, a_shape), jnp.broadcast_to(abi, a_shape), bur, bui),
            axis=1)
        yd = (jnp.einsum("bsgp,gmp->bsgm", xr, C_re[d].astype(f32))
              - jnp.einsum("bsgp,gmp->bsgm", xi, C_im[d].astype(f32)))
        if d == 1:
            yd = jnp.flip(yd, axis=1)
        y = y + yd.reshape(bsz, seq, S5_DIM)
    y = jax.nn.gelu(y)
    return y * jax.nn.sigmoid(y @ glu_w + glu_b)


def mlstm_chunkwise(q, k, v, log_i, log_f, chunk):
    n, S, H, dh = q.shape
    nc = S // chunk

    def to_chunks(t):
        t = t.reshape((n, nc, chunk, H) + t.shape[3:])
        return jnp.moveaxis(t, (1, 3), (0, 2))

    tri = jnp.tril(jnp.ones((chunk, chunk), bool))

    def step(carry, inp):
        C, nv, m = carry
        qc, kc, vc, li, lf = inp
        b = jnp.cumsum(lf, axis=-1)
        log_d = jnp.where(tri, b[..., :, None] - b[..., None, :] + li[..., None, :], -jnp.inf)
        inter = b + m[..., None]
        m_t = jnp.maximum(jnp.max(log_d, axis=-1), inter)
        s = jnp.einsum("nhtd,nhsd->nhts", qc, kc) * jnp.exp(log_d - m_t[..., None])
        w_in = jnp.exp(inter - m_t)
        num = (jnp.einsum("nhts,nhsv->nhtv", s, vc)
               + w_in[..., None] * jnp.einsum("nhtd,nhdv->nhtv", qc, C))
        den = s.sum(-1) + w_in * jnp.einsum("nhtd,nhd->nht", qc, nv)
        h = num / jnp.maximum(jnp.abs(den), jnp.exp(-m_t))[..., None]
        b_last = b[..., -1]
        log_w = b_last[..., None] - b + li
        m_new = jnp.maximum(b_last + m, jnp.max(log_w, axis=-1))
        w = jnp.exp(log_w - m_new[..., None])
        dec = jnp.exp(b_last + m - m_new)
        C = dec[..., None, None] * C + jnp.einsum("nhs,nhsd,nhsv->nhdv", w, kc, vc)
        nv = dec[..., None] * nv + jnp.einsum("nhs,nhsd->nhd", w, kc)
        return (C, nv, m_new), h

    init = (jnp.zeros((n, H, dh, dh), q.dtype), jnp.zeros((n, H, dh), q.dtype),
            jnp.zeros((n, H), q.dtype))
    _, h = lax.scan(step, init, (to_chunks(q), to_chunks(k), to_chunks(v),
                                 to_chunks(log_i), to_chunks(log_f)))
    return jnp.moveaxis(h, (0, 2), (1, 3)).reshape(n, S, H, dh)


def mlstm_mixer(cols, conv_w, conv_b, wq, wk, wv, i_b, f_b, norm_w, skip):
    bsz, seq, _ = cols.shape
    f32 = jnp.float32
    xm, o_pre, i_pre, f_pre = _split(cols, [ML_DIM, ML_DIM, 2 * ML_HEADS, 2 * ML_HEADS])
    xc = jax.nn.silu(centred_dwconv(xm, conv_w, conv_b))

    def headwise(t, w):
        t = t.reshape(bsz, seq, ML_DIM // ML_BLOCK, ML_BLOCK)
        return jnp.einsum("bsjc,jcd->bsjd", t, w).reshape(bsz, seq, ML_HEADS, ML_HEAD).astype(f32)

    q = headwise(xc, wq)
    k = headwise(xc, wk) * (ML_HEAD ** -0.5)
    v = headwise(xm, wv)

    def gate_dirs(pre, bias):
        g = pre.reshape(bsz, seq, 2, ML_HEADS).astype(f32) + bias.astype(f32)
        return merge_dirs(flip_dir1(jnp.moveaxis(g, 2, 0)))

    log_i = gate_dirs(i_pre, i_b)
    log_f = jax.nn.log_sigmoid(gate_dirs(f_pre, f_b))
    h = mlstm_chunkwise(merge_dirs(to_dirs(q)), merge_dirs(to_dirs(k)),
                        merge_dirs(to_dirs(v)), log_i, log_f, ML_CHUNK)
    h = flip_dir1(h.reshape(2, bsz, seq, ML_HEADS, ML_HEAD)).sum(0)
    h = head_norm(h, norm_w, EPS)
    return jax.nn.sigmoid(o_pre.astype(f32)) * h + skip * xc


def sq_relu_mlp(x, w1, w2):
    return jnp.square(jax.nn.relu(x @ w1)) @ w2


def setup_inputs(seed: int = 0) -> dict:
    key = jax.random.key(seed)
    ks = iter(jax.random.split(key, 64))
    f32 = jnp.float32
    nrm = lambda shape, scale: scale * jax.random.normal(next(ks), shape, f32)
    uni = lambda shape, lo, hi: jax.random.uniform(next(ks), shape, f32, lo, hi)
    gain = lambda shape: 1.0 + nrm(shape, 0.02)

    x = nrm((BATCH, SEQ, D_MODEL), 1.0)
    norm_mix = gain((DEPTH, D_MODEL))
    norm_mlp = gain((DEPTH, D_MODEL))
    norm_final = gain((D_MODEL,))
    mlp_w1 = nrm((DEPTH, D_MODEL, D_FF), D_MODEL ** -0.5)
    mlp_w2 = nrm((DEPTH, D_FF, D_MODEL), 0.5 * D_FF ** -0.5)

    ab_w_in = nrm((N_AB, D_MODEL, AB_IN), D_MODEL ** -0.5)
    ab_w_out = nrm((N_AB, AB_OUT, D_MODEL), AB_OUT ** -0.5)
    rw_mu = uni((N_AB, 2, RW_COLS), 0.0, 0.4)
    rw_w0 = uni((N_AB, 2, RW_DIM), -6.0, 1.0)
    rw_w2 = nrm((N_AB, 2, RW_DECAY_RANK, RW_DIM), 0.1)
    rw_a0 = nrm((N_AB, RW_DIM), 0.1)
    rw_a2 = nrm((N_AB, RW_AAA_RANK, RW_DIM), 0.1)
    rw_g2 = nrm((N_AB, RW_GATE_RANK, RW_DIM), RW_GATE_RANK ** -0.5)
    rw_k_k = 0.85 + nrm((N_AB, RW_DIM), 0.02)
    rw_k_a = gain((N_AB, RW_DIM))
    rw_r_k = nrm((N_AB, RW_HEADS, RW_HEAD), 0.1)
    rw_ln_w = gain((N_AB, RW_DIM))
    mb_conv_w = nrm((N_AB, SHORT_CONV, MB_XBC), SHORT_CONV ** -0.5)
    mb_conv_b = nrm((N_AB, MB_XBC), 0.02)
    dt0 = jnp.exp(uni((N_AB, 2, MB_HEADS), float(np.log(1e-3)), float(np.log(1e-1))))
    mb_dt_bias = dt0 + jnp.log(-jnp.expm1(-dt0))
    mb_A_log = jnp.log(uni((N_AB, 2, MB_HEADS), 1.0, 16.0))
    mb_D = gain((N_AB, MB_HEADS))
    mb_norm_w = gain((N_AB, MB_DIM))

    cd_w_in = nrm((N_CD, D_MODEL, CD_IN), D_MODEL ** -0.5)
    cd_w_out = nrm((N_CD, CD_OUT, D_MODEL), CD_OUT ** -0.5)
    s5_A_re = -0.5 + nrm((N_CD, 2, S5_GROUPS, S5_STATE), 0.01)
    s5_A_im = (jnp.pi * jnp.arange(S5_STATE, dtype=f32)
               + nrm((N_CD, 2, S5_GROUPS, S5_STATE), 0.01))
    s5_log_dt = uni((N_CD, 2, S5_GROUPS), float(np.log(1e-3)), float(np.log(1e-1)))
    s5_B_re = nrm((N_CD, S5_GROUPS, S5_STATE, S5_GROUP), (2 * S5_GROUP) ** -0.5)
    s5_B_im = nrm((N_CD, S5_GROUPS, S5_STATE, S5_GROUP), (2 * S5_GROUP) ** -0.5)
    s5_C_re = nrm((N_CD, 2, S5_GROUPS, S5_GROUP, S5_STATE), S5_STATE ** -0.5)
    s5_C_im = nrm((N_CD, 2, S5_GROUPS, S5_GROUP, S5_STATE), S5_STATE ** -0.5)
    s5_D = nrm((N_CD, S5_DIM), 1.0)
    s5_glu_w = nrm((N_CD, S5_DIM, S5_DIM), S5_DIM ** -0.5)
    s5_glu_b = nrm((N_CD, S5_DIM), 0.02)
    ml_conv_w = nrm((N_CD, SHORT_CONV, ML_DIM), SHORT_CONV ** -0.5)
    ml_conv_b = nrm((N_CD, ML_DIM), 0.02)
    ml_wq = nrm((N_CD, ML_DIM // ML_BLOCK, ML_BLOCK, ML_BLOCK), ML_BLOCK ** -0.5)
    ml_wk = nrm((N_CD, ML_DIM // ML_BLOCK, ML_BLOCK, ML_BLOCK), ML_BLOCK ** -0.5)
    ml_wv = nrm((N_CD, ML_DIM // ML_BLOCK, ML_BLOCK, ML_BLOCK), ML_BLOCK ** -0.5)
    ml_i_b = nrm((N_CD, 2, ML_HEADS), 0.1)
    ml_f_b = jnp.linspace(3.0, 6.0, ML_HEADS, dtype=f32) + nrm((N_CD, 2, ML_HEADS), 0.02)
    ml_norm_w = gain((N_CD, ML_DIM))
    ml_skip = gain((N_CD, ML_DIM))

    return {
        "x": x, "norm_mix": norm_mix, "norm_mlp": norm_mlp, "norm_final": norm_final,
        "mlp_w1": mlp_w1, "mlp_w2": mlp_w2,
        "ab_w_in": ab_w_in, "ab_w_out": ab_w_out,
        "rw_mu": rw_mu, "rw_w0": rw_w0, "rw_w2": rw_w2, "rw_a0": rw_a0, "rw_a2": rw_a2,
        "rw_g2": rw_g2, "rw_k_k": rw_k_k, "rw_k_a": rw_k_a, "rw_r_k": rw_r_k,
        "rw_ln_w": rw_ln_w,
        "mb_conv_w": mb_conv_w, "mb_conv_b": mb_conv_b, "mb_dt_bias": mb_dt_bias,
        "mb_A_log": mb_A_log, "mb_D": mb_D, "mb_norm_w": mb_norm_w,
        "cd_w_in": cd_w_in, "cd_w_out": cd_w_out,
        "s5_A_re": s5_A_re, "s5_A_im": s5_A_im, "s5_log_dt": s5_log_dt,
        "s5_B_re": s5_B_re, "s5_B_im": s5_B_im, "s5_C_re": s5_C_re, "s5_C_im": s5_C_im,
        "s5_D": s5_D, "s5_glu_w": s5_glu_w, "s5_glu_b": s5_glu_b,
        "ml_conv_w": ml_conv_w, "ml_conv_b": ml_conv_b, "ml_wq": ml_wq, "ml_wk": ml_wk,
        "ml_wv": ml_wv, "ml_i_b": ml_i_b, "ml_f_b": ml_f_b, "ml_norm_w": ml_norm_w,
        "ml_skip": ml_skip,
    }


def reference(x, norm_mix, norm_mlp, norm_final, mlp_w1, mlp_w2,
              ab_w_in, ab_w_out, rw_mu, rw_w0, rw_w2, rw_a0, rw_a2, rw_g2, rw_k_k, rw_k_a,
              rw_r_k, rw_ln_w, mb_conv_w, mb_conv_b, mb_dt_bias, mb_A_log, mb_D, mb_norm_w,
              cd_w_in, cd_w_out, s5_A_re, s5_A_im, s5_log_dt, s5_B_re, s5_B_im, s5_C_re,
              s5_C_im, s5_D, s5_glu_w, s5_glu_b, ml_conv_w, ml_conv_b, ml_wq, ml_wk, ml_wv,
              ml_i_b, ml_f_b, ml_norm_w, ml_skip):
    h = x
    for layer in range(DEPTH):
        xn = rmsnorm(h, norm_mix[layer])
        i = layer // 2
        if layer % 2 == 0:
            cols = xn @ ab_w_in[i]
            rw_cols, mb_cols = _split(cols, [RW_COLS, MB_COLS])
            y_rw = rwkv7_mixer(rw_cols, rw_mu[i], rw_w0[i], rw_w2[i], rw_a0[i], rw_a2[i],
                               rw_g2[i], rw_k_k[i], rw_k_a[i], rw_r_k[i], rw_ln_w[i])
            y_mb = mamba2_mixer(mb_cols, mb_conv_w[i], mb_conv_b[i], mb_dt_bias[i],
                                mb_A_log[i], mb_D[i], mb_norm_w[i])
            mixed = jnp.concatenate([y_rw, y_mb], axis=-1).astype(xn.dtype) @ ab_w_out[i]
        else:
            cols = xn @ cd_w_in[i]
            s5_cols, ml_cols = _split(cols, [S5_DIM, ML_COLS])
            y_s5 = s5_mixer(s5_cols, s5_A_re[i], s5_A_im[i], s5_log_dt[i], s5_B_re[i],
                            s5_B_im[i], s5_C_re[i], s5_C_im[i], s5_D[i], s5_glu_w[i], s5_glu_b[i])
            y_ml = mlstm_mixer(ml_cols, ml_conv_w[i], ml_conv_b[i], ml_wq[i], ml_wk[i], ml_wv[i],
                               ml_i_b[i], ml_f_b[i], ml_norm_w[i], ml_skip[i])
            mixed = jnp.concatenate([y_s5, y_ml], axis=-1).astype(xn.dtype) @ cd_w_out[i]
        h = h + mixed
        h = h + sq_relu_mlp(rmsnorm(h, norm_mlp[layer]), mlp_w1[layer], mlp_w2[layer])
    return rmsnorm(h, norm_final)
```

```cpp
#include <hip/hip_runtime.h>
#include <hip/hip_cooperative_groups.h>
#include <stdint.h>
#include <cstdio>
namespace cg = cooperative_groups;

typedef unsigned short bf16_t;
typedef short bf16x8 __attribute__((ext_vector_type(8)));
typedef float f32x4 __attribute__((ext_vector_type(4)));
typedef unsigned u32x4 __attribute__((ext_vector_type(4)));
typedef unsigned u32x2 __attribute__((ext_vector_type(2)));

#define DI __device__ __forceinline__
#define MFMA16(a, b, c) __builtin_amdgcn_mfma_f32_16x16x32_bf16((a), (b), (c), 0, 0, 0)

constexpr int NTOK = 32768, SEQ = 2048;
constexpr size_t MiB = 1ull << 20;
constexpr size_t OFF_WABIN = 0;
constexpr size_t OFF_WABOUT = OFF_WABIN + 4480ull * 1024 * 2;
constexpr size_t OFF_W1 = OFF_WABOUT + 1024ull * 1536 * 2;
constexpr size_t OFF_W2 = OFF_W1 + 2ull * 4096 * 1024 * 2;
constexpr size_t OFF_WCDIN = OFF_W2 + 2ull * 4096 * 1024 * 2;
constexpr size_t OFF_WCDOUT = OFF_WCDIN + 2688ull * 1024 * 2;
constexpr size_t OFF_WGLU = OFF_WCDOUT + 1024ull * 1536 * 2;
constexpr size_t OFF_WG2 = OFF_WGLU + 512ull * 512 * 2;
constexpr size_t OFF_WW2 = OFF_WG2 + 512ull * 128 * 2;
constexpr size_t OFF_WA2 = OFF_WW2 + 2ull * 512 * 64 * 2;
constexpr size_t OFF_WEND = OFF_WA2 + 512ull * 64 * 2;
static_assert(OFF_WEND <= 56 * MiB, "weights region");
constexpr size_t OFF_XN = 56 * MiB;
constexpr size_t OFF_R1 = 120 * MiB;
constexpr size_t OFF_R2 = 232 * MiB;
constexpr size_t OFF_RKV = 394 * MiB;
constexpr size_t OFF_SM = 490 * MiB;
constexpr size_t OFF_S5U = 120 * MiB;
constexpr size_t OFF_MLRAW = 152 * MiB;
constexpr size_t OFF_S5Y = 282 * MiB;
constexpr size_t OFF_HFB = 346 * MiB;
constexpr size_t OFF_YG = 474 * MiB;
constexpr int LDS_BYTES = 79872;

struct Params {
  const float *x, *norm_mix, *norm_mlp, *norm_final, *mlp_w1, *mlp_w2, *ab_w_in, *ab_w_out, *rw_mu, *rw_w0, *rw_w2, *rw_a0,
      *rw_a2, *rw_g2, *rw_k_k, *rw_k_a, *rw_r_k, *rw_ln_w, *mb_conv_w, *mb_conv_b, *mb_dt_bias, *mb_A_log, *mb_D, *mb_norm_w,
      *cd_w_in, *cd_w_out, *s5_A_re, *s5_A_im, *s5_log_dt, *s5_B_re, *s5_B_im, *s5_C_re, *s5_C_im, *s5_D, *s5_glu_w, *s5_glu_b,
      *ml_conv_w, *ml_conv_b, *ml_wq, *ml_wk, *ml_wv, *ml_i_b, *ml_f_b, *ml_norm_w, *ml_skip;
  float* out;
  char* ws;
};

DI float bf2f(bf16_t v) { return __uint_as_float(((unsigned)v) << 16); }
DI bf16_t f2bf(float x) { unsigned u = __float_as_uint(x); u += 0x7fffu + ((u >> 16) & 1u); return (bf16_t)(u >> 16); }
DI unsigned pack2(float lo, float hi) { return (unsigned)f2bf(lo) | ((unsigned)f2bf(hi) << 16); }
DI void unpack8(u32x4 w, float* f) {
#pragma unroll
  for (int i = 0; i < 4; ++i) { f[2 * i] = __uint_as_float(w[i] << 16); f[2 * i + 1] = __uint_as_float(w[i] & 0xffff0000u); }
}
DI u32x4 pack8(const float* f) { u32x4 w; w.x = pack2(f[0], f[1]); w.y = pack2(f[2], f[3]); w.z = pack2(f[4], f[5]); w.w = pack2(f[6], f[7]); return w; }
DI u32x4 ld8(const bf16_t* p) { return *(const u32x4*)p; }
DI float wave_sum(float v) {
#pragma unroll
  for (int o = 32; o > 0; o >>= 1) v += __shfl_xor(v, o);
  return v;
}
DI float sigmoidf_(float x) { return 1.0f / (1.0f + __expf(-x)); }
DI float siluf_(float x) { return x / (1.0f + __expf(-x)); }
DI float softplusf_(float x) { return x > 20.f ? x : log1pf(expf(x)); }
DI float wave_incl_sum(float v, int lane) {
#pragma unroll
  for (int o = 1; o < 64; o <<= 1) { float t = __shfl_up(v, o); if (lane >= o) v += t; }
  return v;
}
DI float wave_incl_max(float v, int lane) {
#pragma unroll
  for (int o = 1; o < 64; o <<= 1) { float t = __shfl_up(v, o); if (lane >= o) v = fmaxf(v, t); }
  return v;
}

DI bool get_tdesc(const Params& p, int i, const float*& src, bf16_t*& dst, int& K, int& Nsrc, int& Npad) {
  char* ws = p.ws;
  switch (i) {
    case 0: src = p.ab_w_in; dst = (bf16_t*)(ws + OFF_WABIN); K = 1024; Nsrc = 4384; Npad = 4480; return true;
    case 1: src = p.ab_w_out; dst = (bf16_t*)(ws + OFF_WABOUT); K = 1536; Nsrc = 1024; Npad = 1024; return true;
    case 2: src = p.mlp_w1; dst = (bf16_t*)(ws + OFF_W1); K = 1024; Nsrc = 4096; Npad = 4096; return true;
    case 3: src = p.mlp_w1 + 1024ull * 4096; dst = (bf16_t*)(ws + OFF_W1) + 4096ull * 1024; K = 1024; Nsrc = 4096; Npad = 4096; return true;
    case 4: src = p.mlp_w2; dst = (bf16_t*)(ws + OFF_W2); K = 4096; Nsrc = 1024; Npad = 1024; return true;
    case 5: src = p.mlp_w2 + 4096ull * 1024; dst = (bf16_t*)(ws + OFF_W2) + 4096ull * 1024; K = 4096; Nsrc = 1024; Npad = 1024; return true;
    case 6: src = p.cd_w_in; dst = (bf16_t*)(ws + OFF_WCDIN); K = 1024; Nsrc = 2592; Npad = 2688; return true;
    case 7: src = p.cd_w_out; dst = (bf16_t*)(ws + OFF_WCDOUT); K = 1536; Nsrc = 1024; Npad = 1024; return true;
    case 8: src = p.s5_glu_w; dst = (bf16_t*)(ws + OFF_WGLU); K = 512; Nsrc = 512; Npad = 512; return true;
    case 9: src = p.rw_g2; dst = (bf16_t*)(ws + OFF_WG2); K = 128; Nsrc = 512; Npad = 512; return true;
    case 10: src = p.rw_w2; dst = (bf16_t*)(ws + OFF_WW2); K = 64; Nsrc = 512; Npad = 512; return true;
    case 11: src = p.rw_w2 + 64 * 512; dst = (bf16_t*)(ws + OFF_WW2) + 512 * 64; K = 64; Nsrc = 512; Npad = 512; return true;
    case 12: src = p.rw_a2; dst = (bf16_t*)(ws + OFF_WA2); K = 64; Nsrc = 512; Npad = 512; return true;
    default: return false;
  }
}

DI void rmsnorm_row_to_bf16(const float* __restrict__ xr, const float* __restrict__ w, bf16_t* __restrict__ o, int lane) {
  f32x4 v[4]; float ss = 0.f;
#pragma unroll
  for (int i = 0; i < 4; ++i) { v[i] = *(const f32x4*)(xr + i * 256 + lane * 4); ss += v[i][0] * v[i][0] + v[i][1] * v[i][1] + v[i][2] * v[i][2] + v[i][3] * v[i][3]; }
  ss = wave_sum(ss);
  const float rs = rsqrtf(ss * (1.0f / 1024.0f) + 1e-5f);
#pragma unroll
  for (int i = 0; i < 4; ++i) { const f32x4 g = *(const f32x4*)(w + i * 256 + lane * 4); u32x2 q; q.x = pack2(v[i][0] * rs * g[0], v[i][1] * rs * g[1]); q.y = pack2(v[i][2] * rs * g[2], v[i][3] * rs * g[3]); *(u32x2*)(o + i * 256 + lane * 4) = q; }
}

DI void phase_rmsnorm(const Params& p, const float* src, const float* w) {
  bf16_t* xn = (bf16_t*)(p.ws + OFF_XN);
  const int lane = threadIdx.x & 63, wid = threadIdx.x >> 6;
  for (int u = blockIdx.x; u < NTOK / 4; u += gridDim.x) { const int row = u * 4 + wid; rmsnorm_row_to_bf16(src + (size_t)row * 1024, w, xn + (size_t)row * 1024, lane); }
}

DI void phase_prep(const Params& p, char* smem) {
  float* tile = (float*)smem;
  const int tid = threadIdx.x;
  int ntr = 0;
  for (int i = 0; i < 13; ++i) { const float* s; bf16_t* d; int K, Ns, Np; get_tdesc(p, i, s, d, K, Ns, Np); ntr += (K / 64) * (Np / 64); }
  for (int u = blockIdx.x; u < ntr; u += gridDim.x) {
    const float* src = nullptr; bf16_t* dst = nullptr; int K = 64, Ns = 0, Np = 64, r = u;
    for (int mi = 0; mi < 13; ++mi) { get_tdesc(p, mi, src, dst, K, Ns, Np); const int nt = (K / 64) * (Np / 64); if (r < nt) break; r -= nt; }
    const int nkb = K / 64, kb = r % nkb, nb = r / nkb;
    __syncthreads();
#pragma unroll
    for (int i = 0; i < 16; ++i) { const int k = i * 4 + (tid >> 6), n = tid & 63; const int gn = nb * 64 + n; tile[k * 65 + n] = gn < Ns ? src[(size_t)(kb * 64 + k) * Ns + gn] : 0.f; }
    __syncthreads();
    const int n = tid >> 2, ks = (tid & 3) * 16; float f[16];
#pragma unroll
    for (int j = 0; j < 16; ++j) f[j] = tile[(ks + j) * 65 + n];
    bf16_t* o = dst + (size_t)(nb * 64 + n) * K + kb * 64 + ks;
    *(u32x4*)o = pack8(f); *(u32x4*)(o + 8) = pack8(f + 8);
  }
  phase_rmsnorm(p, p.x, p.norm_mix);
}

template <class Epi>
DI void gemm_tile(char* smem, const bf16_t* __restrict__ A0, int lda0, int ksplit, const bf16_t* __restrict__ A1, int lda1,
                  const bf16_t* __restrict__ Bt, int K, int row0, int col0, const Epi& epi) {
  constexpr int BK = 64, PITCH = 72;
  bf16_t* sA = (bf16_t*)smem; bf16_t* sB = sA + 128 * PITCH;
  const int tid = threadIdx.x, lane = tid & 63, wid = tid >> 6, wr = wid >> 1, wc = wid & 1, fr = lane & 15, fq = lane >> 4;
  f32x4 acc[4][4];
#pragma unroll
  for (int m = 0; m < 4; ++m)
#pragma unroll
    for (int n = 0; n < 4; ++n) acc[m][n] = (f32x4){0.f, 0.f, 0.f, 0.f};
  u32x4 ra[4], rb[4];
  const int nk = K / BK;
#define GLOAD(kt) do { const int k0_ = (kt) * BK; const bf16_t* Ab_; int lda_, kk_; \
    if (k0_ < ksplit) { Ab_ = A0; lda_ = lda0; kk_ = k0_; } else { Ab_ = A1; lda_ = lda1; kk_ = k0_ - ksplit; } \
    _Pragma("unroll") for (int i_ = 0; i_ < 4; ++i_) { const int v_ = tid + i_ * 256, r_ = v_ >> 3, cv_ = v_ & 7; \
      ra[i_] = *(const u32x4*)(Ab_ + (size_t)(row0 + r_) * lda_ + kk_ + cv_ * 8); \
      rb[i_] = *(const u32x4*)(Bt + (size_t)(col0 + r_) * K + k0_ + cv_ * 8); } } while (0)
  GLOAD(0);
  for (int kt = 0; kt < nk; ++kt) {
    __syncthreads();
#pragma unroll
    for (int i = 0; i < 4; ++i) { const int v = tid + i * 256, r = v >> 3, cv = v & 7; *(u32x4*)(sA + r * PITCH + cv * 8) = ra[i]; *(u32x4*)(sB + r * PITCH + cv * 8) = rb[i]; }
    __syncthreads();
    if (kt + 1 < nk) GLOAD(kt + 1);
#pragma unroll
    for (int ks = 0; ks < 2; ++ks) {
      bf16x8 af[4], bfr[4];
#pragma unroll
      for (int m = 0; m < 4; ++m) af[m] = *(const bf16x8*)(sA + (wr * 64 + m * 16 + fr) * PITCH + ks * 32 + fq * 8);
#pragma unroll
      for (int n = 0; n < 4; ++n) bfr[n] = *(const bf16x8*)(sB + (wc * 64 + n * 16 + fr) * PITCH + ks * 32 + fq * 8);
#pragma unroll
      for (int m = 0; m < 4; ++m)
#pragma unroll
        for (int n = 0; n < 4; ++n) acc[m][n] = MFMA16(bfr[n], af[m], acc[m][n]);
    }
  }
#undef GLOAD
#pragma unroll
  for (int m = 0; m < 4; ++m)
#pragma unroll
    for (int n = 0; n < 4; ++n) epi(row0 + wr * 64 + m * 16 + fr, col0 + wc * 64 + n * 16 + fq * 4, acc[m][n]);
}

DI void st_bf16x4(bf16_t* o, f32x4 v) { u32x2 q; q.x = pack2(v[0], v[1]); q.y = pack2(v[2], v[3]); *(u32x2*)o = q; }

struct EpiSplit {
  bf16_t* o0; int ld0, n0; bf16_t* o1; int ld1, n1;
  DI void operator()(int row, int col, f32x4 v) const {
    if (col < n0) st_bf16x4(o0 + (size_t)row * ld0 + col, v);
    else { const int c = col - n0; if (c < n1) st_bf16x4(o1 + (size_t)row * ld1 + c, v); }
  }
};
struct EpiDecay { const float* w0; bf16_t* o;
  DI void operator()(int row, int col, f32x4 v) const { f32x4 r; for (int j = 0; j < 4; ++j) r[j] = 0.60653066f * sigmoidf_(w0[col + j] + v[j]); st_bf16x4(o + (size_t)row * 512 + col, r); } };
struct EpiSig { const float* b0; bf16_t* o;
  DI void operator()(int row, int col, f32x4 v) const { f32x4 r; for (int j = 0; j < 4; ++j) r[j] = sigmoidf_(b0[col + j] + v[j]); st_bf16x4(o + (size_t)row * 512 + col, r); } };
struct EpiStore { bf16_t* o; int ld;
  DI void operator()(int row, int col, f32x4 v) const { st_bf16x4(o + (size_t)row * ld + col, v); } };
struct EpiResid { const float* res; float* o;
  DI void operator()(int row, int col, f32x4 v) const { const f32x4 r = *(const f32x4*)(res + (size_t)row * 1024 + col); *(f32x4*)(o + (size_t)row * 1024 + col) = r + v; } };
struct EpiRelu2 { bf16_t* o;
  DI void operator()(int row, int col, f32x4 v) const { f32x4 r; for (int j = 0; j < 4; ++j) { const float t = fmaxf(v[j], 0.f); r[j] = t * t; } st_bf16x4(o + (size_t)row * 4096 + col, r); } };
struct EpiGlu { const bf16_t* y; const float* b; bf16_t* o;
  DI void operator()(int row, int col, f32x4 v) const { const u32x2 q = *(const u32x2*)(y + (size_t)row * 512 + col); f32x4 r;
    const float y0 = __uint_as_float(q.x << 16), y1 = __uint_as_float(q.x & 0xffff0000u), y2 = __uint_as_float(q.y << 16), y3 = __uint_as_float(q.y & 0xffff0000u);
    r[0] = y0 * sigmoidf_(v[0] + b[col]); r[1] = y1 * sigmoidf_(v[1] + b[col + 1]); r[2] = y2 * sigmoidf_(v[2] + b[col + 2]); r[3] = y3 * sigmoidf_(v[3] + b[col + 3]);
    st_bf16x4(o + (size_t)row * 512 + col, r); } };

template <class Epi>
DI void gemm_phase(char* smem, const bf16_t* A0, int lda0, int ksplit, const bf16_t* A1, int lda1, const bf16_t* Bt, int K, int nN, const Epi& epi) {
  const int ntiles = (NTOK / 128) * nN;
  for (int u = blockIdx.x; u < ntiles; u += gridDim.x) { const int rt = u / nN, ct = u % nN; gemm_tile(smem, A0, lda0, ksplit, A1, lda1, Bt, K, rt * 128, ct * 128, epi); }
}

DI void phase_rw_shift(const Params& p) {
  const bf16_t* raw = (const bf16_t*)(p.ws + OFF_R1);
  bf16_t* rkv = (bf16_t*)(p.ws + OFF_RKV); bf16_t* sm = (bf16_t*)(p.ws + OFF_SM);
  const float* mu = p.rw_mu;
  const size_t total = (size_t)NTOK * 224;
  for (size_t i = (size_t)blockIdx.x * 256 + threadIdx.x; i < total; i += (size_t)gridDim.x * 256) {
    const int tok = (int)(i / 224), cv = (int)(i % 224), c = cv * 8, s = tok & (SEQ - 1);
    const bf16_t* rp = raw + (size_t)tok * 1792 + c;
    float cur[8], prv[8], nxt[8], o[8];
    unpack8(ld8(rp), cur);
    if (s > 0) unpack8(ld8(rp - 1792), prv); else for (int j = 0; j < 8; ++j) prv[j] = 0.f;
    if (s < SEQ - 1) unpack8(ld8(rp + 1792), nxt); else for (int j = 0; j < 8; ++j) nxt[j] = 0.f;
#pragma unroll
    for (int j = 0; j < 8; ++j) o[j] = cur[j] + mu[c + j] * (prv[j] - cur[j]) + mu[1792 + c + j] * (nxt[j] - cur[j]);
    if (c < 1536) *(u32x4*)(rkv + (size_t)tok * 1536 + c) = pack8(o);
    else if (c < 1600) { for (int j = 0; j < 8; ++j) o[j] = tanhf(o[j]); *(u32x4*)(sm + (size_t)tok * 256 + (c - 1536)) = pack8(o); }
    else if (c < 1664) *(u32x4*)(sm + (size_t)tok * 256 + 64 + (c - 1600)) = pack8(o);
    else { for (int j = 0; j < 8; ++j) o[j] = sigmoidf_(o[j]); *(u32x4*)(sm + (size_t)tok * 256 + 128 + (c - 1664)) = pack8(o); }
  }
}

DI void phase_rw_small_gemms(const Params& p, char* smem) {
  const bf16_t* sm = (const bf16_t*)(p.ws + OFF_SM);
  bf16_t* E0 = (bf16_t*)(p.ws + OFF_R1); bf16_t* E1 = E0 + (size_t)NTOK * 512; bf16_t* Ab = E1 + (size_t)NTOK * 512;
  bf16_t* G = (bf16_t*)(p.ws + OFF_XN);
  const bf16_t* W2 = (const bf16_t*)(p.ws + OFF_WW2); const bf16_t* A2 = (const bf16_t*)(p.ws + OFF_WA2); const bf16_t* G2 = (const bf16_t*)(p.ws + OFF_WG2);
  for (int u = blockIdx.x; u < 4096; u += gridDim.x) {
    const int prob = u >> 10, rem = u & 1023, rt = rem >> 2, ct = rem & 3;
    if (prob == 0) gemm_tile(smem, sm, 256, 1 << 30, sm, 256, W2, 64, rt * 128, ct * 128, EpiDecay{p.rw_w0, E0});
    else if (prob == 1) gemm_tile(smem, sm, 256, 1 << 30, sm, 256, W2 + 512 * 64, 64, rt * 128, ct * 128, EpiDecay{p.rw_w0 + 512, E1});
    else if (prob == 2) gemm_tile(smem, sm + 64, 256, 1 << 30, sm, 256, A2, 64, rt * 128, ct * 128, EpiSig{p.rw_a0, Ab});
    else gemm_tile(smem, sm + 128, 256, 1 << 30, sm, 256, G2, 128, rt * 128, ct * 128, EpiStore{G, 512});
  }
}

DI void rwkv_item(const Params& p, int item, char* smem) {
  constexpr int T = 16;
  const int dir = item >> 7, b = (item >> 3) & 15, h = item & 7;
  const int tid = threadIdx.x, lane = tid & 63, wave = tid >> 6, row = tid >> 2, q = tid & 3;
  float* op = (float*)smem;
  float* yo = op + T * 6 * 64;
  const bf16_t* RKV = (const bf16_t*)(p.ws + OFF_RKV);
  bf16_t* E0 = (bf16_t*)(p.ws + OFF_R1); bf16_t* Ed = E0 + (size_t)dir * NTOK * 512; const bf16_t* Ab = E0 + (size_t)2 * NTOK * 512;
  const float kkw = p.rw_k_k[h * 64 + lane], kaw = p.rw_k_a[h * 64 + lane];
  float S[16];
#pragma unroll
  for (int j = 0; j < 16; ++j) S[j] = 0.f;
  for (int c0 = 0; c0 < SEQ; c0 += T) {
    __syncthreads();
#pragma unroll
    for (int i = 0; i < 4; ++i) {
      const int s = wave * 4 + i, st = c0 + s, t = dir ? (SEQ - 1 - st) : st; const size_t tok = (size_t)b * SEQ + t;
      const float r = bf2f(RKV[tok * 1536 + h * 64 + lane]), k = bf2f(RKV[tok * 1536 + 512 + h * 64 + lane]), v = bf2f(RKV[tok * 1536 + 1024 + h * 64 + lane]);
      const float a = bf2f(Ab[tok * 512 + h * 64 + lane]), e = bf2f(Ed[tok * 512 + h * 64 + lane]);
      float kk = k * kkw; const float ss = wave_sum(kk * kk); kk *= rsqrtf(fmaxf(ss, 1e-12f));
      float* o = op + s * 384;
      o[lane] = __expf(-e); o[64 + lane] = k * (1.0f + (a - 1.0f) * kaw); o[128 + lane] = -kk; o[192 + lane] = kk * a; o[256 + lane] = r; o[320 + lane] = v;
    }
    __syncthreads();
    for (int s = 0; s < T; ++s) {
      const float* o = op + s * 384 + q * 16;
      float sa = 0.f;
#pragma unroll
      for (int j4 = 0; j4 < 4; ++j4) { const f32x4 av = *(const f32x4*)(o + 128 + j4 * 4);
#pragma unroll
        for (int j = 0; j < 4; ++j) sa += S[j4 * 4 + j] * av[j]; }
      sa += __shfl_xor(sa, 1); sa += __shfl_xor(sa, 2);
      const float vv = op[s * 384 + 320 + row];
      float y = 0.f;
#pragma unroll
      for (int j4 = 0; j4 < 4; ++j4) { const f32x4 wv = *(const f32x4*)(o + j4 * 4), kv = *(const f32x4*)(o + 64 + j4 * 4), bv = *(const f32x4*)(o + 192 + j4 * 4), rv = *(const f32x4*)(o + 256 + j4 * 4);
#pragma unroll
        for (int j = 0; j < 4; ++j) { const float ns = S[j4 * 4 + j] * wv[j] + sa * bv[j] + vv * kv[j]; S[j4 * 4 + j] = ns; y += ns * rv[j]; } }
      y += __shfl_xor(y, 1); y += __shfl_xor(y, 2);
      if (q == 0) yo[s * 64 + row] = y;
    }
    __syncthreads();
#pragma unroll
    for (int i = 0; i < 4; ++i) { const int idx = tid + i * 256, s = idx >> 6, kx = idx & 63, st = c0 + s, t = dir ? (SEQ - 1 - st) : st; Ed[((size_t)b * SEQ + t) * 512 + h * 64 + kx] = f2bf(yo[idx]); }
  }
}

template <int DV>
struct Gla {
  static constexpr int NVB = DV / 16, QP = 136, VP = DV + 8, MP = 72;
  bf16_t *Qs, *Ks, *Vs, *Ms, *St; float *P, *Qv, *I, *Wl, *Mt, *gl;
  f32x4 acc[NVB][2];
  int lane, w, fr, fq;
  DI void init(char* smem) {
    Qs = (bf16_t*)smem; Ks = Qs + 64 * QP; Vs = Ks + 64 * QP; Ms = Vs + 64 * VP; St = Ms + 64 * MP;
    P = (float*)(St + DV * QP); Qv = P + 64; I = Qv + 64; Wl = I + 64; Mt = Wl + 64; gl = Mt + 64;
    lane = threadIdx.x & 63; w = threadIdx.x >> 6; fr = lane & 15; fq = lane >> 4;
    for (int i = threadIdx.x; i < DV * QP / 2; i += 256) ((unsigned*)St)[i] = 0u;
#pragma unroll
    for (int vb = 0; vb < NVB; ++vb) { acc[vb][0] = (f32x4){0.f, 0.f, 0.f, 0.f}; acc[vb][1] = (f32x4){0.f, 0.f, 0.f, 0.f}; }
  }
  DI bf16x8 gather(const bf16_t* base, int pitch, int r0, int col) const { bf16x8 r;
#pragma unroll
    for (int jj = 0; jj < 8; ++jj) r[jj] = (short)base[(r0 + jj) * pitch + col];
    return r; }
  DI void compute_y(f32x4 (&y)[NVB]) {
    bf16x8 qa[4];
#pragma unroll
    for (int ks = 0; ks < 4; ++ks) qa[ks] = *(const bf16x8*)(Qs + (w * 16 + fr) * QP + ks * 32 + fq * 8);
#pragma unroll
    for (int nb = 0; nb < 4; ++nb) {
      f32x4 g = (f32x4){0.f, 0.f, 0.f, 0.f};
      if (nb <= w) {
#pragma unroll
        for (int ks = 0; ks < 4; ++ks) { const bf16x8 kb = *(const bf16x8*)(Ks + (nb * 16 + fr) * QP + ks * 32 + fq * 8); g = MFMA16(qa[ks], kb, g); }
      }
      const int s = nb * 16 + fr; const float qs = Qv[s];
#pragma unroll
      for (int j = 0; j < 4; ++j) { const int t = w * 16 + fq * 4 + j; const float m = (s <= t) ? g[j] * __expf(P[t] - qs) : 0.f; Ms[t * MP + s] = f2bf(m); }
    }
    __syncthreads();
#pragma unroll
    for (int vb = 0; vb < NVB; ++vb) y[vb] = (f32x4){0.f, 0.f, 0.f, 0.f};
#pragma unroll
    for (int ks = 0; ks < 4; ++ks)
#pragma unroll
      for (int vb = 0; vb < NVB; ++vb) { const bf16x8 sb = *(const bf16x8*)(St + (vb * 16 + fr) * QP + ks * 32 + fq * 8); y[vb] = MFMA16(qa[ks], sb, y[vb]); }
    float sc[4];
#pragma unroll
    for (int j = 0; j < 4; ++j) sc[j] = __expf(I[w * 16 + fq * 4 + j]);
#pragma unroll
    for (int vb = 0; vb < NVB; ++vb)
#pragma unroll
      for (int j = 0; j < 4; ++j) y[vb][j] *= sc[j];
#pragma unroll
    for (int k2 = 0; k2 < 2; ++k2) {
      if (k2 * 32 <= w * 16 + 15) {
        const bf16x8 ma = *(const bf16x8*)(Ms + (w * 16 + fr) * MP + k2 * 32 + fq * 8);
#pragma unroll
        for (int vb = 0; vb < NVB; ++vb) { const bf16x8 vf = gather(Vs, VP, k2 * 32 + fq * 8, vb * 16 + fr); y[vb] = MFMA16(ma, vf, y[vb]); }
      }
    }
  }
  DI void update() {
    __syncthreads();
    const float g = __expf(gl[0]);
#pragma unroll
    for (int vb = 0; vb < NVB; ++vb) { acc[vb][0] *= g; acc[vb][1] *= g; }
#pragma unroll
    for (int k2 = 0; k2 < 2; ++k2) {
      const int s0 = k2 * 32 + fq * 8;
      float wsc[8];
#pragma unroll
      for (int jj = 0; jj < 8; ++jj) wsc[jj] = __expf(Wl[s0 + jj]);
      const bf16x8 kb0 = gather(Ks, QP, s0, (2 * w) * 16 + fr), kb1 = gather(Ks, QP, s0, (2 * w + 1) * 16 + fr);
#pragma unroll
      for (int vb = 0; vb < NVB; ++vb) {
        bf16x8 va;
#pragma unroll
        for (int jj = 0; jj < 8; ++jj) va[jj] = (short)f2bf(bf2f(Vs[(s0 + jj) * VP + vb * 16 + fr]) * wsc[jj]);
        acc[vb][0] = MFMA16(va, kb0, acc[vb][0]); acc[vb][1] = MFMA16(va, kb1, acc[vb][1]);
      }
    }
#pragma unroll
    for (int vb = 0; vb < NVB; ++vb)
#pragma unroll
      for (int nn = 0; nn < 2; ++nn)
#pragma unroll
        for (int j = 0; j < 4; ++j) St[(vb * 16 + fq * 4 + j) * QP + (2 * w + nn) * 16 + fr] = f2bf(acc[vb][nn][j]);
    __syncthreads();
  }
};

DI void mamba_item(const Params& p, int item, char* smem) {
  const int dir = item >> 8, b = (item >> 4) & 15, head = item & 15, gq = head >> 3;
  const int tid = threadIdx.x;
  Gla<64> G; G.init(smem);
  const bf16_t* raw = (const bf16_t*)(p.ws + OFF_R2);
  bf16_t* Y = (bf16_t*)p.out + (size_t)dir * NTOK * 1024;
  const float Aneg = -expf(p.mb_A_log[dir * 16 + head]), dtb = p.mb_dt_bias[dir * 16 + head];
  const float* cw = p.mb_conv_w; const float* cb = p.mb_conv_b;
  for (int c = 0; c < SEQ / 64; ++c) {
    for (int v = tid; v < 2560; v += 256) {
      const int s = v / 40, cvi = v % 40;
      int xc; bf16_t* dst; bool isx = false;
      if (cvi < 16) { xc = 1024 + 256 + gq * 128 + cvi * 8; dst = G.Qs + s * G.QP + cvi * 8; }
      else if (cvi < 32) { xc = 1024 + gq * 128 + (cvi - 16) * 8; dst = G.Ks + s * G.QP + (cvi - 16) * 8; }
      else { xc = head * 64 + (cvi - 32) * 8; dst = G.Vs + s * G.VP + (cvi - 32) * 8; isx = true; }
      const int st = c * 64 + s, t = dir ? (SEQ - 1 - st) : st; const size_t tok = (size_t)b * SEQ + t;
      const bf16_t* rp = raw + tok * 2592 + 1024 + xc;
      float cur[8], prv[8], nxt[8], o[8];
      unpack8(ld8(rp), cur);
      if (t > 0) unpack8(ld8(rp - 2592), prv); else for (int j = 0; j < 8; ++j) prv[j] = 0.f;
      if (t < SEQ - 1) unpack8(ld8(rp + 2592), nxt); else for (int j = 0; j < 8; ++j) nxt[j] = 0.f;
      float sc = 1.f;
      if (isx) sc = softplusf_(bf2f(raw[tok * 2592 + 2560 + dir * 16 + head]) + dtb);
#pragma unroll
      for (int j = 0; j < 8; ++j) o[j] = sc * siluf_(cb[xc + j] + cw[xc + j] * prv[j] + cw[1536 + xc + j] * cur[j] + cw[3072 + xc + j] * nxt[j]);
      *(u32x4*)dst = pack8(o);
    }
    if (tid < 64) {
      const int s = tid, st = c * 64 + s, t = dir ? (SEQ - 1 - st) : st; const size_t tok = (size_t)b * SEQ + t;
      const float dt = softplusf_(bf2f(raw[tok * 2592 + 2560 + dir * 16 + head]) + dtb);
      const float cs = wave_incl_sum(dt * Aneg, s); const float csl = __shfl(cs, 63);
      G.P[s] = cs; G.Qv[s] = cs; G.I[s] = cs; G.Wl[s] = csl - cs; if (s == 0) G.gl[0] = csl;
    }
    __syncthreads();
    f32x4 y[4];
    G.compute_y(y);
#pragma unroll
    for (int vb = 0; vb < 4; ++vb)
#pragma unroll
      for (int j = 0; j < 4; ++j) { const int s = G.w * 16 + G.fq * 4 + j, st = c * 64 + s, t = dir ? (SEQ - 1 - st) : st; Y[((size_t)b * SEQ + t) * 1024 + head * 64 + vb * 16 + G.fr] = f2bf(y[vb][j]); }
    G.update();
  }
}

DI void mlstm_item(const Params& p, int item, char* smem) {
  const int half = item & 1, head = (item >> 1) & 7, b = (item >> 4) & 15, dir = item >> 8;
  const int tid = threadIdx.x;
  Gla<80> G; G.init(smem);
  if (tid < 64) { for (int j = 0; j < 16; ++j) G.Vs[tid * G.VP + 64 + j] = (j == 0) ? (bf16_t)0x3f80 : (bf16_t)0; }
  const bf16_t* raw = (const bf16_t*)(p.ws + OFF_MLRAW);
  bf16_t* H = (bf16_t*)(p.ws + OFF_HFB) + (size_t)dir * NTOK * 1024;
  const float ib = p.ml_i_b[dir * 8 + head], fb = p.ml_f_b[dir * 8 + head];
  const int cvi = tid & 15, ch = head * 128 + cvi * 8, j0 = ch >> 2;
  float mprev = 0.f;
  for (int c = 0; c < SEQ / 64; ++c) {
#pragma unroll 1
    for (int i = 0; i < 4; ++i) {
      asm volatile("" ::: "memory");
      const int s = (tid >> 4) + 16 * i, st = c * 64 + s, t = dir ? (SEQ - 1 - st) : st; const size_t tok = (size_t)b * SEQ + t;
      const bf16_t* rp = raw + tok * 2080 + ch;
      float cur[8], prv[8], nxt[8], xc[8], q[8], k[8], v[8];
      unpack8(ld8(rp), cur);
      if (t > 0) unpack8(ld8(rp - 2080), prv); else for (int j = 0; j < 8; ++j) prv[j] = 0.f;
      if (t < SEQ - 1) unpack8(ld8(rp + 2080), nxt); else for (int j = 0; j < 8; ++j) nxt[j] = 0.f;
#pragma unroll
      for (int j = 0; j < 8; ++j) xc[j] = siluf_(p.ml_conv_b[ch + j] + p.ml_conv_w[ch + j] * prv[j] + p.ml_conv_w[1024 + ch + j] * cur[j] + p.ml_conv_w[2048 + ch + j] * nxt[j]);
#pragma unroll
      for (int bl = 0; bl < 2; ++bl)
#pragma unroll
        for (int d = 0; d < 4; ++d) { float aq = 0.f, ak = 0.f, av = 0.f;
#pragma unroll
          for (int cc = 0; cc < 4; ++cc) { const int wi = (j0 + bl) * 16 + cc * 4 + d; aq += xc[bl * 4 + cc] * p.ml_wq[wi]; ak += xc[bl * 4 + cc] * p.ml_wk[wi]; av += cur[bl * 4 + cc] * p.ml_wv[wi]; }
          q[bl * 4 + d] = aq; k[bl * 4 + d] = ak * 0.08838834764831845f; v[bl * 4 + d] = av; }
      *(u32x4*)(G.Qs + s * G.QP + cvi * 8) = pack8(q);
      *(u32x4*)(G.Ks + s * G.QP + cvi * 8) = pack8(k);
      if ((cvi >> 3) == half) *(u32x4*)(G.Vs + s * G.VP + (cvi & 7) * 8) = pack8(v);
    }
    if (tid < 64) {
      const int s = tid, st = c * 64 + s, t = dir ? (SEQ - 1 - st) : st; const size_t tok = (size_t)b * SEQ + t;
      const float li = bf2f(raw[tok * 2080 + 2048 + dir * 8 + head]) + ib;
      const float fx = bf2f(raw[tok * 2080 + 2064 + dir * 8 + head]) + fb;
      const float lf = fminf(fx, 0.f) - log1pf(expf(-fabsf(fx)));
      const float bc = wave_incl_sum(lf, s);
      const float cc = li - bc;
      const float pm = fmaxf(wave_incl_max(cc, s), mprev);
      const float pml = __shfl(pm, 63), bl = __shfl(bc, 63);
      G.P[s] = -pm; G.Qv[s] = -cc; G.I[s] = mprev - pm; G.Wl[s] = cc - pml; G.Mt[s] = bc + pm; if (s == 0) G.gl[0] = mprev - pml;
      mprev = bl + pml;
    }
    __syncthreads();
    f32x4 y[5];
    G.compute_y(y);
#pragma unroll
    for (int j = 0; j < 4; ++j) {
      const float den = __shfl(y[4][j], G.lane & 48);
      const int s = G.w * 16 + G.fq * 4 + j, st = c * 64 + s, t = dir ? (SEQ - 1 - st) : st;
      const float dn = 1.0f / fmaxf(fabsf(den), __expf(-G.Mt[s]));
#pragma unroll
      for (int vb = 0; vb < 4; ++vb) H[((size_t)b * SEQ + t) * 1024 + head * 128 + half * 64 + vb * 16 + G.fr] = f2bf(y[vb][j] * dn);
    }
    G.update();
  }
}

DI void s5_item(const Params& p, int item, char* smem) {
  constexpr int T = 16, XP = 136;
  const int dir = item >> 7, b = (item >> 3) & 15, gq = item & 7;
  const int tid = threadIdx.x, lane = tid & 63, wave = tid >> 6, fr = lane & 15, fq = lane >> 4;
  const int g = gq * 4 + wave;
  float* Uw = (float*)smem + wave * 256;
  bf16_t* Xw = (bf16_t*)(smem + 4096) + wave * (T * XP);
  const bf16_t* U = (const bf16_t*)(p.ws + OFF_S5U);
  bf16_t* Y = (bf16_t*)(p.ws + OFF_S5Y) + (size_t)dir * NTOK * 512;
  const float dtv = expf(p.s5_log_dt[dir * 32 + g]);
  const float ar = fminf(p.s5_A_re[(dir * 32 + g) * 64 + lane], -1e-4f), ai = p.s5_A_im[(dir * 32 + g) * 64 + lane];
  const float mag = expf(dtv * ar), abr = mag * cosf(dtv * ai), abi = mag * sinf(dtv * ai);
  const float den = ar * ar + ai * ai;
  const float f_r = ((abr - 1.0f) * ar + abi * ai) / den, f_i = (abi * ar - (abr - 1.0f) * ai) / den;
  float bbr[16], bbi[16];
#pragma unroll
  for (int m = 0; m < 16; ++m) { const float br = p.s5_B_re[(g * 64 + lane) * 16 + m], bi = p.s5_B_im[(g * 64 + lane) * 16 + m]; bbr[m] = f_r * br - f_i * bi; bbi[m] = f_r * bi + f_i * br; }
  bf16x8 cf[4];
#pragma unroll
  for (int ks = 0; ks < 4; ++ks)
#pragma unroll
    for (int jj = 0; jj < 8; ++jj) { const int k = ks * 32 + fq * 8 + jj; const size_t base = ((size_t)(dir * 32 + g) * 16 + fr) * 64;
      cf[ks][jj] = (short)f2bf(k < 64 ? p.s5_C_re[base + k] : -p.s5_C_im[base + k - 64]); }
  float xr = 0.f, xi = 0.f;
  for (int c0 = 0; c0 < SEQ; c0 += T) {
    __syncthreads();
    { const int s = lane >> 2, m4 = (lane & 3) * 4, st = c0 + s, t = dir ? (SEQ - 1 - st) : st;
      const u32x2 q = *(const u32x2*)(U + ((size_t)b * SEQ + t) * 512 + g * 16 + m4);
      f32x4 uv; uv[0] = __uint_as_float(q.x << 16); uv[1] = __uint_as_float(q.x & 0xffff0000u); uv[2] = __uint_as_float(q.y << 16); uv[3] = __uint_as_float(q.y & 0xffff0000u);
      *(f32x4*)(Uw + s * 16 + m4) = uv; }
    __syncthreads();
#pragma unroll 4
    for (int s = 0; s < T; ++s) {
      float bur = 0.f, bui = 0.f;
#pragma unroll
      for (int m4 = 0; m4 < 4; ++m4) { const f32x4 uv = *(const f32x4*)(Uw + s * 16 + m4 * 4);
#pragma unroll
        for (int j = 0; j < 4; ++j) { bur += bbr[m4 * 4 + j] * uv[j]; bui += bbi[m4 * 4 + j] * uv[j]; } }
      const float nr = abr * xr - abi * xi + bur, ni = abr * xi + abi * xr + bui;
      xr = nr; xi = ni;
      Xw[s * XP + lane] = f2bf(xr); Xw[s * XP + 64 + lane] = f2bf(xi);
    }
    __syncthreads();
    f32x4 y = (f32x4){0.f, 0.f, 0.f, 0.f};
#pragma unroll
    for (int ks = 0; ks < 4; ++ks) { const bf16x8 xa = *(const bf16x8*)(Xw + fr * XP + ks * 32 + fq * 8); y = MFMA16(xa, cf[ks], y); }
#pragma unroll
    for (int j = 0; j < 4; ++j) { const int s = fq * 4 + j, st = c0 + s, t = dir ? (SEQ - 1 - st) : st; Y[((size_t)b * SEQ + t) * 512 + g * 16 + fr] = f2bf(y[j]); }
  }
}

DI void phase_post0(const Params& p) {
  const int lane = threadIdx.x & 63, wid = threadIdx.x >> 6;
  const int gw = blockIdx.x * 4 + wid, nw = gridDim.x * 4;
  {
    bf16_t* E0 = (bf16_t*)(p.ws + OFF_R1); const bf16_t* E1 = E0 + (size_t)NTOK * 512; const bf16_t* Ab = E1 + (size_t)NTOK * 512;
    const bf16_t* G = (const bf16_t*)(p.ws + OFF_XN); const bf16_t* RKV = (const bf16_t*)(p.ws + OFF_RKV);
    for (int u = gw; u < NTOK * 8; u += nw) {
      const int tok = u >> 3, h = u & 7, c = h * 64 + lane;
      const float y = bf2f(E0[(size_t)tok * 512 + c]) + bf2f(E1[(size_t)tok * 512 + c]);
      const float mean = wave_sum(y) * (1.0f / 64.0f); const float d = y - mean; const float var = wave_sum(d * d) * (1.0f / 64.0f);
      const float yn = d * rsqrtf(var + 64e-5f) * p.rw_ln_w[c];
      const float r = bf2f(RKV[(size_t)tok * 1536 + c]), k = bf2f(RKV[(size_t)tok * 1536 + 512 + c]), v = bf2f(RKV[(size_t)tok * 1536 + 1024 + c]);
      const float a = bf2f(Ab[(size_t)tok * 512 + c]);
      const float k2 = k * (1.0f + (a - 1.0f) * p.rw_k_a[c]);
      const float bonus = wave_sum(r * k2 * p.rw_r_k[c]) * v;
      E0[(size_t)tok * 512 + c] = f2bf((yn + bonus) * bf2f(G[(size_t)tok * 512 + c]));
    }
  }
  {
    bf16_t* raw = (bf16_t*)(p.ws + OFF_R2);
    const bf16_t* Y0 = (const bf16_t*)p.out; const bf16_t* Y1 = Y0 + (size_t)NTOK * 1024;
    const float* cw = p.mb_conv_w; const float* cb = p.mb_conv_b;
    for (int u = gw; u < NTOK * 2; u += nw) {
      const int tok = u >> 1, gq = u & 1, col = gq * 512 + lane * 8, head = col >> 6, t = tok & (SEQ - 1);
      float y0[8], y1[8], z[8], cur[8], prv[8], nxt[8], o[8];
      unpack8(ld8(Y0 + (size_t)tok * 1024 + col), y0); unpack8(ld8(Y1 + (size_t)tok * 1024 + col), y1);
      bf16_t* zp = raw + (size_t)tok * 2592 + col;
      unpack8(ld8(zp), z);
      const bf16_t* rp = zp + 1024;
      unpack8(ld8(rp), cur);
      if (t > 0) unpack8(ld8(rp - 2592), prv); else for (int j = 0; j < 8; ++j) prv[j] = 0.f;
      if (t < SEQ - 1) unpack8(ld8(rp + 2592), nxt); else for (int j = 0; j < 8; ++j) nxt[j] = 0.f;
      const float D = p.mb_D[head];
      float ss = 0.f;
#pragma unroll
      for (int j = 0; j < 8; ++j) { const float xs = siluf_(cb[col + j] + cw[col + j] * prv[j] + cw[1536 + col + j] * cur[j] + cw[3072 + col + j] * nxt[j]);
        const float yy = (y0[j] + y1[j] + D * xs) * siluf_(z[j]); o[j] = yy; ss += yy * yy; }
      ss = wave_sum(ss);
      const float rs = rsqrtf(ss * (1.0f / 512.0f) + 1e-5f);
#pragma unroll
      for (int j = 0; j < 8; ++j) o[j] = o[j] * rs * p.mb_norm_w[col + j];
      *(u32x4*)zp = pack8(o);
    }
  }
}

DI float gelu_tanh(float x) { const float u = 0.7978845608028654f * (x + 0.044715f * x * x * x); return 0.5f * x * (1.0f + tanhf(u)); }

DI void phase_post1(const Params& p) {
  const int lane = threadIdx.x & 63, wid = threadIdx.x >> 6;
  const int gw = blockIdx.x * 4 + wid, nw = gridDim.x * 4;
  {
    const bf16_t* U = (const bf16_t*)(p.ws + OFF_S5U); const bf16_t* Y0 = (const bf16_t*)(p.ws + OFF_S5Y); const bf16_t* Y1 = Y0 + (size_t)NTOK * 512;
    bf16_t* YG = (bf16_t*)(p.ws + OFF_YG);
    for (int tok = gw; tok < NTOK; tok += nw) {
      const int col = lane * 8; float u[8], a[8], c[8], o[8];
      unpack8(ld8(U + (size_t)tok * 512 + col), u); unpack8(ld8(Y0 + (size_t)tok * 512 + col), a); unpack8(ld8(Y1 + (size_t)tok * 512 + col), c);
#pragma unroll
      for (int j = 0; j < 8; ++j) o[j] = gelu_tanh(p.s5_D[col + j] * u[j] + a[j] + c[j]);
      *(u32x4*)(YG + (size_t)tok * 512 + col) = pack8(o);
    }
  }
  {
    bf16_t* raw = (bf16_t*)(p.ws + OFF_MLRAW);
    const bf16_t* HF = (const bf16_t*)(p.ws + OFF_HFB); const bf16_t* HB = HF + (size_t)NTOK * 1024;
    for (int u = gw; u < NTOK * 8; u += nw) {
      const int tok = u >> 3, head = u & 7, c = head * 128 + lane * 2, t = tok & (SEQ - 1);
      const unsigned hf = *(const unsigned*)(HF + (size_t)tok * 1024 + c), hb = *(const unsigned*)(HB + (size_t)tok * 1024 + c);
      const float h0 = __uint_as_float(hf << 16) + __uint_as_float(hb << 16), h1 = __uint_as_float(hf & 0xffff0000u) + __uint_as_float(hb & 0xffff0000u);
      const float mean = wave_sum(h0 + h1) * (1.0f / 128.0f);
      const float d0 = h0 - mean, d1 = h1 - mean;
      const float var = wave_sum(d0 * d0 + d1 * d1) * (1.0f / 128.0f);
      const float rs = rsqrtf(var + 1e-5f);
      bf16_t* xp = raw + (size_t)tok * 2080 + c;
      const unsigned xc_ = *(const unsigned*)xp;
      const unsigned xp_ = t > 0 ? *(const unsigned*)(xp - 2080) : 0u, xn_ = t < SEQ - 1 ? *(const unsigned*)(xp + 2080) : 0u;
      const unsigned ov = *(const unsigned*)(xp + 1024);
      float o[2];
#pragma unroll
      for (int j = 0; j < 2; ++j) {
        const float cur = j ? __uint_as_float(xc_ & 0xffff0000u) : __uint_as_float(xc_ << 16);
        const float prv = j ? __uint_as_float(xp_ & 0xffff0000u) : __uint_as_float(xp_ << 16);
        const float nxt = j ? __uint_as_float(xn_ & 0xffff0000u) : __uint_as_float(xn_ << 16);
        const float og = j ? __uint_as_float(ov & 0xffff0000u) : __uint_as_float(ov << 16);
        const float xcv = siluf_(p.ml_conv_b[c + j] + p.ml_conv_w[c + j] * prv + p.ml_conv_w[1024 + c + j] * cur + p.ml_conv_w[2048 + c + j] * nxt);
        const float hn = (j ? d1 : d0) * rs * p.ml_norm_w[c + j];
        o[j] = sigmoidf_(og) * hn + p.ml_skip[c + j] * xcv;
      }
      *(unsigned*)(xp + 1024) = pack2(o[0], o[1]);
    }
  }
}

DI void phase_final(const Params& p) {
  const int lane = threadIdx.x & 63, wid = threadIdx.x >> 6;
  for (int u = blockIdx.x; u < NTOK / 4; u += gridDim.x) {
    float* xr = p.out + (size_t)(u * 4 + wid) * 1024;
    f32x4 v[4]; float ss = 0.f;
#pragma unroll
    for (int i = 0; i < 4; ++i) { v[i] = *(const f32x4*)(xr + i * 256 + lane * 4); ss += v[i][0] * v[i][0] + v[i][1] * v[i][1] + v[i][2] * v[i][2] + v[i][3] * v[i][3]; }
    ss = wave_sum(ss);
    const float rs = rsqrtf(ss * (1.0f / 1024.0f) + 1e-5f);
#pragma unroll
    for (int i = 0; i < 4; ++i) { const f32x4 g = *(const f32x4*)(p.norm_final + i * 256 + lane * 4); *(f32x4*)(xr + i * 256 + lane * 4) = v[i] * rs * g; }
  }
}

constexpr int NPHASE = 20;
#ifndef ONLY_PHASE
#define ONLY_PHASE -1
#endif
#define PH(k) case k: if (ONLY_PHASE >= 0 && ONLY_PHASE != k) break;
template <int ph> DI void run_phase(const Params& p, char* smem) {
  char* ws = p.ws;
  bf16_t* XN = (bf16_t*)(ws + OFF_XN);
  switch (ph) {
    PH(0) phase_prep(p, smem); break;
    PH(1) gemm_phase(smem, XN, 1024, 1 << 30, XN, 1024, (const bf16_t*)(ws + OFF_WABIN), 1024, 35,
                       EpiSplit{(bf16_t*)(ws + OFF_R1), 1792, 1792, (bf16_t*)(ws + OFF_R2), 2592, 2592}); break;
    PH(2) phase_rw_shift(p); break;
    PH(3) phase_rw_small_gemms(p, smem); break;
    PH(4) {
      const int G = gridDim.x, bx = blockIdx.x;
      if (G >= 512) { if (bx < 256) rwkv_item(p, bx, smem); else for (int u = bx - 256; u < 512; u += G - 256) mamba_item(p, u, smem); }
      else for (int u = bx; u < 768; u += G) { if (u < 256) rwkv_item(p, u, smem); else mamba_item(p, u - 256, smem); }
    } break;
    PH(5) phase_post0(p); break;
    PH(6) gemm_phase(smem, (const bf16_t*)(ws + OFF_R1), 512, 512, (const bf16_t*)(ws + OFF_R2), 2592, (const bf16_t*)(ws + OFF_WABOUT), 1536, 8, EpiResid{p.x, p.out}); break;
    PH(7) phase_rmsnorm(p, p.out, p.norm_mlp); break;
    PH(8) gemm_phase(smem, XN, 1024, 1 << 30, XN, 1024, (const bf16_t*)(ws + OFF_W1), 1024, 32, EpiRelu2{(bf16_t*)(ws + OFF_R1)}); break;
    PH(9) gemm_phase(smem, (const bf16_t*)(ws + OFF_R1), 4096, 1 << 30, XN, 1024, (const bf16_t*)(ws + OFF_W2), 4096, 8, EpiResid{p.out, p.out}); break;
    PH(10) phase_rmsnorm(p, p.out, p.norm_mix + 1024); break;
    PH(11) gemm_phase(smem, XN, 1024, 1 << 30, XN, 1024, (const bf16_t*)(ws + OFF_WCDIN), 1024, 21,
                        EpiSplit{(bf16_t*)(ws + OFF_S5U), 512, 512, (bf16_t*)(ws + OFF_MLRAW), 2080, 2080}); break;
    PH(12) {
      const int G = gridDim.x, bx = blockIdx.x;
      for (int u = bx; u < 768; u += G) { if (u < 512) mlstm_item(p, u, smem); else s5_item(p, u - 512, smem); }
    } break;
    PH(13) phase_post1(p); break;
    PH(14) gemm_phase(smem, (const bf16_t*)(ws + OFF_YG), 512, 1 << 30, XN, 1024, (const bf16_t*)(ws + OFF_WGLU), 512, 4,
                        EpiGlu{(const bf16_t*)(ws + OFF_YG), p.s5_glu_b, (bf16_t*)(ws + OFF_S5Y)}); break;
    PH(15) gemm_phase(smem, (const bf16_t*)(ws + OFF_S5Y), 512, 512, (const bf16_t*)(ws + OFF_MLRAW) + 1024, 2080, (const bf16_t*)(ws + OFF_WCDOUT), 1536, 8, EpiResid{p.out, p.out}); break;
    PH(16) phase_rmsnorm(p, p.out, p.norm_mlp + 1024); break;
    PH(17) gemm_phase(smem, XN, 1024, 1 << 30, XN, 1024, (const bf16_t*)(ws + OFF_W1) + 4096ull * 1024, 1024, 32, EpiRelu2{(bf16_t*)(ws + OFF_R1)}); break;
    PH(18) gemm_phase(smem, (const bf16_t*)(ws + OFF_R1), 4096, 1 << 30, XN, 1024, (const bf16_t*)(ws + OFF_W2) + 4096ull * 1024, 4096, 8, EpiResid{p.out, p.out}); break;
    PH(19) phase_final(p); break;
    default: break;
  }
}

template <int PHI> DI void run_from(const Params& p, char* smem, int ph0, int ph1) {
  if constexpr (PHI < NPHASE) {
    if (ph0 <= PHI && PHI < ph1) {
      run_phase<PHI>(p, smem);
      if (PHI + 1 < ph1) { __syncthreads(); cg::this_grid().sync(); }
    }
    run_from<PHI + 1>(p, smem, ph0, ph1);
  }
}

__global__ void __launch_bounds__(256, 2) mega(Params p, int ph0, int ph1) {
  extern __shared__ __attribute__((aligned(16))) char smem[];
  run_from<0>(p, smem, ph0, ph1);
}

#ifndef ONE_LAUNCH
#define ONE_LAUNCH 1
#endif

extern "C" void kernel_launch(void* const* d_in, const int* in_sizes, int n_in, void* d_out, int out_size, void* d_ws, size_t ws_size,
                              hipStream_t stream) {
  static int grid_blocks = 0;
  if (!grid_blocks) {
    hipFuncSetAttribute((const void*)mega, hipFuncAttributeMaxDynamicSharedMemorySize, LDS_BYTES);
    int dev = 0, cus = 0, per_cu = 0;
    hipGetDevice(&dev);
    hipDeviceGetAttribute(&cus, hipDeviceAttributeMultiprocessorCount, dev);
    hipOccupancyMaxActiveBlocksPerMultiprocessor(&per_cu, mega, 256, LDS_BYTES);
    if (per_cu > 2) per_cu = 2;
    if (per_cu < 1) per_cu = 1;
    grid_blocks = cus * per_cu;
  }
  Params p{};
  const float** pf = (const float**)&p;
  for (int i = 0; i < 45; ++i) pf[i] = (const float*)d_in[i];
  p.out = (float*)d_out;
  p.ws = (char*)d_ws;
#if ONE_LAUNCH
  int ph0 = 0, ph1 = NPHASE;
  void* args[] = {&p, &ph0, &ph1};
  hipError_t e = hipLaunchCooperativeKernel((const void*)mega, dim3(grid_blocks), dim3(256), args, LDS_BYTES, stream);
  if (e != hipSuccess) fprintf(stderr, "cooperative launch failed: %s (grid %d)\n", hipGetErrorString(e), grid_blocks);
#else
  for (int ph = 0; ph < NPHASE; ++ph) hipLaunchKernelGGL(mega, dim3(grid_blocks), dim3(256), LDS_BYTES, stream, p, ph, ph + 1);
#endif
}
```

```cpp
#include <hip/hip_runtime.h>
#include <hip/hip_cooperative_groups.h>
#include <stdint.h>
#include <cstdio>
namespace cg = cooperative_groups;

typedef unsigned short bf16_t;
typedef short bf16x8 __attribute__((ext_vector_type(8)));
typedef float f32x4 __attribute__((ext_vector_type(4)));
typedef unsigned u32x4 __attribute__((ext_vector_type(4)));
typedef unsigned u32x2 __attribute__((ext_vector_type(2)));

#define DI __device__ __forceinline__
#define MFMA16(a, b, c) __builtin_amdgcn_mfma_f32_16x16x32_bf16((a), (b), (c), 0, 0, 0)

constexpr int NTOK = 32768, SEQ = 2048;
constexpr size_t MiB = 1ull << 20;
constexpr size_t OFF_WABIN = 0;
constexpr size_t OFF_WABOUT = OFF_WABIN + 4480ull * 1024 * 2;
constexpr size_t OFF_W1 = OFF_WABOUT + 1024ull * 1536 * 2;
constexpr size_t OFF_W2 = OFF_W1 + 2ull * 4096 * 1024 * 2;
constexpr size_t OFF_WCDIN = OFF_W2 + 2ull * 4096 * 1024 * 2;
constexpr size_t OFF_WCDOUT = OFF_WCDIN + 2688ull * 1024 * 2;
constexpr size_t OFF_WGLU = OFF_WCDOUT + 1024ull * 1536 * 2;
constexpr size_t OFF_WG2 = OFF_WGLU + 512ull * 512 * 2;
constexpr size_t OFF_WW2 = OFF_WG2 + 512ull * 128 * 2;
constexpr size_t OFF_WA2 = OFF_WW2 + 2ull * 512 * 64 * 2;
constexpr size_t OFF_WEND = OFF_WA2 + 512ull * 64 * 2;
static_assert(OFF_WEND <= 56 * MiB, "weights region");
constexpr size_t OFF_XN = 56 * MiB;
constexpr size_t OFF_R1 = 120 * MiB;
constexpr size_t OFF_R2 = 232 * MiB;
constexpr size_t OFF_RKV = 394 * MiB;
constexpr size_t OFF_SM = 490 * MiB;
constexpr size_t OFF_S5U = 120 * MiB;
constexpr size_t OFF_MLRAW = 152 * MiB;
constexpr size_t OFF_S5Y = 282 * MiB;
constexpr size_t OFF_HFB = 346 * MiB;
constexpr size_t OFF_YG = 474 * MiB;
constexpr int LDS_BYTES = 79872;

struct Params {
  const float *x, *norm_mix, *norm_mlp, *norm_final, *mlp_w1, *mlp_w2, *ab_w_in, *ab_w_out, *rw_mu, *rw_w0, *rw_w2, *rw_a0,
      *rw_a2, *rw_g2, *rw_k_k, *rw_k_a, *rw_r_k, *rw_ln_w, *mb_conv_w, *mb_conv_b, *mb_dt_bias, *mb_A_log, *mb_D, *mb_norm_w,
      *cd_w_in, *cd_w_out, *s5_A_re, *s5_A_im, *s5_log_dt, *s5_B_re, *s5_B_im, *s5_C_re, *s5_C_im, *s5_D, *s5_glu_w, *s5_glu_b,
      *ml_conv_w, *ml_conv_b, *ml_wq, *ml_wk, *ml_wv, *ml_i_b, *ml_f_b, *ml_norm_w, *ml_skip;
  float* out;
  char* ws;
};

DI float bf2f(bf16_t v) { return __uint_as_float(((unsigned)v) << 16); }
DI bf16_t f2bf(float x) { unsigned u = __float_as_uint(x); u += 0x7fffu + ((u >> 16) & 1u); return (bf16_t)(u >> 16); }
DI unsigned pack2(float lo, float hi) { return (unsigned)f2bf(lo) | ((unsigned)f2bf(hi) << 16); }
DI void unpack8(u32x4 w, float* f) {
#pragma unroll
  for (int i = 0; i < 4; ++i) { f[2 * i] = __uint_as_float(w[i] << 16); f[2 * i + 1] = __uint_as_float(w[i] & 0xffff0000u); }
}
DI u32x4 pack8(const float* f) { u32x4 w; w.x = pack2(f[0], f[1]); w.y = pack2(f[2], f[3]); w.z = pack2(f[4], f[5]); w.w = pack2(f[6], f[7]); return w; }
DI u32x4 ld8(const bf16_t* p) { return *(const u32x4*)p; }
DI float wave_sum(float v) {
#pragma unroll
  for (int o = 32; o > 0; o >>= 1) v += __shfl_xor(v, o);
  return v;
}
DI float sigmoidf_(float x) { return 1.0f / (1.0f + __expf(-x)); }
DI float siluf_(float x) { return x / (1.0f + __expf(-x)); }
DI float softplusf_(float x) { return x > 20.f ? x : log1pf(expf(x)); }
DI float wave_incl_sum(float v, int lane) {
#pragma unroll
  for (int o = 1; o < 64; o <<= 1) { float t = __shfl_up(v, o); if (lane >= o) v += t; }
  return v;
}
DI float wave_incl_max(float v, int lane) {
#pragma unroll
  for (int o = 1; o < 64; o <<= 1) { float t = __shfl_up(v, o); if (lane >= o) v = fmaxf(v, t); }
  return v;
}

DI bool get_tdesc(const Params& p, int i, const float*& src, bf16_t*& dst, int& K, int& Nsrc, int& Npad) {
  char* ws = p.ws;
  switch (i) {
    case 0: src = p.ab_w_in; dst = (bf16_t*)(ws + OFF_WABIN); K = 1024; Nsrc = 4384; Npad = 4480; return true;
    case 1: src = p.ab_w_out; dst = (bf16_t*)(ws + OFF_WABOUT); K = 1536; Nsrc = 1024; Npad = 1024; return true;
    case 2: src = p.mlp_w1; dst = (bf16_t*)(ws + OFF_W1); K = 1024; Nsrc = 4096; Npad = 4096; return true;
    case 3: src = p.mlp_w1 + 1024ull * 4096; dst = (bf16_t*)(ws + OFF_W1) + 4096ull * 1024; K = 1024; Nsrc = 4096; Npad = 4096; return true;
    case 4: src = p.mlp_w2; dst = (bf16_t*)(ws + OFF_W2); K = 4096; Nsrc = 1024; Npad = 1024; return true;
    case 5: src = p.mlp_w2 + 4096ull * 1024; dst = (bf16_t*)(ws + OFF_W2) + 4096ull * 1024; K = 4096; Nsrc = 1024; Npad = 1024; return true;
    case 6: src = p.cd_w_in; dst = (bf16_t*)(ws + OFF_WCDIN); K = 1024; Nsrc = 2592; Npad = 2688; return true;
    case 7: src = p.cd_w_out; dst = (bf16_t*)(ws + OFF_WCDOUT); K = 1536; Nsrc = 1024; Npad = 1024; return true;
    case 8: src = p.s5_glu_w; dst = (bf16_t*)(ws + OFF_WGLU); K = 512; Nsrc = 512; Npad = 512; return true;
    case 9: src = p.rw_g2; dst = (bf16_t*)(ws + OFF_WG2); K = 128; Nsrc = 512; Npad = 512; return true;
    case 10: src = p.rw_w2; dst = (bf16_t*)(ws + OFF_WW2); K = 64; Nsrc = 512; Npad = 512; return true;
    case 11: src = p.rw_w2 + 64 * 512; dst = (bf16_t*)(ws + OFF_WW2) + 512 * 64; K = 64; Nsrc = 512; Npad = 512; return true;
    case 12: src = p.rw_a2; dst = (bf16_t*)(ws + OFF_WA2); K = 64; Nsrc = 512; Npad = 512; return true;
    default: return false;
  }
}

DI void rmsnorm_row_to_bf16(const float* __restrict__ xr, const float* __restrict__ w, bf16_t* __restrict__ o, int lane) {
  f32x4 v[4]; float ss = 0.f;
#pragma unroll
  for (int i = 0; i < 4; ++i) { v[i] = *(const f32x4*)(xr + i * 256 + lane * 4); ss += v[i][0] * v[i][0] + v[i][1] * v[i][1] + v[i][2] * v[i][2] + v[i][3] * v[i][3]; }
  ss = wave_sum(ss);
  const float rs = rsqrtf(ss * (1.0f / 1024.0f) + 1e-5f);
#pragma unroll
  for (int i = 0; i < 4; ++i) { const f32x4 g = *(const f32x4*)(w + i * 256 + lane * 4); u32x2 q; q.x = pack2(v[i][0] * rs * g[0], v[i][1] * rs * g[1]); q.y = pack2(v[i][2] * rs * g[2], v[i][3] * rs * g[3]); *(u32x2*)(o + i * 256 + lane * 4) = q; }
}

DI void phase_rmsnorm(const Params& p, const float* src, const float* w) {
  bf16_t* xn = (bf16_t*)(p.ws + OFF_XN);
  const int lane = threadIdx.x & 63, wid = threadIdx.x >> 6;
  for (int u = blockIdx.x; u < NTOK / 4; u += gridDim.x) { const int row = u * 4 + wid; rmsnorm_row_to_bf16(src + (size_t)row * 1024, w, xn + (size_t)row * 1024, lane); }
}

DI void phase_prep(const Params& p, char* smem) {
  float* tile = (float*)smem;
  const int tid = threadIdx.x;
  int ntr = 0;
  for (int i = 0; i < 13; ++i) { const float* s; bf16_t* d; int K, Ns, Np; get_tdesc(p, i, s, d, K, Ns, Np); ntr += (K / 64) * (Np / 64); }
  for (int u = blockIdx.x; u < ntr; u += gridDim.x) {
    const float* src = nullptr; bf16_t* dst = nullptr; int K = 64, Ns = 0, Np = 64, r = u;
    for (int mi = 0; mi < 13; ++mi) { get_tdesc(p, mi, src, dst, K, Ns, Np); const int nt = (K / 64) * (Np / 64); if (r < nt) break; r -= nt; }
    const int nkb = K / 64, kb = r % nkb, nb = r / nkb;
    __syncthreads();
#pragma unroll
    for (int i = 0; i < 16; ++i) { const int k = i * 4 + (tid >> 6), n = tid & 63; const int gn = nb * 64 + n; tile[k * 65 + n] = gn < Ns ? src[(size_t)(kb * 64 + k) * Ns + gn] : 0.f; }
    __syncthreads();
    const int n = tid >> 2, ks = (tid & 3) * 16; float f[16];
#pragma unroll
    for (int j = 0; j < 16; ++j) f[j] = tile[(ks + j) * 65 + n];
    bf16_t* o = dst + (size_t)(nb * 64 + n) * K + kb * 64 + ks;
    *(u32x4*)o = pack8(f); *(u32x4*)(o + 8) = pack8(f + 8);
  }
  phase_rmsnorm(p, p.x, p.norm_mix);
}

template <class Epi>
DI void gemm_tile(char* smem, const bf16_t* __restrict__ A0, int lda0, int ksplit, const bf16_t* __restrict__ A1, int lda1,
                  const bf16_t* __restrict__ Bt, int K, int row0, int col0, const Epi& epi) {
  constexpr int BK = 64, PITCH = 72, BUF = 2 * 128 * PITCH;
  bf16_t* sbase = (bf16_t*)smem;
  const int tid = threadIdx.x, lane = tid & 63, wid = tid >> 6, wr = wid >> 1, wc = wid & 1, fr = lane & 15, fq = lane >> 4;
  f32x4 acc[4][4];
#pragma unroll
  for (int m = 0; m < 4; ++m)
#pragma unroll
    for (int n = 0; n < 4; ++n) acc[m][n] = (f32x4){0.f, 0.f, 0.f, 0.f};
  u32x4 ra[2][4], rb[2][4];
  const int nk = K / BK;
#define GLOAD(S, kt) do { const int k0_ = (kt) * BK; const bf16_t* Ab_; int lda_, kk_; \
    if (k0_ < ksplit) { Ab_ = A0; lda_ = lda0; kk_ = k0_; } else { Ab_ = A1; lda_ = lda1; kk_ = k0_ - ksplit; } \
    _Pragma("unroll") for (int i_ = 0; i_ < 4; ++i_) { const int v_ = tid + i_ * 256, r_ = v_ >> 3, cv_ = v_ & 7; \
      ra[S][i_] = *(const u32x4*)(Ab_ + (size_t)(row0 + r_) * lda_ + kk_ + cv_ * 8); \
      rb[S][i_] = *(const u32x4*)(Bt + (size_t)(col0 + r_) * K + k0_ + cv_ * 8); } } while (0)
#define LWRITE(S, buf) do { bf16_t* sA_ = sbase + (buf) * BUF; bf16_t* sB_ = sA_ + 128 * PITCH; \
    _Pragma("unroll") for (int i_ = 0; i_ < 4; ++i_) { const int v_ = tid + i_ * 256, r_ = v_ >> 3, cv_ = v_ & 7; \
      *(u32x4*)(sA_ + r_ * PITCH + cv_ * 8) = ra[S][i_]; *(u32x4*)(sB_ + r_ * PITCH + cv_ * 8) = rb[S][i_]; } } while (0)
#define COMPUTE(buf) do { const bf16_t* sA_ = sbase + (buf) * BUF; const bf16_t* sB_ = sA_ + 128 * PITCH; \
    _Pragma("unroll") for (int ks = 0; ks < 2; ++ks) { bf16x8 af[4], bfr[4]; \
      _Pragma("unroll") for (int m = 0; m < 4; ++m) af[m] = *(const bf16x8*)(sA_ + (wr * 64 + m * 16 + fr) * PITCH + ks * 32 + fq * 8); \
      _Pragma("unroll") for (int n = 0; n < 4; ++n) bfr[n] = *(const bf16x8*)(sB_ + (wc * 64 + n * 16 + fr) * PITCH + ks * 32 + fq * 8); \
      _Pragma("unroll") for (int m = 0; m < 4; ++m) _Pragma("unroll") for (int n = 0; n < 4; ++n) acc[m][n] = MFMA16(bfr[n], af[m], acc[m][n]); } } while (0)
  __syncthreads();
  if (nk == 1) {
    GLOAD(0, 0); LWRITE(0, 0); __syncthreads(); COMPUTE(0); __syncthreads();
  } else {
    const int last = nk - 1;
    GLOAD(0, 0);
    __builtin_amdgcn_sched_barrier(0);
    GLOAD(1, 1);
    __builtin_amdgcn_sched_barrier(0);
    LWRITE(0, 0);
    __builtin_amdgcn_sched_barrier(0);
    GLOAD(0, (2 < last ? 2 : last));
    __builtin_amdgcn_sched_barrier(0);
    __syncthreads();
    for (int kt = 0; kt < nk; kt += 2) {
      LWRITE(1, 1);
      __builtin_amdgcn_sched_barrier(0);
      GLOAD(1, (kt + 3 < last ? kt + 3 : last));
      __builtin_amdgcn_sched_barrier(0);
      COMPUTE(0);
      __syncthreads();
      LWRITE(0, 0);
      __builtin_amdgcn_sched_barrier(0);
      GLOAD(0, (kt + 4 < last ? kt + 4 : last));
      __builtin_amdgcn_sched_barrier(0);
      COMPUTE(1);
      __syncthreads();
    }
  }
#undef GLOAD
#undef LWRITE
#undef COMPUTE
#pragma unroll
  for (int m = 0; m < 4; ++m)
#pragma unroll
    for (int n = 0; n < 4; ++n) epi(row0 + wr * 64 + m * 16 + fr, col0 + wc * 64 + n * 16 + fq * 4, acc[m][n]);
}

DI void st_bf16x4(bf16_t* o, f32x4 v) { u32x2 q; q.x = pack2(v[0], v[1]); q.y = pack2(v[2], v[3]); *(u32x2*)o = q; }

struct EpiSplit {
  bf16_t* o0; int ld0, n0; bf16_t* o1; int ld1, n1;
  DI void operator()(int row, int col, f32x4 v) const {
    if (col < n0) st_bf16x4(o0 + (size_t)row * ld0 + col, v);
    else { const int c = col - n0; if (c < n1) st_bf16x4(o1 + (size_t)row * ld1 + c, v); }
  }
};
struct EpiDecay { const float* w0; bf16_t* o;
  DI void operator()(int row, int col, f32x4 v) const { f32x4 r; for (int j = 0; j < 4; ++j) r[j] = 0.60653066f * sigmoidf_(w0[col + j] + v[j]); st_bf16x4(o + (size_t)row * 512 + col, r); } };
struct EpiSig { const float* b0; bf16_t* o;
  DI void operator()(int row, int col, f32x4 v) const { f32x4 r; for (int j = 0; j < 4; ++j) r[j] = sigmoidf_(b0[col + j] + v[j]); st_bf16x4(o + (size_t)row * 512 + col, r); } };
struct EpiStore { bf16_t* o; int ld;
  DI void operator()(int row, int col, f32x4 v) const { st_bf16x4(o + (size_t)row * ld + col, v); } };
struct EpiResid { const float* res; float* o;
  DI void operator()(int row, int col, f32x4 v) const { const f32x4 r = *(const f32x4*)(res + (size_t)row * 1024 + col); *(f32x4*)(o + (size_t)row * 1024 + col) = r + v; } };
struct EpiRelu2 { bf16_t* o;
  DI void operator()(int row, int col, f32x4 v) const { f32x4 r; for (int j = 0; j < 4; ++j) { const float t = fmaxf(v[j], 0.f); r[j] = t * t; } st_bf16x4(o + (size_t)row * 4096 + col, r); } };
struct EpiGlu { const bf16_t* y; const float* b; bf16_t* o;
  DI void operator()(int row, int col, f32x4 v) const { const u32x2 q = *(const u32x2*)(y + (size_t)row * 512 + col); f32x4 r;
    const float y0 = __uint_as_float(q.x << 16), y1 = __uint_as_float(q.x & 0xffff0000u), y2 = __uint_as_float(q.y << 16), y3 = __uint_as_float(q.y & 0xffff0000u);
    r[0] = y0 * sigmoidf_(v[0] + b[col]); r[1] = y1 * sigmoidf_(v[1] + b[col + 1]); r[2] = y2 * sigmoidf_(v[2] + b[col + 2]); r[3] = y3 * sigmoidf_(v[3] + b[col + 3]);
    st_bf16x4(o + (size_t)row * 512 + col, r); } };

template <class Epi>
DI void gemm_phase(char* smem, const bf16_t* A0, int lda0, int ksplit, const bf16_t* A1, int lda1, const bf16_t* Bt, int K, int nN, const Epi& epi) {
  const int G = gridDim.x;
  if ((G & 7) == 0) {
    const int x = blockIdx.x & 7, l = blockIdx.x >> 3, L = G >> 3, per = 8 * nN, tot = 4 * per;
    for (int q = l; q < tot; q += L) { const int rgl = q / per, rem = q % per, ct = rem >> 3, rt = (x * 4 + rgl) * 8 + (rem & 7);
      gemm_tile(smem, A0, lda0, ksplit, A1, lda1, Bt, K, rt * 128, ct * 128, epi); }
  } else {
    const int ntiles = (NTOK / 128) * nN;
    for (int u = blockIdx.x; u < ntiles; u += G) { const int rt = u / nN, ct = u % nN; gemm_tile(smem, A0, lda0, ksplit, A1, lda1, Bt, K, rt * 128, ct * 128, epi); }
  }
}

DI void phase_rw_shift(const Params& p) {
  const bf16_t* raw = (const bf16_t*)(p.ws + OFF_R1);
  bf16_t* rkv = (bf16_t*)(p.ws + OFF_RKV); bf16_t* sm = (bf16_t*)(p.ws + OFF_SM);
  const float* mu = p.rw_mu;
  const size_t total = (size_t)NTOK * 224;
  for (size_t i = (size_t)blockIdx.x * 256 + threadIdx.x; i < total; i += (size_t)gridDim.x * 256) {
    const int tok = (int)(i / 224), cv = (int)(i % 224), c = cv * 8, s = tok & (SEQ - 1);
    const bf16_t* rp = raw + (size_t)tok * 1792 + c;
    float cur[8], prv[8], nxt[8], o[8];
    unpack8(ld8(rp), cur);
    if (s > 0) unpack8(ld8(rp - 1792), prv); else for (int j = 0; j < 8; ++j) prv[j] = 0.f;
    if (s < SEQ - 1) unpack8(ld8(rp + 1792), nxt); else for (int j = 0; j < 8; ++j) nxt[j] = 0.f;
#pragma unroll
    for (int j = 0; j < 8; ++j) o[j] = cur[j] + mu[c + j] * (prv[j] - cur[j]) + mu[1792 + c + j] * (nxt[j] - cur[j]);
    if (c < 1536) *(u32x4*)(rkv + (size_t)tok * 1536 + c) = pack8(o);
    else if (c < 1600) { for (int j = 0; j < 8; ++j) o[j] = tanhf(o[j]); *(u32x4*)(sm + (size_t)tok * 256 + (c - 1536)) = pack8(o); }
    else if (c < 1664) *(u32x4*)(sm + (size_t)tok * 256 + 64 + (c - 1600)) = pack8(o);
    else { for (int j = 0; j < 8; ++j) o[j] = sigmoidf_(o[j]); *(u32x4*)(sm + (size_t)tok * 256 + 128 + (c - 1664)) = pack8(o); }
  }
  const bf16_t* mraw = (const bf16_t*)(p.ws + OFF_R2); bf16_t* BC = (bf16_t*)(p.ws + OFF_XN + 32 * MiB);
  const float* cw = p.mb_conv_w; const float* cb = p.mb_conv_b;
  const size_t total2 = (size_t)NTOK * 64;
  for (size_t i = (size_t)blockIdx.x * 256 + threadIdx.x; i < total2; i += (size_t)gridDim.x * 256) {
    const int tok = (int)(i >> 6), cv = (int)(i & 63), xc = 1024 + cv * 8, t = tok & (SEQ - 1);
    const bf16_t* rp = mraw + (size_t)tok * 2592 + 1024 + xc;
    float cur[8], prv[8], nxt[8], o[8];
    unpack8(ld8(rp), cur);
    if (t > 0) unpack8(ld8(rp - 2592), prv); else for (int j = 0; j < 8; ++j) prv[j] = 0.f;
    if (t < SEQ - 1) unpack8(ld8(rp + 2592), nxt); else for (int j = 0; j < 8; ++j) nxt[j] = 0.f;
#pragma unroll
    for (int j = 0; j < 8; ++j) o[j] = siluf_(cb[xc + j] + cw[xc + j] * prv[j] + cw[1536 + xc + j] * cur[j] + cw[3072 + xc + j] * nxt[j]);
    *(u32x4*)(BC + (size_t)tok * 512 + cv * 8) = pack8(o);
  }
}

DI void phase_rw_small_gemms(const Params& p, char* smem) {
  const bf16_t* sm = (const bf16_t*)(p.ws + OFF_SM);
  bf16_t* E0 = (bf16_t*)(p.ws + OFF_R1); bf16_t* E1 = E0 + (size_t)NTOK * 512; bf16_t* Ab = E1 + (size_t)NTOK * 512;
  bf16_t* G = (bf16_t*)(p.ws + OFF_XN);
  const bf16_t* W2 = (const bf16_t*)(p.ws + OFF_WW2); const bf16_t* A2 = (const bf16_t*)(p.ws + OFF_WA2); const bf16_t* G2 = (const bf16_t*)(p.ws + OFF_WG2);
  for (int u = blockIdx.x; u < 4096; u += gridDim.x) {
    const int prob = u >> 10, rem = u & 1023, rt = rem >> 2, ct = rem & 3;
    if (prob == 0) gemm_tile(smem, sm, 256, 1 << 30, sm, 256, W2, 64, rt * 128, ct * 128, EpiDecay{p.rw_w0, E0});
    else if (prob == 1) gemm_tile(smem, sm, 256, 1 << 30, sm, 256, W2 + 512 * 64, 64, rt * 128, ct * 128, EpiDecay{p.rw_w0 + 512, E1});
    else if (prob == 2) gemm_tile(smem, sm + 64, 256, 1 << 30, sm, 256, A2, 64, rt * 128, ct * 128, EpiSig{p.rw_a0, Ab});
    else gemm_tile(smem, sm + 128, 256, 1 << 30, sm, 256, G2, 128, rt * 128, ct * 128, EpiStore{G, 512});
  }
}

typedef float f32x2 __attribute__((ext_vector_type(2)));
DI void rwkv_item(const Params& p, int item, char* smem) {
  constexpr int T = 32;
  const int dir = item >> 7, b = (item >> 3) & 15, h = item & 7;
  const int tid = threadIdx.x, lane = tid & 63, wave = tid >> 6, rp = tid >> 3, kq = tid & 7;
  float* op = (float*)smem;
  float* yo = op + T * 6 * 64;
  const bf16_t* RKV = (const bf16_t*)(p.ws + OFF_RKV);
  bf16_t* E0 = (bf16_t*)(p.ws + OFF_R1); bf16_t* Ed = E0 + (size_t)dir * NTOK * 512; const bf16_t* Ab = E0 + (size_t)2 * NTOK * 512;
  const float kkw = p.rw_k_k[h * 64 + lane], kaw = p.rw_k_a[h * 64 + lane];
  f32x2 S0[4], S1[4];
#pragma unroll
  for (int j = 0; j < 4; ++j) { S0[j] = (f32x2){0.f, 0.f}; S1[j] = (f32x2){0.f, 0.f}; }
  bf16_t pr[8], pk[8], pv[8], pa[8], pe[8];
#define RW_PREFETCH(c0_) do { _Pragma("unroll") for (int i = 0; i < 8; ++i) { const int st_ = (c0_) + wave * 8 + i, t_ = dir ? (SEQ - 1 - st_) : st_; const size_t tok_ = (size_t)b * SEQ + t_; \
    pr[i] = RKV[tok_ * 1536 + h * 64 + lane]; pk[i] = RKV[tok_ * 1536 + 512 + h * 64 + lane]; pv[i] = RKV[tok_ * 1536 + 1024 + h * 64 + lane]; \
    pa[i] = Ab[tok_ * 512 + h * 64 + lane]; pe[i] = Ed[tok_ * 512 + h * 64 + lane]; } } while (0)
  RW_PREFETCH(0);
  for (int c0 = 0; c0 < SEQ; c0 += T) {
    __syncthreads();
#pragma unroll
    for (int i = 0; i < 8; ++i) {
      const int s = wave * 8 + i;
      const float r = bf2f(pr[i]), k = bf2f(pk[i]), v = bf2f(pv[i]), a = bf2f(pa[i]), e = bf2f(pe[i]);
      float kk = k * kkw; const float ss = wave_sum(kk * kk); kk *= rsqrtf(fmaxf(ss, 1e-12f));
      float* o = op + s * 384;
      o[lane] = __expf(-e); o[64 + lane] = k * (1.0f + (a - 1.0f) * kaw); o[128 + lane] = -kk; o[192 + lane] = kk * a; o[256 + lane] = r; o[320 + lane] = v;
    }
    __syncthreads();
    if (c0 + T < SEQ) RW_PREFETCH(c0 + T);
#pragma unroll 2
    for (int s = 0; s < T; ++s) {
      const float* o = op + s * 384 + kq * 8;
      const f32x4 a0 = *(const f32x4*)(o + 128), a1 = *(const f32x4*)(o + 132);
      const f32x2 av[4] = {(f32x2){a0[0], a0[1]}, (f32x2){a0[2], a0[3]}, (f32x2){a1[0], a1[1]}, (f32x2){a1[2], a1[3]}};
      f32x2 t0 = S0[0] * av[0], t1 = S1[0] * av[0];
#pragma unroll
      for (int j = 1; j < 4; ++j) { t0 += S0[j] * av[j]; t1 += S1[j] * av[j]; }
      float sa0 = t0[0] + t0[1], sa1 = t1[0] + t1[1];
      sa0 += __shfl_xor(sa0, 1); sa1 += __shfl_xor(sa1, 1); sa0 += __shfl_xor(sa0, 2); sa1 += __shfl_xor(sa1, 2); sa0 += __shfl_xor(sa0, 4); sa1 += __shfl_xor(sa1, 4);
      const f32x2 vv = *(const f32x2*)(op + s * 384 + 320 + rp * 2);
      const f32x4 w0 = *(const f32x4*)(o), w1 = *(const f32x4*)(o + 4), k0 = *(const f32x4*)(o + 64), k1 = *(const f32x4*)(o + 68);
      const f32x4 b0 = *(const f32x4*)(o + 192), b1 = *(const f32x4*)(o + 196), r0 = *(const f32x4*)(o + 256), r1 = *(const f32x4*)(o + 260);
      const f32x2 wv[4] = {(f32x2){w0[0], w0[1]}, (f32x2){w0[2], w0[3]}, (f32x2){w1[0], w1[1]}, (f32x2){w1[2], w1[3]}};
      const f32x2 kv[4] = {(f32x2){k0[0], k0[1]}, (f32x2){k0[2], k0[3]}, (f32x2){k1[0], k1[1]}, (f32x2){k1[2], k1[3]}};
      const f32x2 bv[4] = {(f32x2){b0[0], b0[1]}, (f32x2){b0[2], b0[3]}, (f32x2){b1[0], b1[1]}, (f32x2){b1[2], b1[3]}};
      const f32x2 rv[4] = {(f32x2){r0[0], r0[1]}, (f32x2){r0[2], r0[3]}, (f32x2){r1[0], r1[1]}, (f32x2){r1[2], r1[3]}};
      f32x2 y0 = (f32x2){0.f, 0.f}, y1 = (f32x2){0.f, 0.f};
#pragma unroll
      for (int j = 0; j < 4; ++j) {
        S0[j] = S0[j] * wv[j] + bv[j] * sa0 + kv[j] * vv[0];
        S1[j] = S1[j] * wv[j] + bv[j] * sa1 + kv[j] * vv[1];
        y0 += S0[j] * rv[j]; y1 += S1[j] * rv[j];
      }
      float ya = y0[0] + y0[1], yb = y1[0] + y1[1];
      ya += __shfl_xor(ya, 1); yb += __shfl_xor(yb, 1); ya += __shfl_xor(ya, 2); yb += __shfl_xor(yb, 2); ya += __shfl_xor(ya, 4); yb += __shfl_xor(yb, 4);
      if (kq == 0) *(f32x2*)(yo + s * 64 + rp * 2) = (f32x2){ya, yb};
    }
    __syncthreads();
#pragma unroll
    for (int i = 0; i < 8; ++i) { const int idx = tid + i * 256, s = idx >> 6, kx = idx & 63, st = c0 + s, t = dir ? (SEQ - 1 - st) : st; Ed[((size_t)b * SEQ + t) * 512 + h * 64 + kx] = f2bf(yo[idx]); }
  }
#undef RW_PREFETCH
}

template <int DV>
struct Gla {
  static constexpr int NVB = DV / 16, QP = 136, VP = DV + 8, MP = QP;
  static constexpr int BYTES = (64 * QP * 2 + 64 * VP + DV * QP) * 2 + 6 * 64 * 4;
  char* sm;
  DI bf16_t* Qs() const { return (bf16_t*)sm; }
  DI bf16_t* Ks() const { return (bf16_t*)sm + 64 * QP; }
  DI bf16_t* Vs() const { return (bf16_t*)sm + 128 * QP; }
  DI bf16_t* St() const { return (bf16_t*)sm + 128 * QP + 64 * VP; }
  DI bf16_t* Ms() const { return (bf16_t*)sm; }
  DI float* P() const { return (float*)((bf16_t*)sm + 128 * QP + 64 * VP + DV * QP); }
  DI float* Qv() const { return P() + 64; }
  DI float* I() const { return P() + 128; }
  DI float* Wl() const { return P() + 192; }
  DI float* Mt() const { return P() + 256; }
  DI float* gl() const { return P() + 320; }
  f32x4 acc[NVB][2];
  int lane, w, fr, fq;
  DI void init(char* smem) {
    sm = smem;
    lane = threadIdx.x & 63; w = threadIdx.x >> 6; fr = lane & 15; fq = lane >> 4;
    for (int i = threadIdx.x; i < DV * QP / 2; i += 256) ((unsigned*)St())[i] = 0u;
#pragma unroll
    for (int vb = 0; vb < NVB; ++vb) { acc[vb][0] = (f32x4){0.f, 0.f, 0.f, 0.f}; acc[vb][1] = (f32x4){0.f, 0.f, 0.f, 0.f}; }
  }
  DI bf16x8 gather(const bf16_t* base, int pitch, int r0, int col) const { bf16x8 r;
#pragma unroll
    for (int jj = 0; jj < 8; ++jj) r[jj] = (short)base[(r0 + jj) * pitch + col];
    return r; }
  DI void compute_y(f32x4 (&y)[NVB]) {
    bf16x8 qa[4];
#pragma unroll
    for (int ks = 0; ks < 4; ++ks) qa[ks] = *(const bf16x8*)(Qs() + (w * 16 + fr) * QP + ks * 32 + fq * 8);
#pragma unroll
    for (int nb = 0; nb < 4; ++nb) {
      f32x4 g = (f32x4){0.f, 0.f, 0.f, 0.f};
      if (nb <= w) {
#pragma unroll
        for (int ks = 0; ks < 4; ++ks) { const bf16x8 kb = *(const bf16x8*)(Ks() + (nb * 16 + fr) * QP + ks * 32 + fq * 8); g = MFMA16(qa[ks], kb, g); }
      }
      const int s = nb * 16 + fr; const float qs = Qv()[s];
#pragma unroll
      for (int j = 0; j < 4; ++j) { const int t = w * 16 + fq * 4 + j; const float m = (s <= t) ? g[j] * __expf(P()[t] - qs) : 0.f; Ms()[t * MP + s] = f2bf(m); }
    }
    __syncthreads();
#pragma unroll
    for (int vb = 0; vb < NVB; ++vb) y[vb] = (f32x4){0.f, 0.f, 0.f, 0.f};
#pragma unroll
    for (int ks = 0; ks < 4; ++ks)
#pragma unroll
      for (int vb = 0; vb < NVB; ++vb) { const bf16x8 sb = *(const bf16x8*)(St() + (vb * 16 + fr) * QP + ks * 32 + fq * 8); y[vb] = MFMA16(qa[ks], sb, y[vb]); }
    float sc[4];
#pragma unroll
    for (int j = 0; j < 4; ++j) sc[j] = __expf(I()[w * 16 + fq * 4 + j]);
#pragma unroll
    for (int vb = 0; vb < NVB; ++vb)
#pragma unroll
      for (int j = 0; j < 4; ++j) y[vb][j] *= sc[j];
#pragma unroll
    for (int k2 = 0; k2 < 2; ++k2) {
      if (k2 * 32 <= w * 16 + 15) {
        const bf16x8 ma = *(const bf16x8*)(Ms() + (w * 16 + fr) * MP + k2 * 32 + fq * 8);
#pragma unroll
        for (int vb = 0; vb < NVB; ++vb) { const bf16x8 vf = gather(Vs(), VP, k2 * 32 + fq * 8, vb * 16 + fr); y[vb] = MFMA16(ma, vf, y[vb]); __builtin_amdgcn_sched_barrier(0); }
      }
    }
  }
  DI void update() {
    __syncthreads();
    const float g = __expf(gl()[0]);
#pragma unroll
    for (int vb = 0; vb < NVB; ++vb) { acc[vb][0] *= g; acc[vb][1] *= g; }
#pragma unroll
    for (int k2 = 0; k2 < 2; ++k2) {
      const int s0 = k2 * 32 + fq * 8;
      float wsc[8];
#pragma unroll
      for (int jj = 0; jj < 8; ++jj) wsc[jj] = __expf(Wl()[s0 + jj]);
      const bf16x8 kb0 = gather(Ks(), QP, s0, (2 * w) * 16 + fr), kb1 = gather(Ks(), QP, s0, (2 * w + 1) * 16 + fr);
#pragma unroll
      for (int vb = 0; vb < NVB; ++vb) {
        bf16x8 va;
#pragma unroll
        for (int jj = 0; jj < 8; ++jj) va[jj] = (short)f2bf(bf2f(Vs()[(s0 + jj) * VP + vb * 16 + fr]) * wsc[jj]);
        acc[vb][0] = MFMA16(va, kb0, acc[vb][0]); acc[vb][1] = MFMA16(va, kb1, acc[vb][1]);
        __builtin_amdgcn_sched_barrier(0);
      }
    }
#pragma unroll
    for (int vb = 0; vb < NVB; ++vb)
#pragma unroll
      for (int nn = 0; nn < 2; ++nn)
#pragma unroll
        for (int j = 0; j < 4; ++j) St()[(vb * 16 + fq * 4 + j) * QP + (2 * w + nn) * 16 + fr] = f2bf(acc[vb][nn][j]);
    __syncthreads();
  }
};

DI void mamba_item(const Params& p, int item, char* smem) {
  const int dir = item >> 8, b = (item >> 4) & 15, head = item & 15, gq = head >> 3;
  const int tid = threadIdx.x;
  Gla<64> G; G.init(smem);
  const bf16_t* raw = (const bf16_t*)(p.ws + OFF_R2);
  const bf16_t* BC = (const bf16_t*)(p.ws + OFF_XN + 32 * MiB);
  bf16_t* Y = (bf16_t*)p.out + (size_t)dir * NTOK * 1024;
  const float Aneg = -expf(p.mb_A_log[dir * 16 + head]), dtb = p.mb_dt_bias[dir * 16 + head];
  const int cvi = tid & 7, tg = tid >> 3, xc = head * 64 + cvi * 8;
  u32x4 px[4]; bf16_t pdt[2] = {0, 0}; bf16_t pdts = 0;
#define MB_LOADBC(c_) do { \
    _Pragma("unroll") for (int i = 0; i < 8; ++i) { const int v_ = tid + i * 256, s_ = v_ >> 5, cv_ = v_ & 31, st_ = (c_) * 64 + s_, t_ = dir ? (SEQ - 1 - st_) : st_; \
      pbc[i] = ld8(BC + ((size_t)b * SEQ + t_) * 512 + (cv_ < 16 ? 256 + gq * 128 + cv_ * 8 : gq * 128 + (cv_ - 16) * 8)); } } while (0)
#define MB_PREFETCH(c_) do { \
    { const int tb_ = dir ? (SEQ - 1 - ((c_) * 64 + tg * 2 + 1)) : ((c_) * 64 + tg * 2); \
      _Pragma("unroll") for (int j = 0; j < 4; ++j) { const int t_ = tb_ - 1 + j; px[j] = (t_ >= 0 && t_ < SEQ) ? ld8(raw + ((size_t)b * SEQ + t_) * 2592 + 1024 + xc) : (u32x4){0u, 0u, 0u, 0u}; } \
      pdt[0] = raw[((size_t)b * SEQ + tb_) * 2592 + 2560 + dir * 16 + head]; pdt[1] = raw[((size_t)b * SEQ + tb_ + 1) * 2592 + 2560 + dir * 16 + head]; } \
    if (tid < 64) { const int st_ = (c_) * 64 + tid, t_ = dir ? (SEQ - 1 - st_) : st_; pdts = raw[((size_t)b * SEQ + t_) * 2592 + 2560 + dir * 16 + head]; } } while (0)
  MB_PREFETCH(0);
  for (int c = 0; c < SEQ / 64; ++c) {
    u32x4 pbc[8];
    MB_LOADBC(c);
    { asm volatile("" ::: "memory");
      float cw0[8], cw1[8], cw2[8], cbv[8];
#pragma unroll
      for (int j = 0; j < 8; ++j) { cw0[j] = p.mb_conv_w[xc + j]; cw1[j] = p.mb_conv_w[1536 + xc + j]; cw2[j] = p.mb_conv_w[3072 + xc + j]; cbv[j] = p.mb_conv_b[xc + j]; }
      float R[4][8];
#pragma unroll
      for (int j = 0; j < 4; ++j) unpack8(px[j], R[j]);
#pragma unroll
      for (int i = 0; i < 2; ++i) {
        const int pi = dir ? (1 - i) : i;
        const float dt = softplusf_(bf2f(pdt[dir ? (1 - i) : i]) + dtb);
        float o[8];
#pragma unroll
        for (int j = 0; j < 8; ++j) o[j] = dt * siluf_(cbv[j] + cw0[j] * R[pi][j] + cw1[j] * R[pi + 1][j] + cw2[j] * R[pi + 2][j]);
        *(u32x4*)(G.Vs() + (tg * 2 + i) * G.VP + cvi * 8) = pack8(o);
      } }
    if (tid < 64) {
      const int s = tid;
      const float dt = softplusf_(bf2f(pdts) + dtb);
      const float cs = wave_incl_sum(dt * Aneg, s); const float csl = __shfl(cs, 63);
      G.P()[s] = cs; G.Qv()[s] = cs; G.I()[s] = cs; G.Wl()[s] = csl - cs; if (s == 0) G.gl()[0] = csl;
    }
#pragma unroll
    for (int i = 0; i < 8; ++i) { const int v = tid + i * 256, s = v >> 5, cv = v & 31; *(u32x4*)((cv < 16 ? G.Qs() : G.Ks()) + s * G.QP + (cv & 15) * 8) = pbc[i]; }
    if (c + 1 < SEQ / 64) MB_PREFETCH(c + 1);
    __syncthreads();
    f32x4 y[4];
    G.compute_y(y);
#pragma unroll
    for (int vb = 0; vb < 4; ++vb)
#pragma unroll
      for (int j = 0; j < 4; ++j) { const int s = G.w * 16 + G.fq * 4 + j, st = c * 64 + s, t = dir ? (SEQ - 1 - st) : st; Y[((size_t)b * SEQ + t) * 1024 + head * 64 + vb * 16 + G.fr] = f2bf(y[vb][j]); }
    G.update();
  }
#undef MB_PREFETCH
#undef MB_LOADBC
}

DI void mlstm_item(const Params& p, int item, char* smem) {
  const int half = item & 1, head = (item >> 1) & 7, b = (item >> 4) & 15, dir = item >> 8;
  const int tid = threadIdx.x;
  Gla<80> G; G.init(smem);
  float* Wl_ = (float*)(smem + Gla<80>::BYTES);
  for (int i = tid; i < 128; i += 256) { const int ch = head * 128 + i; Wl_[i] = p.ml_conv_w[ch]; Wl_[128 + i] = p.ml_conv_w[1024 + ch]; Wl_[256 + i] = p.ml_conv_w[2048 + ch]; Wl_[384 + i] = p.ml_conv_b[ch]; }
  for (int i = tid; i < 512; i += 256) { Wl_[512 + i] = p.ml_wq[head * 512 + i]; Wl_[1024 + i] = p.ml_wk[head * 512 + i] * 0.08838834764831845f; Wl_[1536 + i] = p.ml_wv[head * 512 + i]; }
  if (tid < 64) { for (int j = 0; j < 16; ++j) G.Vs()[tid * G.VP + 64 + j] = (j == 0) ? (bf16_t)0x3f80 : (bf16_t)0; }
  const bf16_t* raw = (const bf16_t*)(p.ws + OFF_MLRAW);
  bf16_t* H = (bf16_t*)(p.ws + OFF_HFB) + (size_t)dir * NTOK * 1024;
  const float ib = p.ml_i_b[dir * 8 + head], fb = p.ml_f_b[dir * 8 + head];
  const int cvi = tid & 15, tg = tid >> 4, ch = head * 128 + cvi * 8;
  float mprev = 0.f;
  u32x4 px[6]; bf16_t pgi = 0, pgf = 0;
#define ML_PREFETCH(c_) do { const int tb_ = dir ? (SEQ - 1 - ((c_) * 64 + tg * 4 + 3)) : ((c_) * 64 + tg * 4); \
    _Pragma("unroll") for (int j = 0; j < 6; ++j) { const int t_ = tb_ - 1 + j; px[j] = (t_ >= 0 && t_ < SEQ) ? ld8(raw + ((size_t)b * SEQ + t_) * 2080 + ch) : (u32x4){0u, 0u, 0u, 0u}; } \
    if (tid < 64) { const int st_ = (c_) * 64 + tid, t_ = dir ? (SEQ - 1 - st_) : st_; const size_t tok_ = (size_t)b * SEQ + t_; pgi = raw[tok_ * 2080 + 2048 + dir * 8 + head]; pgf = raw[tok_ * 2080 + 2064 + dir * 8 + head]; } } while (0)
  ML_PREFETCH(0);
  __syncthreads();
  for (int c = 0; c < SEQ / 64; ++c) {
    {
#pragma unroll
      for (int i = 0; i < 4; ++i) {
        float prv[8], cur[8], nxt[8];
        { const u32x4 a = dir ? px[3 - i] : px[i], bq = dir ? px[4 - i] : px[i + 1], cq = dir ? px[5 - i] : px[i + 2]; unpack8(a, prv); unpack8(bq, cur); unpack8(cq, nxt); }
        float xcv[8], q[8], k[8], v[8];
#pragma unroll
        for (int j4 = 0; j4 < 2; ++j4) {
          const f32x4 w0 = *(const f32x4*)(Wl_ + cvi * 8 + j4 * 4), w1 = *(const f32x4*)(Wl_ + 128 + cvi * 8 + j4 * 4), w2 = *(const f32x4*)(Wl_ + 256 + cvi * 8 + j4 * 4), bb = *(const f32x4*)(Wl_ + 384 + cvi * 8 + j4 * 4);
#pragma unroll
          for (int j = 0; j < 4; ++j) xcv[j4 * 4 + j] = siluf_(bb[j] + w0[j] * prv[j4 * 4 + j] + w1[j] * cur[j4 * 4 + j] + w2[j] * nxt[j4 * 4 + j]);
        }
#pragma unroll
        for (int bl = 0; bl < 2; ++bl) {
          f32x4 aq = (f32x4){0.f, 0.f, 0.f, 0.f}, ak = aq, av = aq;
#pragma unroll
          for (int cc = 0; cc < 4; ++cc) {
            const int wi = (cvi * 2 + bl) * 16 + cc * 4;
            aq += *(const f32x4*)(Wl_ + 512 + wi) * xcv[bl * 4 + cc]; ak += *(const f32x4*)(Wl_ + 1024 + wi) * xcv[bl * 4 + cc]; av += *(const f32x4*)(Wl_ + 1536 + wi) * cur[bl * 4 + cc];
          }
#pragma unroll
          for (int d = 0; d < 4; ++d) { q[bl * 4 + d] = aq[d]; k[bl * 4 + d] = ak[d]; v[bl * 4 + d] = av[d]; }
        }
        const int s = tg * 4 + i;
        *(u32x4*)(G.Qs() + s * G.QP + cvi * 8) = pack8(q);
        *(u32x4*)(G.Ks() + s * G.QP + cvi * 8) = pack8(k);
        if ((cvi >> 3) == half) *(u32x4*)(G.Vs() + s * G.VP + (cvi & 7) * 8) = pack8(v);
        __builtin_amdgcn_sched_barrier(0);
      } }
    if (tid < 64) {
      const int s = tid;
      const float li = bf2f(pgi) + ib;
      const float fx = bf2f(pgf) + fb;
      const float lf = fminf(fx, 0.f) - log1pf(expf(-fabsf(fx)));
      const float bc = wave_incl_sum(lf, s);
      const float cc = li - bc;
      const float pm = fmaxf(wave_incl_max(cc, s), mprev);
      const float pml = __shfl(pm, 63), bl = __shfl(bc, 63);
      G.P()[s] = -pm; G.Qv()[s] = -cc; G.I()[s] = mprev - pm; G.Wl()[s] = cc - pml; G.Mt()[s] = bc + pm; if (s == 0) G.gl()[0] = mprev - pml;
      mprev = bl + pml;
    }
    if (c + 1 < SEQ / 64) ML_PREFETCH(c + 1);
    __syncthreads();
    f32x4 y[5];
    G.compute_y(y);
#pragma unroll
    for (int j = 0; j < 4; ++j) {
      const float den = __shfl(y[4][j], G.lane & 48);
      const int s = G.w * 16 + G.fq * 4 + j, st = c * 64 + s, t = dir ? (SEQ - 1 - st) : st;
      const float dn = 1.0f / fmaxf(fabsf(den), __expf(-G.Mt()[s]));
#pragma unroll
      for (int vb = 0; vb < 4; ++vb) H[((size_t)b * SEQ + t) * 1024 + head * 128 + half * 64 + vb * 16 + G.fr] = f2bf(y[vb][j] * dn);
    }
    G.update();
  }
#undef ML_PREFETCH
}

DI void s5_item(const Params& p, int item, char* smem) {
  constexpr int T = 32, XP = 136;
  const int dir = item >> 7, b = (item >> 3) & 15, gq = item & 7;
  const int tid = threadIdx.x, lane = tid & 63, wave = tid >> 6, fr = lane & 15, fq = lane >> 4;
  const int g = gq * 4 + wave;
  float* Uw = (float*)smem + wave * (T * 16);
  bf16_t* Xw = (bf16_t*)(smem + 4 * T * 16 * 4) + wave * (T * XP);
  const bf16_t* U = (const bf16_t*)(p.ws + OFF_S5U);
  bf16_t* Y = (bf16_t*)(p.ws + OFF_S5Y) + (size_t)dir * NTOK * 512;
  const float dtv = expf(p.s5_log_dt[dir * 32 + g]);
  const float ar = fminf(p.s5_A_re[(dir * 32 + g) * 64 + lane], -1e-4f), ai = p.s5_A_im[(dir * 32 + g) * 64 + lane];
  const float mag = expf(dtv * ar), abr = mag * cosf(dtv * ai), abi = mag * sinf(dtv * ai);
  const float den = ar * ar + ai * ai;
  const float f_r = ((abr - 1.0f) * ar + abi * ai) / den, f_i = (abi * ar - (abr - 1.0f) * ai) / den;
  float bbr[16], bbi[16];
#pragma unroll
  for (int m = 0; m < 16; ++m) { const float br = p.s5_B_re[(g * 64 + lane) * 16 + m], bi = p.s5_B_im[(g * 64 + lane) * 16 + m]; bbr[m] = f_r * br - f_i * bi; bbi[m] = f_r * bi + f_i * br; }
  bf16x8 cf[4];
#pragma unroll
  for (int ks = 0; ks < 4; ++ks)
#pragma unroll
    for (int jj = 0; jj < 8; ++jj) { const int k = ks * 32 + fq * 8 + jj; const size_t base = ((size_t)(dir * 32 + g) * 16 + fr) * 64;
      cf[ks][jj] = (short)f2bf(k < 64 ? p.s5_C_re[base + k] : -p.s5_C_im[base + k - 64]); }
  float xr = 0.f, xi = 0.f;
  u32x4 pu;
#define S5_PREFETCH(c0_) do { const int s_ = lane >> 1, st_ = (c0_) + s_, t_ = dir ? (SEQ - 1 - st_) : st_; pu = ld8(U + ((size_t)b * SEQ + t_) * 512 + g * 16 + (lane & 1) * 8); } while (0)
  S5_PREFETCH(0);
  for (int c0 = 0; c0 < SEQ; c0 += T) {
    __syncthreads();
    { float uf[8]; unpack8(pu, uf); float* d = Uw + (lane >> 1) * 16 + (lane & 1) * 8; *(f32x4*)d = (f32x4){uf[0], uf[1], uf[2], uf[3]}; *(f32x4*)(d + 4) = (f32x4){uf[4], uf[5], uf[6], uf[7]}; }
    __syncthreads();
    if (c0 + T < SEQ) S5_PREFETCH(c0 + T);
#pragma unroll 4
    for (int s = 0; s < T; ++s) {
      float bur = 0.f, bui = 0.f;
#pragma unroll
      for (int m4 = 0; m4 < 4; ++m4) { const f32x4 uv = *(const f32x4*)(Uw + s * 16 + m4 * 4);
#pragma unroll
        for (int j = 0; j < 4; ++j) { bur += bbr[m4 * 4 + j] * uv[j]; bui += bbi[m4 * 4 + j] * uv[j]; } }
      const float nr = abr * xr - abi * xi + bur, ni = abr * xi + abi * xr + bui;
      xr = nr; xi = ni;
      Xw[s * XP + lane] = f2bf(xr); Xw[s * XP + 64 + lane] = f2bf(xi);
    }
    __syncthreads();
#pragma unroll
    for (int mb = 0; mb < 2; ++mb) {
      f32x4 y = (f32x4){0.f, 0.f, 0.f, 0.f};
#pragma unroll
      for (int ks = 0; ks < 4; ++ks) { const bf16x8 xa = *(const bf16x8*)(Xw + (mb * 16 + fr) * XP + ks * 32 + fq * 8); y = MFMA16(xa, cf[ks], y); }
#pragma unroll
      for (int j = 0; j < 4; ++j) { const int s = mb * 16 + fq * 4 + j, st = c0 + s, t = dir ? (SEQ - 1 - st) : st; Y[((size_t)b * SEQ + t) * 512 + g * 16 + fr] = f2bf(y[j]); }
    }
  }
#undef S5_PREFETCH
}

DI void phase_post0(const Params& p) {
  const int lane = threadIdx.x & 63, wid = threadIdx.x >> 6;
  const int gw = blockIdx.x * 4 + wid, nw = gridDim.x * 4;
  {
    bf16_t* E0 = (bf16_t*)(p.ws + OFF_R1); const bf16_t* E1 = E0 + (size_t)NTOK * 512; const bf16_t* Ab = E1 + (size_t)NTOK * 512;
    const bf16_t* G = (const bf16_t*)(p.ws + OFF_XN); const bf16_t* RKV = (const bf16_t*)(p.ws + OFF_RKV);
    for (int u = gw; u < NTOK * 8; u += nw) {
      const int tok = u >> 3, h = u & 7, c = h * 64 + lane;
      const float y = bf2f(E0[(size_t)tok * 512 + c]) + bf2f(E1[(size_t)tok * 512 + c]);
      const float mean = wave_sum(y) * (1.0f / 64.0f); const float d = y - mean; const float var = wave_sum(d * d) * (1.0f / 64.0f);
      const float yn = d * rsqrtf(var + 64e-5f) * p.rw_ln_w[c];
      const float r = bf2f(RKV[(size_t)tok * 1536 + c]), k = bf2f(RKV[(size_t)tok * 1536 + 512 + c]), v = bf2f(RKV[(size_t)tok * 1536 + 1024 + c]);
      const float a = bf2f(Ab[(size_t)tok * 512 + c]);
      const float k2 = k * (1.0f + (a - 1.0f) * p.rw_k_a[c]);
      const float bonus = wave_sum(r * k2 * p.rw_r_k[c]) * v;
      E0[(size_t)tok * 512 + c] = f2bf((yn + bonus) * bf2f(G[(size_t)tok * 512 + c]));
    }
  }
  {
    bf16_t* raw = (bf16_t*)(p.ws + OFF_R2);
    const bf16_t* Y0 = (const bf16_t*)p.out; const bf16_t* Y1 = Y0 + (size_t)NTOK * 1024;
    const float* cw = p.mb_conv_w; const float* cb = p.mb_conv_b;
    for (int u = gw; u < NTOK * 2; u += nw) {
      const int tok = u >> 1, gq = u & 1, col = gq * 512 + lane * 8, head = col >> 6, t = tok & (SEQ - 1);
      float y0[8], y1[8], z[8], cur[8], prv[8], nxt[8], o[8];
      unpack8(ld8(Y0 + (size_t)tok * 1024 + col), y0); unpack8(ld8(Y1 + (size_t)tok * 1024 + col), y1);
      bf16_t* zp = raw + (size_t)tok * 2592 + col;
      unpack8(ld8(zp), z);
      const bf16_t* rp = zp + 1024;
      unpack8(ld8(rp), cur);
      if (t > 0) unpack8(ld8(rp - 2592), prv); else for (int j = 0; j < 8; ++j) prv[j] = 0.f;
      if (t < SEQ - 1) unpack8(ld8(rp + 2592), nxt); else for (int j = 0; j < 8; ++j) nxt[j] = 0.f;
      const float D = p.mb_D[head];
      float ss = 0.f;
#pragma unroll
      for (int j = 0; j < 8; ++j) { const float xs = siluf_(cb[col + j] + cw[col + j] * prv[j] + cw[1536 + col + j] * cur[j] + cw[3072 + col + j] * nxt[j]);
        const float yy = (y0[j] + y1[j] + D * xs) * siluf_(z[j]); o[j] = yy; ss += yy * yy; }
      ss = wave_sum(ss);
      const float rs = rsqrtf(ss * (1.0f / 512.0f) + 1e-5f);
#pragma unroll
      for (int j = 0; j < 8; ++j) o[j] = o[j] * rs * p.mb_norm_w[col + j];
      *(u32x4*)zp = pack8(o);
    }
  }
}

DI float gelu_tanh(float x) { const float u = 0.7978845608028654f * (x + 0.044715f * x * x * x); return 0.5f * x * (1.0f + tanhf(u)); }

DI void phase_post1(const Params& p) {
  const int lane = threadIdx.x & 63, wid = threadIdx.x >> 6;
  const int gw = blockIdx.x * 4 + wid, nw = gridDim.x * 4;
  {
    const bf16_t* U = (const bf16_t*)(p.ws + OFF_S5U); const bf16_t* Y0 = (const bf16_t*)(p.ws + OFF_S5Y); const bf16_t* Y1 = Y0 + (size_t)NTOK * 512;
    bf16_t* YG = (bf16_t*)(p.ws + OFF_YG);
    for (int tok = gw; tok < NTOK; tok += nw) {
      const int col = lane * 8; float u[8], a[8], c[8], o[8];
      unpack8(ld8(U + (size_t)tok * 512 + col), u); unpack8(ld8(Y0 + (size_t)tok * 512 + col), a); unpack8(ld8(Y1 + (size_t)tok * 512 + col), c);
#pragma unroll
      for (int j = 0; j < 8; ++j) o[j] = gelu_tanh(p.s5_D[col + j] * u[j] + a[j] + c[j]);
      *(u32x4*)(YG + (size_t)tok * 512 + col) = pack8(o);
    }
  }
  {
    bf16_t* raw = (bf16_t*)(p.ws + OFF_MLRAW);
    const bf16_t* HF = (const bf16_t*)(p.ws + OFF_HFB); const bf16_t* HB = HF + (size_t)NTOK * 1024;
    for (int u = gw; u < NTOK * 8; u += nw) {
      const int tok = u >> 3, head = u & 7, c = head * 128 + lane * 2, t = tok & (SEQ - 1);
      const unsigned hf = *(const unsigned*)(HF + (size_t)tok * 1024 + c), hb = *(const unsigned*)(HB + (size_t)tok * 1024 + c);
      const float h0 = __uint_as_float(hf << 16) + __uint_as_float(hb << 16), h1 = __uint_as_float(hf & 0xffff0000u) + __uint_as_float(hb & 0xffff0000u);
      const float mean = wave_sum(h0 + h1) * (1.0f / 128.0f);
      const float d0 = h0 - mean, d1 = h1 - mean;
      const float var = wave_sum(d0 * d0 + d1 * d1) * (1.0f / 128.0f);
      const float rs = rsqrtf(var + 1e-5f);
      bf16_t* xp = raw + (size_t)tok * 2080 + c;
      const unsigned xc_ = *(const unsigned*)xp;
      const unsigned xp_ = t > 0 ? *(const unsigned*)(xp - 2080) : 0u, xn_ = t < SEQ - 1 ? *(const unsigned*)(xp + 2080) : 0u;
      const unsigned ov = *(const unsigned*)(xp + 1024);
      float o[2];
#pragma unroll
      for (int j = 0; j < 2; ++j) {
        const float cur = j ? __uint_as_float(xc_ & 0xffff0000u) : __uint_as_float(xc_ << 16);
        const float prv = j ? __uint_as_float(xp_ & 0xffff0000u) : __uint_as_float(xp_ << 16);
        const float nxt = j ? __uint_as_float(xn_ & 0xffff0000u) : __uint_as_float(xn_ << 16);
        const float og = j ? __uint_as_float(ov & 0xffff0000u) : __uint_as_float(ov << 16);
        const float xcv = siluf_(p.ml_conv_b[c + j] + p.ml_conv_w[c + j] * prv + p.ml_conv_w[1024 + c + j] * cur + p.ml_conv_w[2048 + c + j] * nxt);
        const float hn = (j ? d1 : d0) * rs * p.ml_norm_w[c + j];
        o[j] = sigmoidf_(og) * hn + p.ml_skip[c + j] * xcv;
      }
      *(unsigned*)(xp + 1024) = pack2(o[0], o[1]);
    }
  }
}

DI void phase_final(const Params& p) {
  const int lane = threadIdx.x & 63, wid = threadIdx.x >> 6;
  for (int u = blockIdx.x; u < NTOK / 4; u += gridDim.x) {
    float* xr = p.out + (size_t)(u * 4 + wid) * 1024;
    f32x4 v[4]; float ss = 0.f;
#pragma unroll
    for (int i = 0; i < 4; ++i) { v[i] = *(const f32x4*)(xr + i * 256 + lane * 4); ss += v[i][0] * v[i][0] + v[i][1] * v[i][1] + v[i][2] * v[i][2] + v[i][3] * v[i][3]; }
    ss = wave_sum(ss);
    const float rs = rsqrtf(ss * (1.0f / 1024.0f) + 1e-5f);
#pragma unroll
    for (int i = 0; i < 4; ++i) { const f32x4 g = *(const f32x4*)(p.norm_final + i * 256 + lane * 4); *(f32x4*)(xr + i * 256 + lane * 4) = v[i] * rs * g; }
  }
}

constexpr int NPHASE = 20;
#ifdef NO_RW
#define RWK(x)
#else
#define RWK(x) x
#endif
#ifdef NO_MB
#define MBK(x)
#else
#define MBK(x) x
#endif
#ifndef ONLY_PHASE
#define ONLY_PHASE -1
#endif
#define PH(k) case k: if (ONLY_PHASE >= 0 && ONLY_PHASE != k) break;
template <int ph> DI void run_phase(const Params& p, char* smem) {
  char* ws = p.ws;
  bf16_t* XN = (bf16_t*)(ws + OFF_XN);
  switch (ph) {
    PH(0) phase_prep(p, smem); break;
    PH(1) gemm_phase(smem, XN, 1024, 1 << 30, XN, 1024, (const bf16_t*)(ws + OFF_WABIN), 1024, 35,
                       EpiSplit{(bf16_t*)(ws + OFF_R1), 1792, 1792, (bf16_t*)(ws + OFF_R2), 2592, 2592}); break;
    PH(2) phase_rw_shift(p); break;
    PH(3) phase_rw_small_gemms(p, smem); break;
    PH(4) {
      const int G = gridDim.x, bx = blockIdx.x;
      if (G >= 512) { if (bx < 256) { RWK(rwkv_item(p, bx, smem);) } else for (int u = bx - 256; u < 512; u += G - 256) { MBK(mamba_item(p, u, smem);) } }
      else { for (int u = bx; u < 256; u += G) { RWK(rwkv_item(p, u, smem);) } __syncthreads(); for (int u = bx + ((256 - bx + G - 1) / G) * G; u < 768; u += G) { MBK(mamba_item(p, u - 256, smem);) } }
    } break;
    PH(5) phase_post0(p); break;
    PH(6) gemm_phase(smem, (const bf16_t*)(ws + OFF_R1), 512, 512, (const bf16_t*)(ws + OFF_R2), 2592, (const bf16_t*)(ws + OFF_WABOUT), 1536, 8, EpiResid{p.x, p.out}); break;
    PH(7) phase_rmsnorm(p, p.out, p.norm_mlp); break;
    PH(8) gemm_phase(smem, XN, 1024, 1 << 30, XN, 1024, (const bf16_t*)(ws + OFF_W1), 1024, 32, EpiRelu2{(bf16_t*)(ws + OFF_R1)}); break;
    PH(9) gemm_phase(smem, (const bf16_t*)(ws + OFF_R1), 4096, 1 << 30, XN, 1024, (const bf16_t*)(ws + OFF_W2), 4096, 8, EpiResid{p.out, p.out}); break;
    PH(10) phase_rmsnorm(p, p.out, p.norm_mix + 1024); break;
    PH(11) gemm_phase(smem, XN, 1024, 1 << 30, XN, 1024, (const bf16_t*)(ws + OFF_WCDIN), 1024, 21,
                        EpiSplit{(bf16_t*)(ws + OFF_S5U), 512, 512, (bf16_t*)(ws + OFF_MLRAW), 2080, 2080}); break;
    PH(12) {
      const int G = gridDim.x, bx = blockIdx.x;
      for (int u = bx; u < 512; u += G) mlstm_item(p, u, smem);
      __syncthreads();
      { int u0 = bx + ((512 - bx + G - 1) / G) * G; for (int u = u0; u < 768; u += G) s5_item(p, u - 512, smem); }
    } break;
    PH(13) phase_post1(p); break;
    PH(14) gemm_phase(smem, (const bf16_t*)(ws + OFF_YG), 512, 1 << 30, XN, 1024, (const bf16_t*)(ws + OFF_WGLU), 512, 4,
                        EpiGlu{(const bf16_t*)(ws + OFF_YG), p.s5_glu_b, (bf16_t*)(ws + OFF_S5Y)}); break;
    PH(15) gemm_phase(smem, (const bf16_t*)(ws + OFF_S5Y), 512, 512, (const bf16_t*)(ws + OFF_MLRAW) + 1024, 2080, (const bf16_t*)(ws + OFF_WCDOUT), 1536, 8, EpiResid{p.out, p.out}); break;
    PH(16) phase_rmsnorm(p, p.out, p.norm_mlp + 1024); break;
    PH(17) gemm_phase(smem, XN, 1024, 1 << 30, XN, 1024, (const bf16_t*)(ws + OFF_W1) + 4096ull * 1024, 1024, 32, EpiRelu2{(bf16_t*)(ws + OFF_R1)}); break;
    PH(18) gemm_phase(smem, (const bf16_t*)(ws + OFF_R1), 4096, 1 << 30, XN, 1024, (const bf16_t*)(ws + OFF_W2) + 4096ull * 1024, 4096, 8, EpiResid{p.out, p.out}); break;
    PH(19) phase_final(p); break;
    default: break;
  }
}

template <int PHI> DI void run_from(const Params& p, char* smem, int ph0, int ph1) {
  if constexpr (PHI < NPHASE) {
    if (ph0 <= PHI && PHI < ph1) {
      run_phase<PHI>(p, smem);
#ifdef PROBE_DUP_MASK
      if ((PROBE_DUP_MASK >> PHI) & 1) { __syncthreads(); cg::this_grid().sync(); run_phase<PHI>(p, smem); }
#endif
      if (PHI + 1 < ph1) { __syncthreads(); cg::this_grid().sync(); }
    }
    run_from<PHI + 1>(p, smem, ph0, ph1);
  }
}

__global__ void __launch_bounds__(256, 2) mega(Params p, int ph0, int ph1) {
  extern __shared__ __attribute__((aligned(16))) char smem[];
  run_from<0>(p, smem, ph0, ph1);
}

#ifndef ONE_LAUNCH
#define ONE_LAUNCH 1
#endif

extern "C" void kernel_launch(void* const* d_in, const int* in_sizes, int n_in, void* d_out, int out_size, void* d_ws, size_t ws_size,
                              hipStream_t stream) {
  static int grid_blocks = 0;
  if (!grid_blocks) {
    hipFuncSetAttribute((const void*)mega, hipFuncAttributeMaxDynamicSharedMemorySize, LDS_BYTES);
    int dev = 0, cus = 0, per_cu = 0;
    hipGetDevice(&dev);
    hipDeviceGetAttribute(&cus, hipDeviceAttributeMultiprocessorCount, dev);
    hipOccupancyMaxActiveBlocksPerMultiprocessor(&per_cu, mega, 256, LDS_BYTES);
    if (per_cu > 2) per_cu = 2;
    if (per_cu < 1) per_cu = 1;
    grid_blocks = cus * per_cu;
  }
  Params p{};
  const float** pf = (const float**)&p;
  for (int i = 0; i < 45; ++i) pf[i] = (const float*)d_in[i];
  p.out = (float*)d_out;
  p.ws = (char*)d_ws;
#if ONE_LAUNCH
  int ph0 = 0, ph1 = NPHASE;
  void* args[] = {&p, &ph0, &ph1};
  hipError_t e = hipLaunchCooperativeKernel((const void*)mega, dim3(grid_blocks), dim3(256), args, LDS_BYTES, stream);
  if (e != hipSuccess) fprintf(stderr, "cooperative launch failed: %s (grid %d)\n", hipGetErrorString(e), grid_blocks);
#else
  for (int ph = 0; ph < NPHASE; ++ph) hipLaunchKernelGGL(mega, dim3(grid_blocks), dim3(256), LDS_BYTES, stream, p, ph, ph + 1);
#endif
}
```

```cpp
#include <hip/hip_runtime.h>
#include <hip/hip_cooperative_groups.h>
#include <stdint.h>
#include <cstdio>
namespace cg = cooperative_groups;

typedef unsigned short bf16_t;
typedef short bf16x8 __attribute__((ext_vector_type(8)));
typedef float f32x4 __attribute__((ext_vector_type(4)));
typedef unsigned u32x4 __attribute__((ext_vector_type(4)));
typedef unsigned u32x2 __attribute__((ext_vector_type(2)));

#define DI __device__ __forceinline__
#define LANEID() ((int)__builtin_amdgcn_mbcnt_hi(~0u, __builtin_amdgcn_mbcnt_lo(~0u, 0u)))
#define TIDX (p.wid * 64 + LANEID())
#define MFMA16(a, b, c) __builtin_amdgcn_mfma_f32_16x16x32_bf16((a), (b), (c), 0, 0, 0)

constexpr int NTOK = 32768, SEQ = 2048;
constexpr size_t MiB = 1ull << 20;
constexpr size_t OFF_WABIN = 0;
constexpr size_t OFF_WABOUT = OFF_WABIN + 4480ull * 1024 * 2;
constexpr size_t OFF_W1 = OFF_WABOUT + 1024ull * 1536 * 2;
constexpr size_t OFF_W2 = OFF_W1 + 2ull * 4096 * 1024 * 2;
constexpr size_t OFF_WCDIN = OFF_W2 + 2ull * 4096 * 1024 * 2;
constexpr size_t OFF_WCDOUT = OFF_WCDIN + 2688ull * 1024 * 2;
constexpr size_t OFF_WGLU = OFF_WCDOUT + 1024ull * 1536 * 2;
constexpr size_t OFF_WG2 = OFF_WGLU + 512ull * 512 * 2;
constexpr size_t OFF_WW2 = OFF_WG2 + 512ull * 128 * 2;
constexpr size_t OFF_WA2 = OFF_WW2 + 2ull * 512 * 64 * 2;
constexpr size_t OFF_WEND = OFF_WA2 + 512ull * 64 * 2;
static_assert(OFF_WEND <= 56 * MiB, "weights region");
constexpr size_t OFF_XN = 56 * MiB;
constexpr size_t OFF_R1 = 120 * MiB;
constexpr size_t OFF_R2 = 232 * MiB;
constexpr size_t OFF_RKV = 394 * MiB;
constexpr size_t OFF_SM = 490 * MiB;
constexpr size_t OFF_S5U = 120 * MiB;
constexpr size_t OFF_MLRAW = 152 * MiB;
constexpr size_t OFF_S5Y = 282 * MiB;
constexpr size_t OFF_HFB = 346 * MiB;
constexpr size_t OFF_YG = 474 * MiB;
constexpr size_t OFF_BAR = 510 * MiB;
constexpr int LDS_BYTES = 79872;

struct Params {
  const float *x, *norm_mix, *norm_mlp, *norm_final, *mlp_w1, *mlp_w2, *ab_w_in, *ab_w_out, *rw_mu, *rw_w0, *rw_w2, *rw_a0,
      *rw_a2, *rw_g2, *rw_k_k, *rw_k_a, *rw_r_k, *rw_ln_w, *mb_conv_w, *mb_conv_b, *mb_dt_bias, *mb_A_log, *mb_D, *mb_norm_w,
      *cd_w_in, *cd_w_out, *s5_A_re, *s5_A_im, *s5_log_dt, *s5_B_re, *s5_B_im, *s5_C_re, *s5_C_im, *s5_D, *s5_glu_w, *s5_glu_b,
      *ml_conv_w, *ml_conv_b, *ml_wq, *ml_wk, *ml_wv, *ml_i_b, *ml_f_b, *ml_norm_w, *ml_skip;
  float* out;
  char* ws;
  int wid;
  int pad_;
};

DI float bf2f(bf16_t v) { return __uint_as_float(((unsigned)v) << 16); }
DI bf16_t f2bf(float x) { unsigned u = __float_as_uint(x); u += 0x7fffu + ((u >> 16) & 1u); return (bf16_t)(u >> 16); }
DI unsigned pack2(float lo, float hi) { return (unsigned)f2bf(lo) | ((unsigned)f2bf(hi) << 16); }
DI void unpack8(u32x4 w, float* f) {
#pragma unroll
  for (int i = 0; i < 4; ++i) { f[2 * i] = __uint_as_float(w[i] << 16); f[2 * i + 1] = __uint_as_float(w[i] & 0xffff0000u); }
}
DI u32x4 pack8(const float* f) { u32x4 w; w.x = pack2(f[0], f[1]); w.y = pack2(f[2], f[3]); w.z = pack2(f[4], f[5]); w.w = pack2(f[6], f[7]); return w; }
DI u32x4 ld8(const bf16_t* p) { return *(const u32x4*)p; }
DI float wave_sum(float v) {
#pragma unroll
  for (int o = 32; o > 0; o >>= 1) v += __shfl_xor(v, o);
  return v;
}
DI float sigmoidf_(float x) { return 1.0f / (1.0f + __expf(-x)); }
DI float siluf_(float x) { return x / (1.0f + __expf(-x)); }
DI float softplusf_(float x) { return x > 20.f ? x : log1pf(expf(x)); }
DI float wave_incl_sum(float v, int lane) {
#pragma unroll
  for (int o = 1; o < 64; o <<= 1) { float t = __shfl_up(v, o); if (lane >= o) v += t; }
  return v;
}
DI float wave_incl_max(float v, int lane) {
#pragma unroll
  for (int o = 1; o < 64; o <<= 1) { float t = __shfl_up(v, o); if (lane >= o) v = fmaxf(v, t); }
  return v;
}

DI bool get_tdesc(const Params& p, int i, const float*& src, bf16_t*& dst, int& K, int& Nsrc, int& Npad) {
  char* ws = p.ws;
  switch (i) {
    case 0: src = p.ab_w_in; dst = (bf16_t*)(ws + OFF_WABIN); K = 1024; Nsrc = 4384; Npad = 4480; return true;
    case 1: src = p.ab_w_out; dst = (bf16_t*)(ws + OFF_WABOUT); K = 1536; Nsrc = 1024; Npad = 1024; return true;
    case 2: src = p.mlp_w1; dst = (bf16_t*)(ws + OFF_W1); K = 1024; Nsrc = 4096; Npad = 4096; return true;
    case 3: src = p.mlp_w1 + 1024ull * 4096; dst = (bf16_t*)(ws + OFF_W1) + 4096ull * 1024; K = 1024; Nsrc = 4096; Npad = 4096; return true;
    case 4: src = p.mlp_w2; dst = (bf16_t*)(ws + OFF_W2); K = 4096; Nsrc = 1024; Npad = 1024; return true;
    case 5: src = p.mlp_w2 + 4096ull * 1024; dst = (bf16_t*)(ws + OFF_W2) + 4096ull * 1024; K = 4096; Nsrc = 1024; Npad = 1024; return true;
    case 6: src = p.cd_w_in; dst = (bf16_t*)(ws + OFF_WCDIN); K = 1024; Nsrc = 2592; Npad = 2688; return true;
    case 7: src = p.cd_w_out; dst = (bf16_t*)(ws + OFF_WCDOUT); K = 1536; Nsrc = 1024; Npad = 1024; return true;
    case 8: src = p.s5_glu_w; dst = (bf16_t*)(ws + OFF_WGLU); K = 512; Nsrc = 512; Npad = 512; return true;
    case 9: src = p.rw_g2; dst = (bf16_t*)(ws + OFF_WG2); K = 128; Nsrc = 512; Npad = 512; return true;
    case 10: src = p.rw_w2; dst = (bf16_t*)(ws + OFF_WW2); K = 64; Nsrc = 512; Npad = 512; return true;
    case 11: src = p.rw_w2 + 64 * 512; dst = (bf16_t*)(ws + OFF_WW2) + 512 * 64; K = 64; Nsrc = 512; Npad = 512; return true;
    case 12: src = p.rw_a2; dst = (bf16_t*)(ws + OFF_WA2); K = 64; Nsrc = 512; Npad = 512; return true;
    default: return false;
  }
}

DI void rmsnorm_row_to_bf16(const float* __restrict__ xr, const float* __restrict__ w, bf16_t* __restrict__ o, int lane) {
  f32x4 v[4]; float ss = 0.f;
#pragma unroll
  for (int i = 0; i < 4; ++i) { v[i] = *(const f32x4*)(xr + i * 256 + lane * 4); ss += v[i][0] * v[i][0] + v[i][1] * v[i][1] + v[i][2] * v[i][2] + v[i][3] * v[i][3]; }
  ss = wave_sum(ss);
  const float rs = rsqrtf(ss * (1.0f / 1024.0f) + 1e-5f);
#pragma unroll
  for (int i = 0; i < 4; ++i) { const f32x4 g = *(const f32x4*)(w + i * 256 + lane * 4); u32x2 q; q.x = pack2(v[i][0] * rs * g[0], v[i][1] * rs * g[1]); q.y = pack2(v[i][2] * rs * g[2], v[i][3] * rs * g[3]); *(u32x2*)(o + i * 256 + lane * 4) = q; }
}

DI void phase_rmsnorm(const Params& p, const float* src, const float* w) {
  bf16_t* xn = (bf16_t*)(p.ws + OFF_XN);
  const int lane = TIDX & 63, wid = TIDX >> 6;
  for (int u = blockIdx.x; u < NTOK / 4; u += gridDim.x) { const int row = u * 4 + wid; rmsnorm_row_to_bf16(src + (size_t)row * 1024, w, xn + (size_t)row * 1024, lane); }
}

DI void phase_prep(const Params& p, char* smem) {
  if (blockIdx.x == 0 && TIDX == 0) __hip_atomic_store((unsigned*)(p.ws + OFF_BAR), 0u, __ATOMIC_RELAXED, __HIP_MEMORY_SCOPE_AGENT);
  float* tile = (float*)smem;
  const int tid = TIDX;
  int ntr = 0;
  for (int i = 0; i < 13; ++i) { const float* s; bf16_t* d; int K, Ns, Np; get_tdesc(p, i, s, d, K, Ns, Np); ntr += (K / 64) * (Np / 64); }
  for (int u = blockIdx.x; u < ntr; u += gridDim.x) {
    const float* src = nullptr; bf16_t* dst = nullptr; int K = 64, Ns = 0, Np = 64, r = u;
    for (int mi = 0; mi < 13; ++mi) { get_tdesc(p, mi, src, dst, K, Ns, Np); const int nt = (K / 64) * (Np / 64); if (r < nt) break; r -= nt; }
    const int nkb = K / 64, kb = r % nkb, nb = r / nkb;
    __syncthreads();
#pragma unroll
    for (int i = 0; i < 16; ++i) { const int k = i * 4 + (tid >> 6), n = tid & 63; const int gn = nb * 64 + n; tile[k * 65 + n] = gn < Ns ? src[(size_t)(kb * 64 + k) * Ns + gn] : 0.f; }
    __syncthreads();
    const int n = tid >> 2, ks = (tid & 3) * 16; float f[16];
#pragma unroll
    for (int j = 0; j < 16; ++j) f[j] = tile[(ks + j) * 65 + n];
    bf16_t* o = dst + (size_t)(nb * 64 + n) * K + kb * 64 + ks;
    *(u32x4*)o = pack8(f); *(u32x4*)(o + 8) = pack8(f + 8);
  }
  phase_rmsnorm(p, p.x, p.norm_mix);
}

template <class Epi>
DI void gemm_tile(char* smem, const bf16_t* __restrict__ A0, int lda0, int ksplit, const bf16_t* __restrict__ A1, int lda1,
                  const bf16_t* __restrict__ Bt, int K, int row0, int col0, const Epi& epi, int tid) {
  constexpr int BK = 32, PITCH = 40, BUF = (256 + 128) * PITCH;
  bf16_t* sbase = (bf16_t*)smem;
  const int lane = tid & 63, wid = tid >> 6, wr = wid >> 1, wc = wid & 1, fr = lane & 15, fq = lane >> 4;
  f32x4 acc[8][4];
#pragma unroll
  for (int m = 0; m < 8; ++m)
#pragma unroll
    for (int n = 0; n < 4; ++n) acc[m][n] = (f32x4){0.f, 0.f, 0.f, 0.f};
  u32x4 ra[2][4], rb[2][2];
  const int nk = K / BK;
  const int sr = tid >> 2, scv = tid & 3;
#define GLOAD(S, kt) do { const int k0_ = (kt) * BK; const bf16_t* Ab_; int lda_, kk_; \
    if (k0_ < ksplit) { Ab_ = A0; lda_ = lda0; kk_ = k0_; } else { Ab_ = A1; lda_ = lda1; kk_ = k0_ - ksplit; } \
    _Pragma("unroll") for (int i_ = 0; i_ < 4; ++i_) ra[S][i_] = *(const u32x4*)(Ab_ + (size_t)(row0 + sr + i_ * 64) * lda_ + kk_ + scv * 8); \
    _Pragma("unroll") for (int i_ = 0; i_ < 2; ++i_) rb[S][i_] = *(const u32x4*)(Bt + (size_t)(col0 + sr + i_ * 64) * K + k0_ + scv * 8); } while (0)
#define LWRITE(S, buf) do { bf16_t* sA_ = sbase + (buf) * BUF; bf16_t* sB_ = sA_ + 256 * PITCH; \
    _Pragma("unroll") for (int i_ = 0; i_ < 4; ++i_) *(u32x4*)(sA_ + (sr + i_ * 64) * PITCH + scv * 8) = ra[S][i_]; \
    _Pragma("unroll") for (int i_ = 0; i_ < 2; ++i_) *(u32x4*)(sB_ + (sr + i_ * 64) * PITCH + scv * 8) = rb[S][i_]; } while (0)
#define COMPUTE(buf) do { const bf16_t* sA_ = sbase + (buf) * BUF; const bf16_t* sB_ = sA_ + 256 * PITCH; \
    bf16x8 bfr[4]; \
    _Pragma("unroll") for (int n = 0; n < 4; ++n) bfr[n] = *(const bf16x8*)(sB_ + (wc * 64 + n * 16 + fr) * PITCH + fq * 8); \
    _Pragma("unroll") for (int m = 0; m < 8; ++m) { const bf16x8 af = *(const bf16x8*)(sA_ + (wr * 128 + m * 16 + fr) * PITCH + fq * 8); \
      _Pragma("unroll") for (int n = 0; n < 4; ++n) acc[m][n] = MFMA16(bfr[n], af, acc[m][n]); } } while (0)
  __syncthreads();
  {
    const int last = nk - 1;
    GLOAD(0, 0);
    __builtin_amdgcn_sched_barrier(0);
    GLOAD(1, 1);
    __builtin_amdgcn_sched_barrier(0);
    LWRITE(0, 0);
    __builtin_amdgcn_sched_barrier(0);
    GLOAD(0, (2 < last ? 2 : last));
    __builtin_amdgcn_sched_barrier(0);
    __syncthreads();
    for (int kt = 0; kt < nk; kt += 2) {
      LWRITE(1, 1);
      __builtin_amdgcn_sched_barrier(0);
      GLOAD(1, (kt + 3 < last ? kt + 3 : last));
      __builtin_amdgcn_sched_barrier(0);
      COMPUTE(0);
      __syncthreads();
      LWRITE(0, 0);
      __builtin_amdgcn_sched_barrier(0);
      GLOAD(0, (kt + 4 < last ? kt + 4 : last));
      __builtin_amdgcn_sched_barrier(0);
      COMPUTE(1);
      __syncthreads();
    }
  }
#undef GLOAD
#undef LWRITE
#undef COMPUTE
#pragma unroll
  for (int m = 0; m < 8; ++m)
#pragma unroll
    for (int n = 0; n < 4; ++n) epi(row0 + wr * 128 + m * 16 + fr, col0 + wc * 64 + n * 16 + fq * 4, acc[m][n]);
}

DI void st_bf16x4(bf16_t* o, f32x4 v) { u32x2 q; q.x = pack2(v[0], v[1]); q.y = pack2(v[2], v[3]); *(u32x2*)o = q; }

struct EpiSplit {
  bf16_t* o0; int ld0, n0; bf16_t* o1; int ld1, n1;
  DI void operator()(int row, int col, f32x4 v) const {
    if (col < n0) st_bf16x4(o0 + (size_t)row * ld0 + col, v);
    else { const int c = col - n0; if (c < n1) st_bf16x4(o1 + (size_t)row * ld1 + c, v); }
  }
};
struct EpiSmall { int mode; const float* b0; bf16_t* o;
  DI void operator()(int row, int col, f32x4 v) const { f32x4 r;
    if (mode == 2) r = v; else { for (int j = 0; j < 4; ++j) r[j] = sigmoidf_(b0[col + j] + v[j]); if (mode == 0) r *= 0.60653066f; }
    st_bf16x4(o + (size_t)row * 512 + col, r); } };
struct EpiStore { bf16_t* o; int ld;
  DI void operator()(int row, int col, f32x4 v) const { st_bf16x4(o + (size_t)row * ld + col, v); } };
struct EpiResid { const float* res; float* o;
  DI void operator()(int row, int col, f32x4 v) const { const f32x4 r = *(const f32x4*)(res + (size_t)row * 1024 + col); *(f32x4*)(o + (size_t)row * 1024 + col) = r + v; } };
struct EpiRelu2 { bf16_t* o;
  DI void operator()(int row, int col, f32x4 v) const { f32x4 r; for (int j = 0; j < 4; ++j) { const float t = fmaxf(v[j], 0.f); r[j] = t * t; } st_bf16x4(o + (size_t)row * 4096 + col, r); } };
struct EpiGlu { const bf16_t* y; const float* b; bf16_t* o;
  DI void operator()(int row, int col, f32x4 v) const { const u32x2 q = *(const u32x2*)(y + (size_t)row * 512 + col); f32x4 r;
    const float y0 = __uint_as_float(q.x << 16), y1 = __uint_as_float(q.x & 0xffff0000u), y2 = __uint_as_float(q.y << 16), y3 = __uint_as_float(q.y & 0xffff0000u);
    r[0] = y0 * sigmoidf_(v[0] + b[col]); r[1] = y1 * sigmoidf_(v[1] + b[col + 1]); r[2] = y2 * sigmoidf_(v[2] + b[col + 2]); r[3] = y3 * sigmoidf_(v[3] + b[col + 3]);
    st_bf16x4(o + (size_t)row * 512 + col, r); } };

template <class Epi>
DI void gemm_phase(char* smem, const bf16_t* A0, int lda0, int ksplit, const bf16_t* A1, int lda1, const bf16_t* Bt, int K, int nN, const Epi& epi, int tid) {
  const int G = gridDim.x;
  if ((G & 7) == 0) {
    const int x = blockIdx.x & 7, l = blockIdx.x >> 3, L = G >> 3, per = 8 * nN, tot = 2 * per;
    for (int q = l; q < tot; q += L) { const int rgl = q / per, rem = q % per, ct = rem >> 3, rt = (x * 2 + rgl) * 8 + (rem & 7);
      gemm_tile(smem, A0, lda0, ksplit, A1, lda1, Bt, K, rt * 256, ct * 128, epi, tid); }
  } else {
    const int ntiles = (NTOK / 256) * nN;
    for (int u = blockIdx.x; u < ntiles; u += G) { const int rt = u / nN, ct = u % nN; gemm_tile(smem, A0, lda0, ksplit, A1, lda1, Bt, K, rt * 256, ct * 128, epi, tid); }
  }
}

DI void phase_rw_shift(const Params& p) {
  const bf16_t* raw = (const bf16_t*)(p.ws + OFF_R1);
  bf16_t* rkv = (bf16_t*)(p.ws + OFF_RKV); bf16_t* sm = (bf16_t*)(p.ws + OFF_SM);
  const float* mu = p.rw_mu;
  const size_t total = (size_t)NTOK * 224;
  for (size_t i = (size_t)blockIdx.x * 256 + TIDX; i < total; i += (size_t)gridDim.x * 256) {
    const int tok = (int)(i / 224), cv = (int)(i % 224), c = cv * 8, s = tok & (SEQ - 1);
    const bf16_t* rp = raw + (size_t)tok * 1792 + c;
    float cur[8], prv[8], nxt[8], o[8];
    unpack8(ld8(rp), cur);
    if (s > 0) unpack8(ld8(rp - 1792), prv); else for (int j = 0; j < 8; ++j) prv[j] = 0.f;
    if (s < SEQ - 1) unpack8(ld8(rp + 1792), nxt); else for (int j = 0; j < 8; ++j) nxt[j] = 0.f;
#pragma unroll
    for (int j = 0; j < 8; ++j) o[j] = cur[j] + mu[c + j] * (prv[j] - cur[j]) + mu[1792 + c + j] * (nxt[j] - cur[j]);
    if (c < 1536) *(u32x4*)(rkv + (size_t)tok * 1536 + c) = pack8(o);
    else if (c < 1600) { for (int j = 0; j < 8; ++j) o[j] = tanhf(o[j]); *(u32x4*)(sm + (size_t)tok * 256 + (c - 1536)) = pack8(o); }
    else if (c < 1664) *(u32x4*)(sm + (size_t)tok * 256 + 64 + (c - 1600)) = pack8(o);
    else { for (int j = 0; j < 8; ++j) o[j] = sigmoidf_(o[j]); *(u32x4*)(sm + (size_t)tok * 256 + 128 + (c - 1664)) = pack8(o); }
  }
  const bf16_t* mraw = (const bf16_t*)(p.ws + OFF_R2); bf16_t* BC = (bf16_t*)(p.ws + OFF_XN + 32 * MiB);
  const float* cw = p.mb_conv_w; const float* cb = p.mb_conv_b;
  const size_t total2 = (size_t)NTOK * 64;
  for (size_t i = (size_t)blockIdx.x * 256 + TIDX; i < total2; i += (size_t)gridDim.x * 256) {
    const int tok = (int)(i >> 6), cv = (int)(i & 63), xc = 1024 + cv * 8, t = tok & (SEQ - 1);
    const bf16_t* rp = mraw + (size_t)tok * 2592 + 1024 + xc;
    float cur[8], prv[8], nxt[8], o[8];
    unpack8(ld8(rp), cur);
    if (t > 0) unpack8(ld8(rp - 2592), prv); else for (int j = 0; j < 8; ++j) prv[j] = 0.f;
    if (t < SEQ - 1) unpack8(ld8(rp + 2592), nxt); else for (int j = 0; j < 8; ++j) nxt[j] = 0.f;
#pragma unroll
    for (int j = 0; j < 8; ++j) o[j] = siluf_(cb[xc + j] + cw[xc + j] * prv[j] + cw[1536 + xc + j] * cur[j] + cw[3072 + xc + j] * nxt[j]);
    *(u32x4*)(BC + (size_t)tok * 512 + cv * 8) = pack8(o);
  }
}

DI void phase_rw_small_gemms(const Params& p, char* smem) {
  const int tid = TIDX;
  const bf16_t* sm = (const bf16_t*)(p.ws + OFF_SM);
  bf16_t* E0 = (bf16_t*)(p.ws + OFF_R1); bf16_t* E1 = E0 + (size_t)NTOK * 512; bf16_t* Ab = E1 + (size_t)NTOK * 512;
  bf16_t* G = (bf16_t*)(p.ws + OFF_XN);
  const bf16_t* W2 = (const bf16_t*)(p.ws + OFF_WW2); const bf16_t* A2 = (const bf16_t*)(p.ws + OFF_WA2); const bf16_t* G2 = (const bf16_t*)(p.ws + OFF_WG2);
  for (int u = blockIdx.x; u < 2048; u += gridDim.x) {
    const int prob = u >> 9, rem = u & 511, rt = rem >> 2, ct = rem & 3;
    const bf16_t* Ap = sm + (prob == 2 ? 64 : prob == 3 ? 128 : 0);
    const bf16_t* Bp = prob == 0 ? W2 : prob == 1 ? W2 + 512 * 64 : prob == 2 ? A2 : G2;
    const EpiSmall epi{prob < 2 ? 0 : prob == 2 ? 1 : 2, prob == 0 ? p.rw_w0 : prob == 1 ? p.rw_w0 + 512 : p.rw_a0, prob == 0 ? E0 : prob == 1 ? E1 : prob == 2 ? Ab : G};
    gemm_tile(smem, Ap, 256, 1 << 30, Ap, 256, Bp, prob == 3 ? 128 : 64, rt * 256, ct * 128, epi, tid);
  }
}

typedef float f32x2 __attribute__((ext_vector_type(2)));
DI void rwkv_item(const Params& p, int item, char* smem) {
  constexpr int T = 32;
  const int dir = item >> 7, b = (item >> 3) & 15, h = item & 7;
  const int tid = TIDX, lane = tid & 63, wave = tid >> 6, rp = tid >> 3, kq = tid & 7;
  float* op = (float*)smem;
  float* yo = op + T * 6 * 64;
  const bf16_t* RKV = (const bf16_t*)(p.ws + OFF_RKV);
  bf16_t* E0 = (bf16_t*)(p.ws + OFF_R1); bf16_t* Ed = E0 + (size_t)dir * NTOK * 512; const bf16_t* Ab = E0 + (size_t)2 * NTOK * 512;
  const float kkw = p.rw_k_k[h * 64 + lane], kaw = p.rw_k_a[h * 64 + lane];
  f32x2 S0[4], S1[4];
#pragma unroll
  for (int j = 0; j < 4; ++j) { S0[j] = (f32x2){0.f, 0.f}; S1[j] = (f32x2){0.f, 0.f}; }
  bf16_t pr[8], pk[8], pv[8], pa[8], pe[8];
#define RW_PREFETCH(c0_) do { _Pragma("unroll") for (int i = 0; i < 8; ++i) { const int st_ = (c0_) + wave * 8 + i, t_ = dir ? (SEQ - 1 - st_) : st_; const size_t tok_ = (size_t)b * SEQ + t_; \
    pr[i] = RKV[tok_ * 1536 + h * 64 + lane]; pk[i] = RKV[tok_ * 1536 + 512 + h * 64 + lane]; pv[i] = RKV[tok_ * 1536 + 1024 + h * 64 + lane]; \
    pa[i] = Ab[tok_ * 512 + h * 64 + lane]; pe[i] = Ed[tok_ * 512 + h * 64 + lane]; } } while (0)
  RW_PREFETCH(0);
  for (int c0 = 0; c0 < SEQ; c0 += T) {
    __syncthreads();
#pragma unroll
    for (int i = 0; i < 8; ++i) {
      const int s = wave * 8 + i;
      const float r = bf2f(pr[i]), k = bf2f(pk[i]), v = bf2f(pv[i]), a = bf2f(pa[i]), e = bf2f(pe[i]);
      float kk = k * kkw; const float ss = wave_sum(kk * kk); kk *= rsqrtf(fmaxf(ss, 1e-12f));
      float* o = op + s * 384;
      o[lane] = __expf(-e); o[64 + lane] = k * (1.0f + (a - 1.0f) * kaw); o[128 + lane] = -kk; o[192 + lane] = kk * a; o[256 + lane] = r; o[320 + lane] = v;
    }
    __syncthreads();
    if (c0 + T < SEQ) RW_PREFETCH(c0 + T);
#pragma unroll 2
    for (int s = 0; s < T; ++s) {
      const float* o = op + s * 384 + kq * 8;
      const f32x4 a0 = *(const f32x4*)(o + 128), a1 = *(const f32x4*)(o + 132);
      const f32x2 av[4] = {(f32x2){a0[0], a0[1]}, (f32x2){a0[2], a0[3]}, (f32x2){a1[0], a1[1]}, (f32x2){a1[2], a1[3]}};
      f32x2 t0 = S0[0] * av[0], t1 = S1[0] * av[0];
#pragma unroll
      for (int j = 1; j < 4; ++j) { t0 += S0[j] * av[j]; t1 += S1[j] * av[j]; }
      float sa0 = t0[0] + t0[1], sa1 = t1[0] + t1[1];
      sa0 += __shfl_xor(sa0, 1); sa1 += __shfl_xor(sa1, 1); sa0 += __shfl_xor(sa0, 2); sa1 += __shfl_xor(sa1, 2); sa0 += __shfl_xor(sa0, 4); sa1 += __shfl_xor(sa1, 4);
      const f32x2 vv = *(const f32x2*)(op + s * 384 + 320 + rp * 2);
      const f32x4 w0 = *(const f32x4*)(o), w1 = *(const f32x4*)(o + 4), k0 = *(const f32x4*)(o + 64), k1 = *(const f32x4*)(o + 68);
      const f32x4 b0 = *(const f32x4*)(o + 192), b1 = *(const f32x4*)(o + 196), r0 = *(const f32x4*)(o + 256), r1 = *(const f32x4*)(o + 260);
      const f32x2 wv[4] = {(f32x2){w0[0], w0[1]}, (f32x2){w0[2], w0[3]}, (f32x2){w1[0], w1[1]}, (f32x2){w1[2], w1[3]}};
      const f32x2 kv[4] = {(f32x2){k0[0], k0[1]}, (f32x2){k0[2], k0[3]}, (f32x2){k1[0], k1[1]}, (f32x2){k1[2], k1[3]}};
      const f32x2 bv[4] = {(f32x2){b0[0], b0[1]}, (f32x2){b0[2], b0[3]}, (f32x2){b1[0], b1[1]}, (f32x2){b1[2], b1[3]}};
      const f32x2 rv[4] = {(f32x2){r0[0], r0[1]}, (f32x2){r0[2], r0[3]}, (f32x2){r1[0], r1[1]}, (f32x2){r1[2], r1[3]}};
      f32x2 y0 = (f32x2){0.f, 0.f}, y1 = (f32x2){0.f, 0.f};
#pragma unroll
      for (int j = 0; j < 4; ++j) {
        S0[j] = S0[j] * wv[j] + bv[j] * sa0 + kv[j] * vv[0];
        S1[j] = S1[j] * wv[j] + bv[j] * sa1 + kv[j] * vv[1];
        y0 += S0[j] * rv[j]; y1 += S1[j] * rv[j];
      }
      float ya = y0[0] + y0[1], yb = y1[0] + y1[1];
      ya += __shfl_xor(ya, 1); yb += __shfl_xor(yb, 1); ya += __shfl_xor(ya, 2); yb += __shfl_xor(yb, 2); ya += __shfl_xor(ya, 4); yb += __shfl_xor(yb, 4);
      if (kq == 0) *(f32x2*)(yo + s * 64 + rp * 2) = (f32x2){ya, yb};
    }
    __syncthreads();
#pragma unroll
    for (int i = 0; i < 8; ++i) { const int idx = tid + i * 256, s = idx >> 6, kx = idx & 63, st = c0 + s, t = dir ? (SEQ - 1 - st) : st; Ed[((size_t)b * SEQ + t) * 512 + h * 64 + kx] = f2bf(yo[idx]); }
  }
#undef RW_PREFETCH
}

template <int DV>
struct Gla {
  static constexpr int NVB = DV / 16, QP = 136, VP = DV + 8, MP = QP;
  static constexpr int BYTES = (64 * QP * 2 + 64 * VP + DV * QP) * 2 + 6 * 64 * 4;
  char* sm;
  DI bf16_t* Qs() const { return (bf16_t*)sm; }
  DI bf16_t* Ks() const { return (bf16_t*)sm + 64 * QP; }
  DI bf16_t* Vs() const { return (bf16_t*)sm + 128 * QP; }
  DI bf16_t* St() const { return (bf16_t*)sm + 128 * QP + 64 * VP; }
  DI bf16_t* Ms() const { return (bf16_t*)sm; }
  DI float* P() const { return (float*)((bf16_t*)sm + 128 * QP + 64 * VP + DV * QP); }
  DI float* Qv() const { return P() + 64; }
  DI float* I() const { return P() + 128; }
  DI float* Wl() const { return P() + 192; }
  DI float* Mt() const { return P() + 256; }
  DI float* gl() const { return P() + 320; }
  f32x4 acc[NVB][2];
  int lane, w, fr, fq;
  DI void init(char* smem, int tid_) {
    sm = smem;
    lane = tid_ & 63; w = tid_ >> 6; fr = lane & 15; fq = lane >> 4;
    for (int i = tid_; i < DV * QP / 2; i += 256) ((unsigned*)St())[i] = 0u;
#pragma unroll
    for (int vb = 0; vb < NVB; ++vb) { acc[vb][0] = (f32x4){0.f, 0.f, 0.f, 0.f}; acc[vb][1] = (f32x4){0.f, 0.f, 0.f, 0.f}; }
  }
  DI bf16x8 gather(const bf16_t* base, int pitch, int r0, int col) const { bf16x8 r;
#pragma unroll
    for (int jj = 0; jj < 8; ++jj) r[jj] = (short)base[(r0 + jj) * pitch + col];
    return r; }
  DI void compute_y(f32x4 (&y)[NVB]) {
    bf16x8 qa[4];
#pragma unroll
    for (int ks = 0; ks < 4; ++ks) qa[ks] = *(const bf16x8*)(Qs() + (w * 16 + fr) * QP + ks * 32 + fq * 8);
#pragma unroll
    for (int nb = 0; nb < 4; ++nb) {
      f32x4 g = (f32x4){0.f, 0.f, 0.f, 0.f};
      if (nb <= w) {
#pragma unroll
        for (int ks = 0; ks < 4; ++ks) { const bf16x8 kb = *(const bf16x8*)(Ks() + (nb * 16 + fr) * QP + ks * 32 + fq * 8); g = MFMA16(qa[ks], kb, g); }
      }
      const int s = nb * 16 + fr; const float qs = Qv()[s];
#pragma unroll
      for (int j = 0; j < 4; ++j) { const int t = w * 16 + fq * 4 + j; const float m = (s <= t) ? g[j] * __expf(P()[t] - qs) : 0.f; Ms()[t * MP + s] = f2bf(m); }
    }
    __syncthreads();
#pragma unroll
    for (int vb = 0; vb < NVB; ++vb) y[vb] = (f32x4){0.f, 0.f, 0.f, 0.f};
#pragma unroll
    for (int ks = 0; ks < 4; ++ks)
      {
#pragma unroll
        for (int vb = 0; vb < NVB; ++vb) { const bf16x8 sb = *(const bf16x8*)(St() + (vb * 16 + fr) * QP + ks * 32 + fq * 8); y[vb] = MFMA16(qa[ks], sb, y[vb]); } __builtin_amdgcn_sched_barrier(0); }
    float sc[4];
#pragma unroll
    for (int j = 0; j < 4; ++j) sc[j] = __expf(I()[w * 16 + fq * 4 + j]);
#pragma unroll
    for (int vb = 0; vb < NVB; ++vb)
#pragma unroll
      for (int j = 0; j < 4; ++j) y[vb][j] *= sc[j];
#pragma unroll
    for (int k2 = 0; k2 < 2; ++k2) {
      if (k2 * 32 <= w * 16 + 15) {
        const bf16x8 ma = *(const bf16x8*)(Ms() + (w * 16 + fr) * MP + k2 * 32 + fq * 8);
#pragma unroll
        for (int vb = 0; vb < NVB; ++vb) { const bf16x8 vf = gather(Vs(), VP, k2 * 32 + fq * 8, vb * 16 + fr); y[vb] = MFMA16(ma, vf, y[vb]); __builtin_amdgcn_sched_barrier(0); }
      }
    }
  }
  DI void update() {
    __syncthreads();
    const float g = __expf(gl()[0]);
#pragma unroll
    for (int vb = 0; vb < NVB; ++vb) { acc[vb][0] *= g; acc[vb][1] *= g; }
#pragma unroll
    for (int k2 = 0; k2 < 2; ++k2) {
      const int s0 = k2 * 32 + fq * 8;
      float wsc[8];
#pragma unroll
      for (int jj = 0; jj < 8; ++jj) wsc[jj] = __expf(Wl()[s0 + jj]);
      const bf16x8 kb0 = gather(Ks(), QP, s0, (2 * w) * 16 + fr), kb1 = gather(Ks(), QP, s0, (2 * w + 1) * 16 + fr);
#pragma unroll
      for (int vb = 0; vb < NVB; ++vb) {
        bf16x8 va;
#pragma unroll
        for (int jj = 0; jj < 8; ++jj) va[jj] = (short)f2bf(bf2f(Vs()[(s0 + jj) * VP + vb * 16 + fr]) * wsc[jj]);
        acc[vb][0] = MFMA16(va, kb0, acc[vb][0]); acc[vb][1] = MFMA16(va, kb1, acc[vb][1]);
        __builtin_amdgcn_sched_barrier(0);
      }
    }
#pragma unroll
    for (int vb = 0; vb < NVB; ++vb)
#pragma unroll
      for (int nn = 0; nn < 2; ++nn)
#pragma unroll
        for (int j = 0; j < 4; ++j) St()[(vb * 16 + fq * 4 + j) * QP + (2 * w + nn) * 16 + fr] = f2bf(acc[vb][nn][j]);
    __syncthreads();
  }
};

DI void mamba_item(const Params& p, int item, char* smem) {
  const int dir = item >> 8, b = (item >> 4) & 15, head = item & 15, gq = head >> 3;
  const int tid = TIDX;
  Gla<64> G; G.init(smem, tid);
  const bf16_t* raw = (const bf16_t*)(p.ws + OFF_R2);
  const bf16_t* BC = (const bf16_t*)(p.ws + OFF_XN + 32 * MiB);
  bf16_t* Y = (bf16_t*)p.out + (size_t)dir * NTOK * 1024;
  const float Aneg = -expf(p.mb_A_log[dir * 16 + head]), dtb = p.mb_dt_bias[dir * 16 + head];
  const int cvi = tid & 7, tg = tid >> 3, xc = head * 64 + cvi * 8;
  u32x4 px[4]; bf16_t pdt[2] = {0, 0}; bf16_t pdts = 0;
#define MB_LOADBC(c_) do { \
    _Pragma("unroll") for (int i = 0; i < 8; ++i) { const int v_ = tid + i * 256, s_ = v_ >> 5, cv_ = v_ & 31, st_ = (c_) * 64 + s_, t_ = dir ? (SEQ - 1 - st_) : st_; \
      pbc[i] = ld8(BC + ((size_t)b * SEQ + t_) * 512 + (cv_ < 16 ? 256 + gq * 128 + cv_ * 8 : gq * 128 + (cv_ - 16) * 8)); } } while (0)
#define MB_PREFETCH(c_) do { \
    { const int tb_ = dir ? (SEQ - 1 - ((c_) * 64 + tg * 2 + 1)) : ((c_) * 64 + tg * 2); \
      _Pragma("unroll") for (int j = 0; j < 4; ++j) { const int t_ = tb_ - 1 + j; px[j] = (t_ >= 0 && t_ < SEQ) ? ld8(raw + ((size_t)b * SEQ + t_) * 2592 + 1024 + xc) : (u32x4){0u, 0u, 0u, 0u}; } \
      pdt[0] = raw[((size_t)b * SEQ + tb_) * 2592 + 2560 + dir * 16 + head]; pdt[1] = raw[((size_t)b * SEQ + tb_ + 1) * 2592 + 2560 + dir * 16 + head]; } \
    if (tid < 64) { const int st_ = (c_) * 64 + tid, t_ = dir ? (SEQ - 1 - st_) : st_; pdts = raw[((size_t)b * SEQ + t_) * 2592 + 2560 + dir * 16 + head]; } } while (0)
  MB_PREFETCH(0);
  for (int c = 0; c < SEQ / 64; ++c) {
    u32x4 pbc[8];
    MB_LOADBC(c);
    { asm volatile("" ::: "memory");
      float cw0[8], cw1[8], cw2[8], cbv[8];
#pragma unroll
      for (int j = 0; j < 8; ++j) { cw0[j] = p.mb_conv_w[xc + j]; cw1[j] = p.mb_conv_w[1536 + xc + j]; cw2[j] = p.mb_conv_w[3072 + xc + j]; cbv[j] = p.mb_conv_b[xc + j]; }
      float R[4][8];
#pragma unroll
      for (int j = 0; j < 4; ++j) unpack8(px[j], R[j]);
#pragma unroll
      for (int i = 0; i < 2; ++i) {
        const int pi = dir ? (1 - i) : i;
        const float dt = softplusf_(bf2f(pdt[dir ? (1 - i) : i]) + dtb);
        float o[8];
#pragma unroll
        for (int j = 0; j < 8; ++j) o[j] = dt * siluf_(cbv[j] + cw0[j] * R[pi][j] + cw1[j] * R[pi + 1][j] + cw2[j] * R[pi + 2][j]);
        *(u32x4*)(G.Vs() + (tg * 2 + i) * G.VP + cvi * 8) = pack8(o);
      } }
    if (tid < 64) {
      const int s = tid;
      const float dt = softplusf_(bf2f(pdts) + dtb);
      const float cs = wave_incl_sum(dt * Aneg, s); const float csl = __shfl(cs, 63);
      G.P()[s] = cs; G.Qv()[s] = cs; G.I()[s] = cs; G.Wl()[s] = csl - cs; if (s == 0) G.gl()[0] = csl;
    }
#pragma unroll
    for (int i = 0; i < 8; ++i) { const int v = tid + i * 256, s = v >> 5, cv = v & 31; *(u32x4*)((cv < 16 ? G.Qs() : G.Ks()) + s * G.QP + (cv & 15) * 8) = pbc[i]; }
    if (c + 1 < SEQ / 64) MB_PREFETCH(c + 1);
    __syncthreads();
    f32x4 y[4];
    G.compute_y(y);
#pragma unroll
    for (int vb = 0; vb < 4; ++vb)
#pragma unroll
      for (int j = 0; j < 4; ++j) { const int s = G.w * 16 + G.fq * 4 + j, st = c * 64 + s, t = dir ? (SEQ - 1 - st) : st; Y[((size_t)b * SEQ + t) * 1024 + head * 64 + vb * 16 + G.fr] = f2bf(y[vb][j]); }
    G.update();
  }
#undef MB_PREFETCH
#undef MB_LOADBC
}

DI void mlstm_item(const Params& p, int item, char* smem) {
  const int half = item & 1, head = (item >> 1) & 7, b = (item >> 4) & 15, dir = item >> 8;
  const int tid = TIDX;
  Gla<80> G; G.init(smem, tid);
  float* Wl_ = (float*)(smem + Gla<80>::BYTES);
  for (int i = tid; i < 128; i += 256) { const int ch = head * 128 + i; Wl_[i] = p.ml_conv_w[ch]; Wl_[128 + i] = p.ml_conv_w[1024 + ch]; Wl_[256 + i] = p.ml_conv_w[2048 + ch]; Wl_[384 + i] = p.ml_conv_b[ch]; }
  for (int i = tid; i < 512; i += 256) { Wl_[512 + i] = p.ml_wq[head * 512 + i]; Wl_[1024 + i] = p.ml_wk[head * 512 + i] * 0.08838834764831845f; Wl_[1536 + i] = p.ml_wv[head * 512 + i]; }
  if (tid < 64) { for (int j = 0; j < 16; ++j) G.Vs()[tid * G.VP + 64 + j] = (j == 0) ? (bf16_t)0x3f80 : (bf16_t)0; }
  const bf16_t* raw = (const bf16_t*)(p.ws + OFF_MLRAW);
  bf16_t* H = (bf16_t*)(p.ws + OFF_HFB) + (size_t)dir * NTOK * 1024;
  const float ib = p.ml_i_b[dir * 8 + head], fb = p.ml_f_b[dir * 8 + head];
  const int cvi = tid & 15, tg = tid >> 4, ch = head * 128 + cvi * 8;
  float mprev = 0.f;
  u32x4 px[6]; bf16_t pgi = 0, pgf = 0;
#define ML_PREFETCH(c_) do { const int tb_ = dir ? (SEQ - 1 - ((c_) * 64 + tg * 4 + 3)) : ((c_) * 64 + tg * 4); \
    _Pragma("unroll") for (int j = 0; j < 6; ++j) { const int t_ = tb_ - 1 + j; px[j] = (t_ >= 0 && t_ < SEQ) ? ld8(raw + ((size_t)b * SEQ + t_) * 2080 + ch) : (u32x4){0u, 0u, 0u, 0u}; } \
    if (tid < 64) { const int st_ = (c_) * 64 + tid, t_ = dir ? (SEQ - 1 - st_) : st_; const size_t tok_ = (size_t)b * SEQ + t_; pgi = raw[tok_ * 2080 + 2048 + dir * 8 + head]; pgf = raw[tok_ * 2080 + 2064 + dir * 8 + head]; } } while (0)
  ML_PREFETCH(0);
  __syncthreads();
  for (int c = 0; c < SEQ / 64; ++c) {
    {
#pragma unroll
      for (int i = 0; i < 4; ++i) {
        float prv[8], cur[8], nxt[8];
        { const u32x4 a = dir ? px[3 - i] : px[i], bq = dir ? px[4 - i] : px[i + 1], cq = dir ? px[5 - i] : px[i + 2]; unpack8(a, prv); unpack8(bq, cur); unpack8(cq, nxt); }
        float xcv[8], q[8], k[8], v[8];
#pragma unroll
        for (int j4 = 0; j4 < 2; ++j4) {
          const f32x4 w0 = *(const f32x4*)(Wl_ + cvi * 8 + j4 * 4), w1 = *(const f32x4*)(Wl_ + 128 + cvi * 8 + j4 * 4), w2 = *(const f32x4*)(Wl_ + 256 + cvi * 8 + j4 * 4), bb = *(const f32x4*)(Wl_ + 384 + cvi * 8 + j4 * 4);
#pragma unroll
          for (int j = 0; j < 4; ++j) xcv[j4 * 4 + j] = siluf_(bb[j] + w0[j] * prv[j4 * 4 + j] + w1[j] * cur[j4 * 4 + j] + w2[j] * nxt[j4 * 4 + j]);
        }
#pragma unroll
        for (int bl = 0; bl < 2; ++bl) {
          f32x4 aq = (f32x4){0.f, 0.f, 0.f, 0.f}, ak = aq, av = aq;
#pragma unroll
          for (int cc = 0; cc < 4; ++cc) {
            const int wi = (cvi * 2 + bl) * 16 + cc * 4;
            aq += *(const f32x4*)(Wl_ + 512 + wi) * xcv[bl * 4 + cc]; ak += *(const f32x4*)(Wl_ + 1024 + wi) * xcv[bl * 4 + cc]; av += *(const f32x4*)(Wl_ + 1536 + wi) * cur[bl * 4 + cc];
          }
#pragma unroll
          for (int d = 0; d < 4; ++d) { q[bl * 4 + d] = aq[d]; k[bl * 4 + d] = ak[d]; v[bl * 4 + d] = av[d]; }
        }
        const int s = tg * 4 + i;
        *(u32x4*)(G.Qs() + s * G.QP + cvi * 8) = pack8(q);
        *(u32x4*)(G.Ks() + s * G.QP + cvi * 8) = pack8(k);
        if ((cvi >> 3) == half) *(u32x4*)(G.Vs() + s * G.VP + (cvi & 7) * 8) = pack8(v);
        __builtin_amdgcn_sched_barrier(0);
      } }
    if (tid < 64) {
      const int s = tid;
      const float li = bf2f(pgi) + ib;
      const float fx = bf2f(pgf) + fb;
      const float lf = fminf(fx, 0.f) - log1pf(expf(-fabsf(fx)));
      const float bc = wave_incl_sum(lf, s);
      const float cc = li - bc;
      const float pm = fmaxf(wave_incl_max(cc, s), mprev);
      const float pml = __shfl(pm, 63), bl = __shfl(bc, 63);
      G.P()[s] = -pm; G.Qv()[s] = -cc; G.I()[s] = mprev - pm; G.Wl()[s] = cc - pml; G.Mt()[s] = bc + pm; if (s == 0) G.gl()[0] = mprev - pml;
      mprev = bl + pml;
    }
    if (c + 1 < SEQ / 64) ML_PREFETCH(c + 1);
    __syncthreads();
    f32x4 y[5];
    G.compute_y(y);
#pragma unroll
    for (int j = 0; j < 4; ++j) {
      const float den = __shfl(y[4][j], G.lane & 48);
      const int s = G.w * 16 + G.fq * 4 + j, st = c * 64 + s, t = dir ? (SEQ - 1 - st) : st;
      const float dn = 1.0f / fmaxf(fabsf(den), __expf(-G.Mt()[s]));
#pragma unroll
      for (int vb = 0; vb < 4; ++vb) H[((size_t)b * SEQ + t) * 1024 + head * 128 + half * 64 + vb * 16 + G.fr] = f2bf(y[vb][j] * dn);
    }
    G.update();
  }
#undef ML_PREFETCH
}

DI void s5_item(const Params& p, int item, char* smem) {
  constexpr int T = 32, XP = 136;
  const int dir = item >> 7, b = (item >> 3) & 15, gq = item & 7;
  const int tid = TIDX, lane = tid & 63, wave = tid >> 6, fr = lane & 15, fq = lane >> 4;
  const int g = gq * 4 + wave;
  float* Uw = (float*)smem + wave * (T * 16);
  bf16_t* Xw = (bf16_t*)(smem + 4 * T * 16 * 4) + wave * (T * XP);
  const bf16_t* U = (const bf16_t*)(p.ws + OFF_S5U);
  bf16_t* Y = (bf16_t*)(p.ws + OFF_S5Y) + (size_t)dir * NTOK * 512;
  const float dtv = expf(p.s5_log_dt[dir * 32 + g]);
  const float ar = fminf(p.s5_A_re[(dir * 32 + g) * 64 + lane], -1e-4f), ai = p.s5_A_im[(dir * 32 + g) * 64 + lane];
  const float mag = expf(dtv * ar), abr = mag * cosf(dtv * ai), abi = mag * sinf(dtv * ai);
  const float den = ar * ar + ai * ai;
  const float f_r = ((abr - 1.0f) * ar + abi * ai) / den, f_i = (abi * ar - (abr - 1.0f) * ai) / den;
  float bbr[16], bbi[16];
#pragma unroll
  for (int m = 0; m < 16; ++m) { const float br = p.s5_B_re[(g * 64 + lane) * 16 + m], bi = p.s5_B_im[(g * 64 + lane) * 16 + m]; bbr[m] = f_r * br - f_i * bi; bbi[m] = f_r * bi + f_i * br; }
  bf16x8 cf[4];
#pragma unroll
  for (int ks = 0; ks < 4; ++ks)
#pragma unroll
    for (int jj = 0; jj < 8; ++jj) { const int k = ks * 32 + fq * 8 + jj; const size_t base = ((size_t)(dir * 32 + g) * 16 + fr) * 64;
      cf[ks][jj] = (short)f2bf(k < 64 ? p.s5_C_re[base + k] : -p.s5_C_im[base + k - 64]); }
  float xr = 0.f, xi = 0.f;
  u32x4 pu;
#define S5_PREFETCH(c0_) do { const int s_ = lane >> 1, st_ = (c0_) + s_, t_ = dir ? (SEQ - 1 - st_) : st_; pu = ld8(U + ((size_t)b * SEQ + t_) * 512 + g * 16 + (lane & 1) * 8); } while (0)
  S5_PREFETCH(0);
  for (int c0 = 0; c0 < SEQ; c0 += T) {
    __syncthreads();
    { float uf[8]; unpack8(pu, uf); float* d = Uw + (lane >> 1) * 16 + (lane & 1) * 8; *(f32x4*)d = (f32x4){uf[0], uf[1], uf[2], uf[3]}; *(f32x4*)(d + 4) = (f32x4){uf[4], uf[5], uf[6], uf[7]}; }
    __syncthreads();
    if (c0 + T < SEQ) S5_PREFETCH(c0 + T);
#pragma unroll 4
    for (int s = 0; s < T; ++s) {
      float bur = 0.f, bui = 0.f;
#pragma unroll
      for (int m4 = 0; m4 < 4; ++m4) { const f32x4 uv = *(const f32x4*)(Uw + s * 16 + m4 * 4);
#pragma unroll
        for (int j = 0; j < 4; ++j) { bur += bbr[m4 * 4 + j] * uv[j]; bui += bbi[m4 * 4 + j] * uv[j]; } }
      const float nr = abr * xr - abi * xi + bur, ni = abr * xi + abi * xr + bui;
      xr = nr; xi = ni;
      Xw[s * XP + lane] = f2bf(xr); Xw[s * XP + 64 + lane] = f2bf(xi);
    }
    __syncthreads();
#pragma unroll
    for (int mb = 0; mb < 2; ++mb) {
      f32x4 y = (f32x4){0.f, 0.f, 0.f, 0.f};
#pragma unroll
      for (int ks = 0; ks < 4; ++ks) { const bf16x8 xa = *(const bf16x8*)(Xw + (mb * 16 + fr) * XP + ks * 32 + fq * 8); y = MFMA16(xa, cf[ks], y); }
#pragma unroll
      for (int j = 0; j < 4; ++j) { const int s = mb * 16 + fq * 4 + j, st = c0 + s, t = dir ? (SEQ - 1 - st) : st; Y[((size_t)b * SEQ + t) * 512 + g * 16 + fr] = f2bf(y[j]); }
    }
  }
#undef S5_PREFETCH
}

DI void phase_post0(const Params& p) {
  const int lane = TIDX & 63, wid = TIDX >> 6;
  const int gw = blockIdx.x * 4 + wid, nw = gridDim.x * 4;
  {
    bf16_t* E0 = (bf16_t*)(p.ws + OFF_R1); const bf16_t* E1 = E0 + (size_t)NTOK * 512; const bf16_t* Ab = E1 + (size_t)NTOK * 512;
    const bf16_t* G = (const bf16_t*)(p.ws + OFF_XN); const bf16_t* RKV = (const bf16_t*)(p.ws + OFF_RKV);
    for (int u = gw; u < NTOK * 8; u += nw) {
      const int tok = u >> 3, h = u & 7, c = h * 64 + lane;
      const float y = bf2f(E0[(size_t)tok * 512 + c]) + bf2f(E1[(size_t)tok * 512 + c]);
      const float mean = wave_sum(y) * (1.0f / 64.0f); const float d = y - mean; const float var = wave_sum(d * d) * (1.0f / 64.0f);
      const float yn = d * rsqrtf(var + 64e-5f) * p.rw_ln_w[c];
      const float r = bf2f(RKV[(size_t)tok * 1536 + c]), k = bf2f(RKV[(size_t)tok * 1536 + 512 + c]), v = bf2f(RKV[(size_t)tok * 1536 + 1024 + c]);
      const float a = bf2f(Ab[(size_t)tok * 512 + c]);
      const float k2 = k * (1.0f + (a - 1.0f) * p.rw_k_a[c]);
      const float bonus = wave_sum(r * k2 * p.rw_r_k[c]) * v;
      E0[(size_t)tok * 512 + c] = f2bf((yn + bonus) * bf2f(G[(size_t)tok * 512 + c]));
    }
  }
  {
    bf16_t* raw = (bf16_t*)(p.ws + OFF_R2);
    const bf16_t* Y0 = (const bf16_t*)p.out; const bf16_t* Y1 = Y0 + (size_t)NTOK * 1024;
    const float* cw = p.mb_conv_w; const float* cb = p.mb_conv_b;
    for (int u = gw; u < NTOK * 2; u += nw) {
      const int tok = u >> 1, gq = u & 1, col = gq * 512 + lane * 8, head = col >> 6, t = tok & (SEQ - 1);
      float y0[8], y1[8], z[8], cur[8], prv[8], nxt[8], o[8];
      unpack8(ld8(Y0 + (size_t)tok * 1024 + col), y0); unpack8(ld8(Y1 + (size_t)tok * 1024 + col), y1);
      bf16_t* zp = raw + (size_t)tok * 2592 + col;
      unpack8(ld8(zp), z);
      const bf16_t* rp = zp + 1024;
      unpack8(ld8(rp), cur);
      if (t > 0) unpack8(ld8(rp - 2592), prv); else for (int j = 0; j < 8; ++j) prv[j] = 0.f;
      if (t < SEQ - 1) unpack8(ld8(rp + 2592), nxt); else for (int j = 0; j < 8; ++j) nxt[j] = 0.f;
      const float D = p.mb_D[head];
      float ss = 0.f;
#pragma unroll
      for (int j = 0; j < 8; ++j) { const float xs = siluf_(cb[col + j] + cw[col + j] * prv[j] + cw[1536 + col + j] * cur[j] + cw[3072 + col + j] * nxt[j]);
        const float yy = (y0[j] + y1[j] + D * xs) * siluf_(z[j]); o[j] = yy; ss += yy * yy; }
      ss = wave_sum(ss);
      const float rs = rsqrtf(ss * (1.0f / 512.0f) + 1e-5f);
#pragma unroll
      for (int j = 0; j < 8; ++j) o[j] = o[j] * rs * p.mb_norm_w[col + j];
      *(u32x4*)zp = pack8(o);
    }
  }
}

DI float gelu_tanh(float x) { const float u = 0.7978845608028654f * (x + 0.044715f * x * x * x); return 0.5f * x * (1.0f + tanhf(u)); }

DI void phase_post1(const Params& p) {
  const int lane = TIDX & 63, wid = TIDX >> 6;
  const int gw = blockIdx.x * 4 + wid, nw = gridDim.x * 4;
  {
    const bf16_t* U = (const bf16_t*)(p.ws + OFF_S5U); const bf16_t* Y0 = (const bf16_t*)(p.ws + OFF_S5Y); const bf16_t* Y1 = Y0 + (size_t)NTOK * 512;
    bf16_t* YG = (bf16_t*)(p.ws + OFF_YG);
    for (int tok = gw; tok < NTOK; tok += nw) {
      const int col = lane * 8; float u[8], a[8], c[8], o[8];
      unpack8(ld8(U + (size_t)tok * 512 + col), u); unpack8(ld8(Y0 + (size_t)tok * 512 + col), a); unpack8(ld8(Y1 + (size_t)tok * 512 + col), c);
#pragma unroll
      for (int j = 0; j < 8; ++j) o[j] = gelu_tanh(p.s5_D[col + j] * u[j] + a[j] + c[j]);
      *(u32x4*)(YG + (size_t)tok * 512 + col) = pack8(o);
    }
  }
  {
    bf16_t* raw = (bf16_t*)(p.ws + OFF_MLRAW);
    const bf16_t* HF = (const bf16_t*)(p.ws + OFF_HFB); const bf16_t* HB = HF + (size_t)NTOK * 1024;
    for (int u = gw; u < NTOK * 8; u += nw) {
      const int tok = u >> 3, head = u & 7, c = head * 128 + lane * 2, t = tok & (SEQ - 1);
      const unsigned hf = *(const unsigned*)(HF + (size_t)tok * 1024 + c), hb = *(const unsigned*)(HB + (size_t)tok * 1024 + c);
      const float h0 = __uint_as_float(hf << 16) + __uint_as_float(hb << 16), h1 = __uint_as_float(hf & 0xffff0000u) + __uint_as_float(hb & 0xffff0000u);
      const float mean = wave_sum(h0 + h1) * (1.0f / 128.0f);
      const float d0 = h0 - mean, d1 = h1 - mean;
      const float var = wave_sum(d0 * d0 + d1 * d1) * (1.0f / 128.0f);
      const float rs = rsqrtf(var + 1e-5f);
      bf16_t* xp = raw + (size_t)tok * 2080 + c;
      const unsigned xc_ = *(const unsigned*)xp;
      const unsigned xp_ = t > 0 ? *(const unsigned*)(xp - 2080) : 0u, xn_ = t < SEQ - 1 ? *(const unsigned*)(xp + 2080) : 0u;
      const unsigned ov = *(const unsigned*)(xp + 1024);
      float o[2];
#pragma unroll
      for (int j = 0; j < 2; ++j) {
        const float cur = j ? __uint_as_float(xc_ & 0xffff0000u) : __uint_as_float(xc_ << 16);
        const float prv = j ? __uint_as_float(xp_ & 0xffff0000u) : __uint_as_float(xp_ << 16);
        const float nxt = j ? __uint_as_float(xn_ & 0xffff0000u) : __uint_as_float(xn_ << 16);
        const float og = j ? __uint_as_float(ov & 0xffff0000u) : __uint_as_float(ov << 16);
        const float xcv = siluf_(p.ml_conv_b[c + j] + p.ml_conv_w[c + j] * prv + p.ml_conv_w[1024 + c + j] * cur + p.ml_conv_w[2048 + c + j] * nxt);
        const float hn = (j ? d1 : d0) * rs * p.ml_norm_w[c + j];
        o[j] = sigmoidf_(og) * hn + p.ml_skip[c + j] * xcv;
      }
      *(unsigned*)(xp + 1024) = pack2(o[0], o[1]);
    }
  }
}

DI void phase_final(const Params& p) {
  const int lane = TIDX & 63, wid = TIDX >> 6;
  for (int u = blockIdx.x; u < NTOK / 4; u += gridDim.x) {
    float* xr = p.out + (size_t)(u * 4 + wid) * 1024;
    f32x4 v[4]; float ss = 0.f;
#pragma unroll
    for (int i = 0; i < 4; ++i) { v[i] = *(const f32x4*)(xr + i * 256 + lane * 4); ss += v[i][0] * v[i][0] + v[i][1] * v[i][1] + v[i][2] * v[i][2] + v[i][3] * v[i][3]; }
    ss = wave_sum(ss);
    const float rs = rsqrtf(ss * (1.0f / 1024.0f) + 1e-5f);
#pragma unroll
    for (int i = 0; i < 4; ++i) { const f32x4 g = *(const f32x4*)(p.norm_final + i * 256 + lane * 4); *(f32x4*)(xr + i * 256 + lane * 4) = v[i] * rs * g; }
  }
}

constexpr int NPHASE = 20;
#ifdef NO_RW
#define RWK(x)
#else
#define RWK(x) x
#endif
#ifdef NO_MB
#define MBK(x)
#else
#define MBK(x) x
#endif
#ifndef ONLY_PHASE
#define ONLY_PHASE -1
#endif
#define PH(k) case k: if (ONLY_PHASE >= 0 && ONLY_PHASE != k) break;
template <int ph> DI void run_phase(const Params& p, char* smem) {
  char* ws = p.ws;
  bf16_t* XN = (bf16_t*)(ws + OFF_XN);
  switch (ph) {
    PH(0) phase_prep(p, smem); break;
    PH(1) gemm_phase(smem, XN, 1024, 1 << 30, XN, 1024, (const bf16_t*)(ws + OFF_WABIN), 1024, 35,
                       EpiSplit{(bf16_t*)(ws + OFF_R1), 1792, 1792, (bf16_t*)(ws + OFF_R2), 2592, 2592}, TIDX); break;
    PH(2) phase_rw_shift(p); break;
    PH(3) phase_rw_small_gemms(p, smem); break;
    PH(4) {
      const int G = gridDim.x, bx = blockIdx.x;
      if (G >= 512) { if (bx < 256) { RWK(rwkv_item(p, bx, smem);) } else for (int u = bx - 256; u < 512; u += G - 256) { MBK(mamba_item(p, u, smem);) } }
      else { for (int u = bx; u < 256; u += G) { RWK(rwkv_item(p, u, smem);) } __syncthreads(); for (int u = bx + ((256 - bx + G - 1) / G) * G; u < 768; u += G) { MBK(mamba_item(p, u - 256, smem);) } }
    } break;
    PH(5) phase_post0(p); break;
    PH(6) gemm_phase(smem, (const bf16_t*)(ws + OFF_R1), 512, 512, (const bf16_t*)(ws + OFF_R2), 2592, (const bf16_t*)(ws + OFF_WABOUT), 1536, 8, EpiResid{p.x, p.out}, TIDX); break;
    PH(7) phase_rmsnorm(p, p.out, p.norm_mlp); break;
    PH(8) gemm_phase(smem, XN, 1024, 1 << 30, XN, 1024, (const bf16_t*)(ws + OFF_W1), 1024, 32, EpiRelu2{(bf16_t*)(ws + OFF_R1)}, TIDX); break;
    PH(9) gemm_phase(smem, (const bf16_t*)(ws + OFF_R1), 4096, 1 << 30, XN, 1024, (const bf16_t*)(ws + OFF_W2), 4096, 8, EpiResid{p.out, p.out}, TIDX); break;
    PH(10) phase_rmsnorm(p, p.out, p.norm_mix + 1024); break;
    PH(11) gemm_phase(smem, XN, 1024, 1 << 30, XN, 1024, (const bf16_t*)(ws + OFF_WCDIN), 1024, 21,
                        EpiSplit{(bf16_t*)(ws + OFF_S5U), 512, 512, (bf16_t*)(ws + OFF_MLRAW), 2080, 2080}, TIDX); break;
    PH(12) {
      const int G = gridDim.x, bx = blockIdx.x;
      for (int u = bx; u < 512; u += G) mlstm_item(p, u, smem);
      __syncthreads();
      { int u0 = bx + ((512 - bx + G - 1) / G) * G; for (int u = u0; u < 768; u += G) s5_item(p, u - 512, smem); }
    } break;
    PH(13) phase_post1(p); break;
    PH(14) gemm_phase(smem, (const bf16_t*)(ws + OFF_YG), 512, 1 << 30, XN, 1024, (const bf16_t*)(ws + OFF_WGLU), 512, 4,
                        EpiGlu{(const bf16_t*)(ws + OFF_YG), p.s5_glu_b, (bf16_t*)(ws + OFF_S5Y)}, TIDX); break;
    PH(15) gemm_phase(smem, (const bf16_t*)(ws + OFF_S5Y), 512, 512, (const bf16_t*)(ws + OFF_MLRAW) + 1024, 2080, (const bf16_t*)(ws + OFF_WCDOUT), 1536, 8, EpiResid{p.out, p.out}, TIDX); break;
    PH(16) phase_rmsnorm(p, p.out, p.norm_mlp + 1024); break;
    PH(17) gemm_phase(smem, XN, 1024, 1 << 30, XN, 1024, (const bf16_t*)(ws + OFF_W1) + 4096ull * 1024, 1024, 32, EpiRelu2{(bf16_t*)(ws + OFF_R1)}, TIDX); break;
    PH(18) gemm_phase(smem, (const bf16_t*)(ws + OFF_R1), 4096, 1 << 30, XN, 1024, (const bf16_t*)(ws + OFF_W2) + 4096ull * 1024, 4096, 8, EpiResid{p.out, p.out}, TIDX); break;
    PH(19) phase_final(p); break;
    default: break;
  }
}

DI void grid_barrier(const Params& p, unsigned idx) {
  asm volatile("s_waitcnt vmcnt(0)" ::: "memory");
  __syncthreads();
  if (TIDX == 0) {
    unsigned* cnt = (unsigned*)(p.ws + OFF_BAR);
    __builtin_amdgcn_fence(__ATOMIC_RELEASE, "agent");
    asm volatile("s_waitcnt vmcnt(0)" ::: "memory");
    __hip_atomic_fetch_add(cnt, 1u, __ATOMIC_RELAXED, __HIP_MEMORY_SCOPE_AGENT);
    const unsigned target = idx * gridDim.x;
    while (__hip_atomic_load(cnt, __ATOMIC_RELAXED, __HIP_MEMORY_SCOPE_AGENT) < target) __builtin_amdgcn_s_sleep(1);
    __builtin_amdgcn_fence(__ATOMIC_ACQUIRE, "agent");
    asm volatile("s_waitcnt vmcnt(0)" ::: "memory");
  }
  __syncthreads();
}
template <int PHI> DI void run_from(const Params& p, char* smem, int ph0, int ph1) {
  if constexpr (PHI < NPHASE) {
    if (ph0 <= PHI && PHI < ph1) {
      run_phase<PHI>(p, smem);
      if (PHI + 1 < ph1) {
        if constexpr (PHI == 0) { __syncthreads(); cg::this_grid().sync(); }
        else grid_barrier(p, (unsigned)PHI);
      }
    }
    run_from<PHI + 1>(p, smem, ph0, ph1);
  }
}

__global__ void __launch_bounds__(256, 2) mega(Params p, int ph0, int ph1) {
  extern __shared__ __attribute__((aligned(16))) char smem[];
  Params q = p;
  q.wid = __builtin_amdgcn_readfirstlane((int)(__builtin_amdgcn_workitem_id_x() >> 6));
  run_from<0>(q, smem, ph0, ph1);
}

#ifndef ONE_LAUNCH
#define ONE_LAUNCH 1
#endif

extern "C" void kernel_launch(void* const* d_in, const int* in_sizes, int n_in, void* d_out, int out_size, void* d_ws, size_t ws_size,
                              hipStream_t stream) {
  static int grid_blocks = 0;
  if (!grid_blocks) {
    hipFuncSetAttribute((const void*)mega, hipFuncAttributeMaxDynamicSharedMemorySize, LDS_BYTES);
    int dev = 0, cus = 0, per_cu = 0;
    hipGetDevice(&dev);
    hipDeviceGetAttribute(&cus, hipDeviceAttributeMultiprocessorCount, dev);
    hipOccupancyMaxActiveBlocksPerMultiprocessor(&per_cu, mega, 256, LDS_BYTES);
    if (per_cu > 2) per_cu = 2;
    if (per_cu < 1) per_cu = 1;
    grid_blocks = cus * per_cu;
  }
  Params p{};
  const float** pf = (const float**)&p;
  for (int i = 0; i < 45; ++i) pf[i] = (const float*)d_in[i];
  p.out = (float*)d_out;
  p.ws = (char*)d_ws;
#if ONE_LAUNCH
  int ph0 = 0, ph1 = NPHASE;
  void* args[] = {&p, &ph0, &ph1};
  hipError_t e = hipLaunchCooperativeKernel((const void*)mega, dim3(grid_blocks), dim3(256), args, LDS_BYTES, stream);
  if (e != hipSuccess) fprintf(stderr, "cooperative launch failed: %s (grid %d)\n", hipGetErrorString(e), grid_blocks);
#else
  for (int ph = 0; ph < NPHASE; ++ph) hipLaunchKernelGGL(mega, dim3(grid_blocks), dim3(256), LDS_BYTES, stream, p, ph, ph + 1);
#endif
}
```

```cpp
#include <hip/hip_runtime.h>
#include <hip/hip_cooperative_groups.h>
#include <stdint.h>
#include <cstdio>
namespace cg = cooperative_groups;

typedef unsigned short bf16_t;
typedef short bf16x8 __attribute__((ext_vector_type(8)));
typedef float f32x4 __attribute__((ext_vector_type(4)));
typedef unsigned u32x4 __attribute__((ext_vector_type(4)));
typedef unsigned u32x2 __attribute__((ext_vector_type(2)));

#define DI __device__ __forceinline__
#define LANEID() ((int)__builtin_amdgcn_mbcnt_hi(~0u, __builtin_amdgcn_mbcnt_lo(~0u, 0u)))
#define TIDX (c.wid * 64 + LANEID())
#define MFMA16(a, b, c) __builtin_amdgcn_mfma_f32_16x16x32_bf16((a), (b), (c), 0, 0, 0)

constexpr int NTOK = 32768, SEQ = 2048;
constexpr size_t MiB = 1ull << 20;
constexpr size_t OFF_WABIN = 0;
constexpr size_t OFF_WABOUT = OFF_WABIN + 4480ull * 1024 * 2;
constexpr size_t OFF_W1 = OFF_WABOUT + 1024ull * 1536 * 2;
constexpr size_t OFF_W2 = OFF_W1 + 2ull * 4096 * 1024 * 2;
constexpr size_t OFF_WCDIN = OFF_W2 + 2ull * 4096 * 1024 * 2;
constexpr size_t OFF_WCDOUT = OFF_WCDIN + 2688ull * 1024 * 2;
constexpr size_t OFF_WGLU = OFF_WCDOUT + 1024ull * 1536 * 2;
constexpr size_t OFF_WG2 = OFF_WGLU + 512ull * 512 * 2;
constexpr size_t OFF_WW2 = OFF_WG2 + 512ull * 128 * 2;
constexpr size_t OFF_WA2 = OFF_WW2 + 2ull * 512 * 64 * 2;
constexpr size_t OFF_WEND = OFF_WA2 + 512ull * 64 * 2;
static_assert(OFF_WEND <= 56 * MiB, "weights region");
constexpr size_t OFF_XN = 56 * MiB;
constexpr size_t OFF_R1 = 120 * MiB;
constexpr size_t OFF_R2 = 232 * MiB;
constexpr size_t OFF_RKV = 394 * MiB;
constexpr size_t OFF_SM = 490 * MiB;
constexpr size_t OFF_S5U = 120 * MiB;
constexpr size_t OFF_MLRAW = 152 * MiB;
constexpr size_t OFF_S5Y = 282 * MiB;
constexpr size_t OFF_HFB = 346 * MiB;
constexpr size_t OFF_YG = 474 * MiB;
constexpr size_t OFF_BAR = 510 * MiB;
constexpr int LDS_BYTES = 79872;

struct Params {
  const float *x, *norm_mix, *norm_mlp, *norm_final, *mlp_w1, *mlp_w2, *ab_w_in, *ab_w_out, *rw_mu, *rw_w0, *rw_w2, *rw_a0,
      *rw_a2, *rw_g2, *rw_k_k, *rw_k_a, *rw_r_k, *rw_ln_w, *mb_conv_w, *mb_conv_b, *mb_dt_bias, *mb_A_log, *mb_D, *mb_norm_w,
      *cd_w_in, *cd_w_out, *s5_A_re, *s5_A_im, *s5_log_dt, *s5_B_re, *s5_B_im, *s5_C_re, *s5_C_im, *s5_D, *s5_glu_w, *s5_glu_b,
      *ml_conv_w, *ml_conv_b, *ml_wq, *ml_wk, *ml_wv, *ml_i_b, *ml_f_b, *ml_norm_w, *ml_skip;
  float* out;
  char* ws;
};
struct Ctx { const Params& p; int wid; };

DI float bf2f(bf16_t v) { return __uint_as_float(((unsigned)v) << 16); }
typedef float f32x2c __attribute__((ext_vector_type(2)));
typedef __bf16 bf16x2c __attribute__((ext_vector_type(2)));
DI unsigned pack2(float lo, float hi) { const f32x2c v = {lo, hi}; return __builtin_bit_cast(unsigned, __builtin_convertvector(v, bf16x2c)); }
DI bf16_t f2bf(float x) { return (bf16_t)(pack2(x, x) & 0xffffu); }
DI void unpack8(u32x4 w, float* f) {
#pragma unroll
  for (int i = 0; i < 4; ++i) { f[2 * i] = __uint_as_float(w[i] << 16); f[2 * i + 1] = __uint_as_float(w[i] & 0xffff0000u); }
}
DI u32x4 pack8(const float* f) { u32x4 w; w.x = pack2(f[0], f[1]); w.y = pack2(f[2], f[3]); w.z = pack2(f[4], f[5]); w.w = pack2(f[6], f[7]); return w; }
DI u32x4 ld8(const bf16_t* p) { return *(const u32x4*)p; }
template <int CTRL> DI float dpp_mov(float v) { return __int_as_float(__builtin_amdgcn_update_dpp(0, __float_as_int(v), CTRL, 0xF, 0xF, true)); }
DI float sum8(float v) { v += dpp_mov<0xB1>(v); v += dpp_mov<0x4E>(v); v += dpp_mov<0x141>(v); return v; }
DI float wave_sum(float v) {
  v = sum8(v); v += dpp_mov<0x140>(v);
  v += __shfl_xor(v, 16); v += __shfl_xor(v, 32);
  return v;
}
DI float sigmoidf_(float x) { return __builtin_amdgcn_rcpf(1.0f + __expf(-x)); }
DI float siluf_(float x) { return x * __builtin_amdgcn_rcpf(1.0f + __expf(-x)); }
DI float softplusf_(float x) { return x > 20.f ? x : log1pf(expf(x)); }
DI float wave_incl_sum(float v, int lane) {
#pragma unroll
  for (int o = 1; o < 64; o <<= 1) { float t = __shfl_up(v, o); if (lane >= o) v += t; }
  return v;
}
DI float wave_incl_max(float v, int lane) {
#pragma unroll
  for (int o = 1; o < 64; o <<= 1) { float t = __shfl_up(v, o); if (lane >= o) v = fmaxf(v, t); }
  return v;
}

DI bool get_tdesc(const Ctx& c, int i, const float*& src, bf16_t*& dst, int& K, int& Nsrc, int& Npad) {
  const Params& p = c.p; (void)p;
  char* ws = p.ws;
  switch (i) {
    case 0: src = p.ab_w_in; dst = (bf16_t*)(ws + OFF_WABIN); K = 1024; Nsrc = 4384; Npad = 4480; return true;
    case 1: src = p.ab_w_out; dst = (bf16_t*)(ws + OFF_WABOUT); K = 1536; Nsrc = 1024; Npad = 1024; return true;
    case 2: src = p.mlp_w1; dst = (bf16_t*)(ws + OFF_W1); K = 1024; Nsrc = 4096; Npad = 4096; return true;
    case 3: src = p.mlp_w1 + 1024ull * 4096; dst = (bf16_t*)(ws + OFF_W1) + 4096ull * 1024; K = 1024; Nsrc = 4096; Npad = 4096; return true;
    case 4: src = p.mlp_w2; dst = (bf16_t*)(ws + OFF_W2); K = 4096; Nsrc = 1024; Npad = 1024; return true;
    case 5: src = p.mlp_w2 + 4096ull * 1024; dst = (bf16_t*)(ws + OFF_W2) + 4096ull * 1024; K = 4096; Nsrc = 1024; Npad = 1024; return true;
    case 6: src = p.cd_w_in; dst = (bf16_t*)(ws + OFF_WCDIN); K = 1024; Nsrc = 2592; Npad = 2688; return true;
    case 7: src = p.cd_w_out; dst = (bf16_t*)(ws + OFF_WCDOUT); K = 1536; Nsrc = 1024; Npad = 1024; return true;
    case 8: src = p.s5_glu_w; dst = (bf16_t*)(ws + OFF_WGLU); K = 512; Nsrc = 512; Npad = 512; return true;
    case 9: src = p.rw_g2; dst = (bf16_t*)(ws + OFF_WG2); K = 128; Nsrc = 512; Npad = 512; return true;
    case 10: src = p.rw_w2; dst = (bf16_t*)(ws + OFF_WW2); K = 64; Nsrc = 512; Npad = 512; return true;
    case 11: src = p.rw_w2 + 64 * 512; dst = (bf16_t*)(ws + OFF_WW2) + 512 * 64; K = 64; Nsrc = 512; Npad = 512; return true;
    case 12: src = p.rw_a2; dst = (bf16_t*)(ws + OFF_WA2); K = 64; Nsrc = 512; Npad = 512; return true;
    default: return false;
  }
}

DI void rmsnorm_row_to_bf16(const float* __restrict__ xr, const float* __restrict__ w, bf16_t* __restrict__ o, int lane) {
  f32x4 v[4]; float ss = 0.f;
#pragma unroll
  for (int i = 0; i < 4; ++i) { v[i] = *(const f32x4*)(xr + i * 256 + lane * 4); ss += v[i][0] * v[i][0] + v[i][1] * v[i][1] + v[i][2] * v[i][2] + v[i][3] * v[i][3]; }
  ss = wave_sum(ss);
  const float rs = rsqrtf(ss * (1.0f / 1024.0f) + 1e-5f);
#pragma unroll
  for (int i = 0; i < 4; ++i) { const f32x4 g = *(const f32x4*)(w + i * 256 + lane * 4); u32x2 q; q.x = pack2(v[i][0] * rs * g[0], v[i][1] * rs * g[1]); q.y = pack2(v[i][2] * rs * g[2], v[i][3] * rs * g[3]); *(u32x2*)(o + i * 256 + lane * 4) = q; }
}

DI void phase_rmsnorm(const Ctx& c, const float* src, const float* w) {
  const Params& p = c.p; (void)p;
  bf16_t* xn = (bf16_t*)(p.ws + OFF_XN);
  const int lane = TIDX & 63, wid = TIDX >> 6;
  for (int u = blockIdx.x; u < NTOK / 4; u += gridDim.x) { const int row = u * 4 + wid; rmsnorm_row_to_bf16(src + (size_t)row * 1024, w, xn + (size_t)row * 1024, lane); }
}

DI void phase_prep(const Ctx& c, char* smem) {
  const Params& p = c.p; (void)p;
  if (blockIdx.x == 0 && TIDX == 0) __hip_atomic_store((unsigned*)(p.ws + OFF_BAR), 0u, __ATOMIC_RELAXED, __HIP_MEMORY_SCOPE_AGENT);
  float* tile = (float*)smem;
  const int tid = TIDX;
  int ntr = 0;
  for (int i = 0; i < 13; ++i) { const float* s; bf16_t* d; int K, Ns, Np; get_tdesc(c, i, s, d, K, Ns, Np); ntr += (K / 64) * (Np / 64); }
  for (int u = blockIdx.x; u < ntr; u += gridDim.x) {
    const float* src = nullptr; bf16_t* dst = nullptr; int K = 64, Ns = 0, Np = 64, r = u;
    for (int mi = 0; mi < 13; ++mi) { get_tdesc(c, mi, src, dst, K, Ns, Np); const int nt = (K / 64) * (Np / 64); if (r < nt) break; r -= nt; }
    const int nkb = K / 64, kb = r % nkb, nb = r / nkb;
    __syncthreads();
#pragma unroll
    for (int i = 0; i < 16; ++i) { const int k = i * 4 + (tid >> 6), n = tid & 63; const int gn = nb * 64 + n; tile[k * 65 + n] = gn < Ns ? src[(size_t)(kb * 64 + k) * Ns + gn] : 0.f; }
    __syncthreads();
    const int n = tid >> 2, ks = (tid & 3) * 16; float f[16];
#pragma unroll
    for (int j = 0; j < 16; ++j) f[j] = tile[(ks + j) * 65 + n];
    bf16_t* o = dst + (size_t)(nb * 64 + n) * K + kb * 64 + ks;
    *(u32x4*)o = pack8(f); *(u32x4*)(o + 8) = pack8(f + 8);
  }
  phase_rmsnorm(c, p.x, p.norm_mix);
}

template <class Epi>
DI void gemm_tile(char* smem, const bf16_t* __restrict__ A0, int lda0, int ksplit, const bf16_t* __restrict__ A1, int lda1,
                  const bf16_t* __restrict__ Bt, int K, int row0, int col0, const Epi& epi, int tid) {
  constexpr int BK = 32, PITCH = 40, BUF = (256 + 128) * PITCH;
  bf16_t* sbase = (bf16_t*)smem;
  const int lane = tid & 63, wid = tid >> 6, wr = wid >> 1, wc = wid & 1, fr = lane & 15, fq = lane >> 4;
  f32x4 acc[8][4];
#pragma unroll
  for (int m = 0; m < 8; ++m)
#pragma unroll
    for (int n = 0; n < 4; ++n) acc[m][n] = (f32x4){0.f, 0.f, 0.f, 0.f};
  u32x4 ra[2][4], rb[2][2];
  const int nk = K / BK;
  const int sr = tid >> 2, scv = tid & 3;
#define GLOAD(S, kt) do { const int k0_ = (kt) * BK; const bf16_t* Ab_; int lda_, kk_; \
    if (k0_ < ksplit) { Ab_ = A0; lda_ = lda0; kk_ = k0_; } else { Ab_ = A1; lda_ = lda1; kk_ = k0_ - ksplit; } \
    _Pragma("unroll") for (int i_ = 0; i_ < 4; ++i_) ra[S][i_] = *(const u32x4*)(Ab_ + (size_t)(row0 + sr + i_ * 64) * lda_ + kk_ + scv * 8); \
    _Pragma("unroll") for (int i_ = 0; i_ < 2; ++i_) rb[S][i_] = *(const u32x4*)(Bt + (size_t)(col0 + sr + i_ * 64) * K + k0_ + scv * 8); } while (0)
#define LWRITE(S, buf) do { bf16_t* sA_ = sbase + (buf) * BUF; bf16_t* sB_ = sA_ + 256 * PITCH; \
    _Pragma("unroll") for (int i_ = 0; i_ < 4; ++i_) *(u32x4*)(sA_ + (sr + i_ * 64) * PITCH + scv * 8) = ra[S][i_]; \
    _Pragma("unroll") for (int i_ = 0; i_ < 2; ++i_) *(u32x4*)(sB_ + (sr + i_ * 64) * PITCH + scv * 8) = rb[S][i_]; } while (0)
#define COMPUTE(buf) do { const bf16_t* sA_ = sbase + (buf) * BUF; const bf16_t* sB_ = sA_ + 256 * PITCH; \
    bf16x8 bfr[4]; \
    _Pragma("unroll") for (int n = 0; n < 4; ++n) bfr[n] = *(const bf16x8*)(sB_ + (wc * 64 + n * 16 + fr) * PITCH + fq * 8); \
    _Pragma("unroll") for (int m = 0; m < 8; ++m) { const bf16x8 af = *(const bf16x8*)(sA_ + (wr * 128 + m * 16 + fr) * PITCH + fq * 8); \
      _Pragma("unroll") for (int n = 0; n < 4; ++n) acc[m][n] = MFMA16(bfr[n], af, acc[m][n]); } } while (0)
  __syncthreads();
  {
    const int last = nk - 1;
    GLOAD(0, 0);
    __builtin_amdgcn_sched_barrier(0);
    GLOAD(1, 1);
    __builtin_amdgcn_sched_barrier(0);
    LWRITE(0, 0);
    __builtin_amdgcn_sched_barrier(0);
    GLOAD(0, (2 < last ? 2 : last));
    __builtin_amdgcn_sched_barrier(0);
    __syncthreads();
    for (int kt = 0; kt < nk; kt += 2) {
      LWRITE(1, 1);
      __builtin_amdgcn_sched_barrier(0);
      GLOAD(1, (kt + 3 < last ? kt + 3 : last));
      __builtin_amdgcn_sched_barrier(0);
      COMPUTE(0);
      __syncthreads();
      LWRITE(0, 0);
      __builtin_amdgcn_sched_barrier(0);
      GLOAD(0, (kt + 4 < last ? kt + 4 : last));
      __builtin_amdgcn_sched_barrier(0);
      COMPUTE(1);
      __syncthreads();
    }
  }
#undef GLOAD
#undef LWRITE
#undef COMPUTE
#pragma unroll
  for (int m = 0; m < 8; ++m)
#pragma unroll
    for (int n = 0; n < 4; ++n) epi(row0 + wr * 128 + m * 16 + fr, col0 + wc * 64 + n * 16 + fq * 4, acc[m][n]);
}

DI void st_bf16x4(bf16_t* o, f32x4 v) { u32x2 q; q.x = pack2(v[0], v[1]); q.y = pack2(v[2], v[3]); *(u32x2*)o = q; }

struct EpiSplit {
  bf16_t* o0; int ld0, n0; bf16_t* o1; int ld1, n1;
  DI void operator()(int row, int col, f32x4 v) const {
    if (col < n0) st_bf16x4(o0 + (size_t)row * ld0 + col, v);
    else { const int c = col - n0; if (c < n1) st_bf16x4(o1 + (size_t)row * ld1 + c, v); }
  }
};
struct EpiSmall { int mode; const float* b0; bf16_t* o;
  DI void operator()(int row, int col, f32x4 v) const { f32x4 r;
    if (mode == 2) r = v; else { for (int j = 0; j < 4; ++j) r[j] = sigmoidf_(b0[col + j] + v[j]); if (mode == 0) r *= 0.60653066f; }
    st_bf16x4(o + (size_t)row * 512 + col, r); } };
struct EpiStore { bf16_t* o; int ld;
  DI void operator()(int row, int col, f32x4 v) const { st_bf16x4(o + (size_t)row * ld + col, v); } };
struct EpiResid { const float* res; float* o;
  DI void operator()(int row, int col, f32x4 v) const { const f32x4 r = *(const f32x4*)(res + (size_t)row * 1024 + col); *(f32x4*)(o + (size_t)row * 1024 + col) = r + v; } };
struct EpiRelu2 { bf16_t* o;
  DI void operator()(int row, int col, f32x4 v) const { f32x4 r; for (int j = 0; j < 4; ++j) { const float t = fmaxf(v[j], 0.f); r[j] = t * t; } st_bf16x4(o + (size_t)row * 4096 + col, r); } };
struct EpiGlu { const bf16_t* y; const float* b; bf16_t* o;
  DI void operator()(int row, int col, f32x4 v) const { const u32x2 q = *(const u32x2*)(y + (size_t)row * 512 + col); f32x4 r;
    const float y0 = __uint_as_float(q.x << 16), y1 = __uint_as_float(q.x & 0xffff0000u), y2 = __uint_as_float(q.y << 16), y3 = __uint_as_float(q.y & 0xffff0000u);
    r[0] = y0 * sigmoidf_(v[0] + b[col]); r[1] = y1 * sigmoidf_(v[1] + b[col + 1]); r[2] = y2 * sigmoidf_(v[2] + b[col + 2]); r[3] = y3 * sigmoidf_(v[3] + b[col + 3]);
    st_bf16x4(o + (size_t)row * 512 + col, r); } };

template <class Epi>
DI void gemm_phase(char* smem, const bf16_t* A0, int lda0, int ksplit, const bf16_t* A1, int lda1, const bf16_t* Bt, int K, int nN, const Epi& epi, int tid) {
  const int G = gridDim.x;
  if ((G & 7) == 0) {
    const int x = blockIdx.x & 7, l = blockIdx.x >> 3, L = G >> 3, per = 8 * nN, tot = 2 * per;
    for (int q = l; q < tot; q += L) { const int rgl = q / per, rem = q % per, ct = rem >> 3, rt = (x * 2 + rgl) * 8 + (rem & 7);
      gemm_tile(smem, A0, lda0, ksplit, A1, lda1, Bt, K, rt * 256, ct * 128, epi, tid); }
  } else {
    const int ntiles = (NTOK / 256) * nN;
    for (int u = blockIdx.x; u < ntiles; u += G) { const int rt = u / nN, ct = u % nN; gemm_tile(smem, A0, lda0, ksplit, A1, lda1, Bt, K, rt * 256, ct * 128, epi, tid); }
  }
}

DI void phase_rw_shift(const Ctx& c) {
  const Params& p = c.p; (void)p;
  const bf16_t* raw = (const bf16_t*)(p.ws + OFF_R1);
  bf16_t* rkv = (bf16_t*)(p.ws + OFF_RKV); bf16_t* sm = (bf16_t*)(p.ws + OFF_SM);
  const float* mu = p.rw_mu;
  const size_t total = (size_t)NTOK * 224;
  for (size_t i = (size_t)blockIdx.x * 256 + TIDX; i < total; i += (size_t)gridDim.x * 256) {
    const int tok = (int)(i / 224), cv = (int)(i % 224), c = cv * 8, s = tok & (SEQ - 1);
    const bf16_t* rp = raw + (size_t)tok * 1792 + c;
    float cur[8], prv[8], nxt[8], o[8];
    unpack8(ld8(rp), cur);
    if (s > 0) unpack8(ld8(rp - 1792), prv); else for (int j = 0; j < 8; ++j) prv[j] = 0.f;
    if (s < SEQ - 1) unpack8(ld8(rp + 1792), nxt); else for (int j = 0; j < 8; ++j) nxt[j] = 0.f;
#pragma unroll
    for (int j = 0; j < 8; ++j) o[j] = cur[j] + mu[c + j] * (prv[j] - cur[j]) + mu[1792 + c + j] * (nxt[j] - cur[j]);
    if (c < 1536) *(u32x4*)(rkv + (size_t)tok * 1536 + c) = pack8(o);
    else if (c < 1600) { for (int j = 0; j < 8; ++j) o[j] = tanhf(o[j]); *(u32x4*)(sm + (size_t)tok * 256 + (c - 1536)) = pack8(o); }
    else if (c < 1664) *(u32x4*)(sm + (size_t)tok * 256 + 64 + (c - 1600)) = pack8(o);
    else { for (int j = 0; j < 8; ++j) o[j] = sigmoidf_(o[j]); *(u32x4*)(sm + (size_t)tok * 256 + 128 + (c - 1664)) = pack8(o); }
  }
  const bf16_t* mraw = (const bf16_t*)(p.ws + OFF_R2); bf16_t* BC = (bf16_t*)(p.ws + OFF_XN + 32 * MiB);
  const float* cw = p.mb_conv_w; const float* cb = p.mb_conv_b;
  const size_t total2 = (size_t)NTOK * 64;
  for (size_t i = (size_t)blockIdx.x * 256 + TIDX; i < total2; i += (size_t)gridDim.x * 256) {
    const int tok = (int)(i >> 6), cv = (int)(i & 63), xc = 1024 + cv * 8, t = tok & (SEQ - 1);
    const bf16_t* rp = mraw + (size_t)tok * 2592 + 1024 + xc;
    float cur[8], prv[8], nxt[8], o[8];
    unpack8(ld8(rp), cur);
    if (t > 0) unpack8(ld8(rp - 2592), prv); else for (int j = 0; j < 8; ++j) prv[j] = 0.f;
    if (t < SEQ - 1) unpack8(ld8(rp + 2592), nxt); else for (int j = 0; j < 8; ++j) nxt[j] = 0.f;
#pragma unroll
    for (int j = 0; j < 8; ++j) o[j] = siluf_(cb[xc + j] + cw[xc + j] * prv[j] + cw[1536 + xc + j] * cur[j] + cw[3072 + xc + j] * nxt[j]);
    *(u32x4*)(BC + (size_t)tok * 512 + cv * 8) = pack8(o);
  }
}

DI void phase_rw_small_gemms(const Ctx& c, char* smem) {
  const Params& p = c.p; (void)p;
  const int tid = TIDX;
  const bf16_t* sm = (const bf16_t*)(p.ws + OFF_SM);
  bf16_t* E0 = (bf16_t*)(p.ws + OFF_R1); bf16_t* E1 = E0 + (size_t)NTOK * 512; bf16_t* Ab = E1 + (size_t)NTOK * 512;
  bf16_t* G = (bf16_t*)(p.ws + OFF_XN);
  const bf16_t* W2 = (const bf16_t*)(p.ws + OFF_WW2); const bf16_t* A2 = (const bf16_t*)(p.ws + OFF_WA2); const bf16_t* G2 = (const bf16_t*)(p.ws + OFF_WG2);
  gemm_phase(smem, sm, 256, 1 << 30, sm, 256, W2, 64, 4, EpiSmall{0, p.rw_w0, E0}, tid);
  gemm_phase(smem, sm, 256, 1 << 30, sm, 256, W2 + 512 * 64, 64, 4, EpiSmall{0, p.rw_w0 + 512, E1}, tid);
  gemm_phase(smem, sm + 64, 256, 1 << 30, sm, 256, A2, 64, 4, EpiSmall{1, p.rw_a0, Ab}, tid);
  gemm_phase(smem, sm + 128, 256, 1 << 30, sm, 256, G2, 128, 4, EpiSmall{2, p.rw_a0, G}, tid);
}

typedef float f32x2 __attribute__((ext_vector_type(2)));
DI void rwkv_item(const Ctx& c, int item, char* smem) {
  const Params& p = c.p; (void)p;
  constexpr int T = 32;
  const int dir = item >> 7, b = (item >> 3) & 15, h = item & 7;
  const int tid = TIDX, lane = tid & 63, wave = tid >> 6, rp = tid >> 3, kq = tid & 7;
  float* op = (float*)smem;
  float* yo = op + T * 6 * 64;
  const bf16_t* RKV = (const bf16_t*)(p.ws + OFF_RKV);
  bf16_t* E0 = (bf16_t*)(p.ws + OFF_R1); bf16_t* Ed = E0 + (size_t)dir * NTOK * 512; const bf16_t* Ab = E0 + (size_t)2 * NTOK * 512;
  const float kkw = p.rw_k_k[h * 64 + lane], kaw = p.rw_k_a[h * 64 + lane];
  f32x2 S0[4], S1[4];
#pragma unroll
  for (int j = 0; j < 4; ++j) { S0[j] = (f32x2){0.f, 0.f}; S1[j] = (f32x2){0.f, 0.f}; }
  bf16_t pr[8], pk[8], pv[8], pa[8], pe[8];
#define RW_PREFETCH(c0_) do { _Pragma("unroll") for (int i = 0; i < 8; ++i) { const int st_ = (c0_) + wave * 8 + i, t_ = dir ? (SEQ - 1 - st_) : st_; const size_t tok_ = (size_t)b * SEQ + t_; \
    pr[i] = RKV[tok_ * 1536 + h * 64 + lane]; pk[i] = RKV[tok_ * 1536 + 512 + h * 64 + lane]; pv[i] = RKV[tok_ * 1536 + 1024 + h * 64 + lane]; \
    pa[i] = Ab[tok_ * 512 + h * 64 + lane]; pe[i] = Ed[tok_ * 512 + h * 64 + lane]; } } while (0)
  RW_PREFETCH(0);
  for (int c0 = 0; c0 < SEQ; c0 += T) {
    __syncthreads();
#pragma unroll
    for (int i = 0; i < 8; ++i) {
      const int s = wave * 8 + i;
      const float r = bf2f(pr[i]), k = bf2f(pk[i]), v = bf2f(pv[i]), a = bf2f(pa[i]), e = bf2f(pe[i]);
      float kk = k * kkw; const float ss = wave_sum(kk * kk); kk *= rsqrtf(fmaxf(ss, 1e-12f));
      float* o = op + s * 384;
      o[lane] = __expf(-e); o[64 + lane] = k * (1.0f + (a - 1.0f) * kaw); o[128 + lane] = -kk; o[192 + lane] = kk * a; o[256 + lane] = r; o[320 + lane] = v;
    }
    __syncthreads();
    if (c0 + T < SEQ) RW_PREFETCH(c0 + T);
#pragma unroll 2
    for (int s = 0; s < T; ++s) {
      const float* o = op + s * 384 + kq * 8;
      const f32x4 a0 = *(const f32x4*)(o + 128), a1 = *(const f32x4*)(o + 132);
      const f32x2 av[4] = {(f32x2){a0[0], a0[1]}, (f32x2){a0[2], a0[3]}, (f32x2){a1[0], a1[1]}, (f32x2){a1[2], a1[3]}};
      f32x2 t0 = S0[0] * av[0], t1 = S1[0] * av[0];
#pragma unroll
      for (int j = 1; j < 4; ++j) { t0 += S0[j] * av[j]; t1 += S1[j] * av[j]; }
      float sa0 = t0[0] + t0[1], sa1 = t1[0] + t1[1];
      sa0 = sum8(sa0); sa1 = sum8(sa1);
      const f32x2 vv = *(const f32x2*)(op + s * 384 + 320 + rp * 2);
      const f32x4 w0 = *(const f32x4*)(o), w1 = *(const f32x4*)(o + 4), k0 = *(const f32x4*)(o + 64), k1 = *(const f32x4*)(o + 68);
      const f32x4 b0 = *(const f32x4*)(o + 192), b1 = *(const f32x4*)(o + 196), r0 = *(const f32x4*)(o + 256), r1 = *(const f32x4*)(o + 260);
      const f32x2 wv[4] = {(f32x2){w0[0], w0[1]}, (f32x2){w0[2], w0[3]}, (f32x2){w1[0], w1[1]}, (f32x2){w1[2], w1[3]}};
      const f32x2 kv[4] = {(f32x2){k0[0], k0[1]}, (f32x2){k0[2], k0[3]}, (f32x2){k1[0], k1[1]}, (f32x2){k1[2], k1[3]}};
      const f32x2 bv[4] = {(f32x2){b0[0], b0[1]}, (f32x2){b0[2], b0[3]}, (f32x2){b1[0], b1[1]}, (f32x2){b1[2], b1[3]}};
      const f32x2 rv[4] = {(f32x2){r0[0], r0[1]}, (f32x2){r0[2], r0[3]}, (f32x2){r1[0], r1[1]}, (f32x2){r1[2], r1[3]}};
      f32x2 y0 = (f32x2){0.f, 0.f}, y1 = (f32x2){0.f, 0.f};
#pragma unroll
      for (int j = 0; j < 4; ++j) {
        S0[j] = S0[j] * wv[j] + bv[j] * sa0 + kv[j] * vv[0];
        S1[j] = S1[j] * wv[j] + bv[j] * sa1 + kv[j] * vv[1];
        y0 += S0[j] * rv[j]; y1 += S1[j] * rv[j];
      }
      float ya = y0[0] + y0[1], yb = y1[0] + y1[1];
      ya = sum8(ya); yb = sum8(yb);
      if (kq == 0) *(f32x2*)(yo + s * 64 + rp * 2) = (f32x2){ya, yb};
    }
    __syncthreads();
#pragma unroll
    for (int i = 0; i < 8; ++i) { const int idx = tid + i * 256, s = idx >> 6, kx = idx & 63, st = c0 + s, t = dir ? (SEQ - 1 - st) : st; Ed[((size_t)b * SEQ + t) * 512 + h * 64 + kx] = f2bf(yo[idx]); }
  }
#undef RW_PREFETCH
}

template <int DV>
struct Gla {
  static constexpr int NVB = DV / 16, QP = 136, VP = DV + 8, MP = QP;
  static constexpr int BYTES = (64 * QP * 2 + 64 * VP + DV * QP) * 2 + 6 * 64 * 4;
  char* sm;
  DI bf16_t* Qs() const { return (bf16_t*)sm; }
  DI bf16_t* Ks() const { return (bf16_t*)sm + 64 * QP; }
  DI bf16_t* Vs() const { return (bf16_t*)sm + 128 * QP; }
  DI bf16_t* St() const { return (bf16_t*)sm + 128 * QP + 64 * VP; }
  DI bf16_t* Ms() const { return (bf16_t*)sm; }
  DI float* P() const { return (float*)((bf16_t*)sm + 128 * QP + 64 * VP + DV * QP); }
  DI float* Qv() const { return P() + 64; }
  DI float* I() const { return P() + 128; }
  DI float* Wl() const { return P() + 192; }
  DI float* Mt() const { return P() + 256; }
  DI float* gl() const { return P() + 320; }
  f32x4 acc[NVB][2];
  int lane, w, fr, fq;
  DI void init(char* smem, int tid_) {
    sm = smem;
    lane = tid_ & 63; w = tid_ >> 6; fr = lane & 15; fq = lane >> 4;
    for (int i = tid_; i < DV * QP / 2; i += 256) ((unsigned*)St())[i] = 0u;
#pragma unroll
    for (int vb = 0; vb < NVB; ++vb) { acc[vb][0] = (f32x4){0.f, 0.f, 0.f, 0.f}; acc[vb][1] = (f32x4){0.f, 0.f, 0.f, 0.f}; }
  }
  DI bf16x8 gather(const bf16_t* base, int pitch, int r0, int col) const { bf16x8 r;
#pragma unroll
    for (int jj = 0; jj < 8; ++jj) r[jj] = (short)base[(r0 + jj) * pitch + col];
    return r; }
  DI void compute_y(f32x4 (&y)[NVB]) {
    bf16x8 qa[4];
#pragma unroll
    for (int ks = 0; ks < 4; ++ks) qa[ks] = *(const bf16x8*)(Qs() + (w * 16 + fr) * QP + ks * 32 + fq * 8);
#pragma unroll
    for (int nb = 0; nb < 4; ++nb) {
      f32x4 g = (f32x4){0.f, 0.f, 0.f, 0.f};
      if (nb <= w) {
#pragma unroll
        for (int ks = 0; ks < 4; ++ks) { const bf16x8 kb = *(const bf16x8*)(Ks() + (nb * 16 + fr) * QP + ks * 32 + fq * 8); g = MFMA16(qa[ks], kb, g); }
      }
      const int s = nb * 16 + fr; const float qs = Qv()[s];
#pragma unroll
      for (int j = 0; j < 4; ++j) { const int t = w * 16 + fq * 4 + j; const float m = (s <= t) ? g[j] * __expf(P()[t] - qs) : 0.f; Ms()[t * MP + s] = f2bf(m); }
    }
    __syncthreads();
#pragma unroll
    for (int vb = 0; vb < NVB; ++vb) y[vb] = (f32x4){0.f, 0.f, 0.f, 0.f};
#pragma unroll
    for (int ks = 0; ks < 4; ++ks)
      {
#pragma unroll
        for (int vb = 0; vb < NVB; ++vb) { const bf16x8 sb = *(const bf16x8*)(St() + (vb * 16 + fr) * QP + ks * 32 + fq * 8); y[vb] = MFMA16(qa[ks], sb, y[vb]); } __builtin_amdgcn_sched_barrier(0); }
    float sc[4];
#pragma unroll
    for (int j = 0; j < 4; ++j) sc[j] = __expf(I()[w * 16 + fq * 4 + j]);
#pragma unroll
    for (int vb = 0; vb < NVB; ++vb)
#pragma unroll
      for (int j = 0; j < 4; ++j) y[vb][j] *= sc[j];
#pragma unroll
    for (int k2 = 0; k2 < 2; ++k2) {
      if (k2 * 32 <= w * 16 + 15) {
        const bf16x8 ma = *(const bf16x8*)(Ms() + (w * 16 + fr) * MP + k2 * 32 + fq * 8);
#pragma unroll
        for (int vb = 0; vb < NVB; ++vb) { const bf16x8 vf = gather(Vs(), VP, k2 * 32 + fq * 8, vb * 16 + fr); y[vb] = MFMA16(ma, vf, y[vb]); __builtin_amdgcn_sched_barrier(0); }
      }
    }
  }
  DI void update() {
    __syncthreads();
    const float g = __expf(gl()[0]);
#pragma unroll
    for (int vb = 0; vb < NVB; ++vb) { acc[vb][0] *= g; acc[vb][1] *= g; }
#pragma unroll
    for (int k2 = 0; k2 < 2; ++k2) {
      const int s0 = k2 * 32 + fq * 8;
      float wsc[8];
#pragma unroll
      for (int jj = 0; jj < 8; ++jj) wsc[jj] = __expf(Wl()[s0 + jj]);
      const bf16x8 kb0 = gather(Ks(), QP, s0, (2 * w) * 16 + fr), kb1 = gather(Ks(), QP, s0, (2 * w + 1) * 16 + fr);
#pragma unroll
      for (int vb = 0; vb < NVB; ++vb) {
        bf16x8 va;
#pragma unroll
        for (int jj = 0; jj < 8; ++jj) va[jj] = (short)f2bf(bf2f(Vs()[(s0 + jj) * VP + vb * 16 + fr]) * wsc[jj]);
        acc[vb][0] = MFMA16(va, kb0, acc[vb][0]); acc[vb][1] = MFMA16(va, kb1, acc[vb][1]);
        __builtin_amdgcn_sched_barrier(0);
      }
    }
#pragma unroll
    for (int vb = 0; vb < NVB; ++vb)
#pragma unroll
      for (int nn = 0; nn < 2; ++nn)
#pragma unroll
        for (int j = 0; j < 4; ++j) St()[(vb * 16 + fq * 4 + j) * QP + (2 * w + nn) * 16 + fr] = f2bf(acc[vb][nn][j]);
    __syncthreads();
  }
};

DI void mamba_item(const Ctx& c, int item, char* smem) {
  const Params& p = c.p; (void)p;
  const int dir = item >> 8, b = (item >> 4) & 15, head = item & 15, gq = head >> 3;
  const int tid = TIDX;
  Gla<64> G; G.init(smem, tid);
  const bf16_t* raw = (const bf16_t*)(p.ws + OFF_R2);
  const bf16_t* BC = (const bf16_t*)(p.ws + OFF_XN + 32 * MiB);
  bf16_t* Y = (bf16_t*)p.out + (size_t)dir * NTOK * 1024;
  const float Aneg = -expf(p.mb_A_log[dir * 16 + head]), dtb = p.mb_dt_bias[dir * 16 + head];
  const int cvi = tid & 7, tg = tid >> 3, xc = head * 64 + cvi * 8;
  u32x4 px[4]; bf16_t pdt[2] = {0, 0}; bf16_t pdts = 0;
#define MB_LOADBC(c_) do { \
    _Pragma("unroll") for (int i = 0; i < 8; ++i) { const int v_ = tid + i * 256, s_ = v_ >> 5, cv_ = v_ & 31, st_ = (c_) * 64 + s_, t_ = dir ? (SEQ - 1 - st_) : st_; \
      pbc[i] = ld8(BC + ((size_t)b * SEQ + t_) * 512 + (cv_ < 16 ? 256 + gq * 128 + cv_ * 8 : gq * 128 + (cv_ - 16) * 8)); } } while (0)
#define MB_PREFETCH(c_) do { \
    { const int tb_ = dir ? (SEQ - 1 - ((c_) * 64 + tg * 2 + 1)) : ((c_) * 64 + tg * 2); \
      _Pragma("unroll") for (int j = 0; j < 4; ++j) { const int t_ = tb_ - 1 + j; px[j] = (t_ >= 0 && t_ < SEQ) ? ld8(raw + ((size_t)b * SEQ + t_) * 2592 + 1024 + xc) : (u32x4){0u, 0u, 0u, 0u}; } \
      pdt[0] = raw[((size_t)b * SEQ + tb_) * 2592 + 2560 + dir * 16 + head]; pdt[1] = raw[((size_t)b * SEQ + tb_ + 1) * 2592 + 2560 + dir * 16 + head]; } \
    if (tid < 64) { const int st_ = (c_) * 64 + tid, t_ = dir ? (SEQ - 1 - st_) : st_; pdts = raw[((size_t)b * SEQ + t_) * 2592 + 2560 + dir * 16 + head]; } } while (0)
  MB_PREFETCH(0);
  for (int c = 0; c < SEQ / 64; ++c) {
    u32x4 pbc[8];
    MB_LOADBC(c);
    { asm volatile("" ::: "memory");
      float cw0[8], cw1[8], cw2[8], cbv[8];
#pragma unroll
      for (int j = 0; j < 8; ++j) { cw0[j] = p.mb_conv_w[xc + j]; cw1[j] = p.mb_conv_w[1536 + xc + j]; cw2[j] = p.mb_conv_w[3072 + xc + j]; cbv[j] = p.mb_conv_b[xc + j]; }
      float R[4][8];
#pragma unroll
      for (int j = 0; j < 4; ++j) unpack8(px[j], R[j]);
#pragma unroll
      for (int i = 0; i < 2; ++i) {
        const int pi = dir ? (1 - i) : i;
        const float dt = softplusf_(bf2f(pdt[dir ? (1 - i) : i]) + dtb);
        float o[8];
#pragma unroll
        for (int j = 0; j < 8; ++j) o[j] = dt * siluf_(cbv[j] + cw0[j] * R[pi][j] + cw1[j] * R[pi + 1][j] + cw2[j] * R[pi + 2][j]);
        *(u32x4*)(G.Vs() + (tg * 2 + i) * G.VP + cvi * 8) = pack8(o);
      } }
    if (tid < 64) {
      const int s = tid;
      const float dt = softplusf_(bf2f(pdts) + dtb);
      const float cs = wave_incl_sum(dt * Aneg, s); const float csl = __shfl(cs, 63);
      G.P()[s] = cs; G.Qv()[s] = cs; G.I()[s] = cs; G.Wl()[s] = csl - cs; if (s == 0) G.gl()[0] = csl;
    }
#pragma unroll
    for (int i = 0; i < 8; ++i) { const int v = tid + i * 256, s = v >> 5, cv = v & 31; *(u32x4*)((cv < 16 ? G.Qs() : G.Ks()) + s * G.QP + (cv & 15) * 8) = pbc[i]; }
    if (c + 1 < SEQ / 64) MB_PREFETCH(c + 1);
    __syncthreads();
    f32x4 y[4];
    G.compute_y(y);
#pragma unroll
    for (int vb = 0; vb < 4; ++vb)
#pragma unroll
      for (int j = 0; j < 4; ++j) { const int s = G.w * 16 + G.fq * 4 + j, st = c * 64 + s, t = dir ? (SEQ - 1 - st) : st; Y[((size_t)b * SEQ + t) * 1024 + head * 64 + vb * 16 + G.fr] = f2bf(y[vb][j]); }
    G.update();
  }
#undef MB_PREFETCH
#undef MB_LOADBC
}

DI void mlstm_item(const Ctx& c, int item, char* smem) {
  const Params& p = c.p; (void)p;
  const int half = item & 1, head = (item >> 1) & 7, b = (item >> 4) & 15, dir = item >> 8;
  const int tid = TIDX;
  Gla<80> G; G.init(smem, tid);
  float* Wl_ = (float*)(smem + Gla<80>::BYTES);
  for (int i = tid; i < 128; i += 256) { const int ch = head * 128 + i; Wl_[i] = p.ml_conv_w[ch]; Wl_[128 + i] = p.ml_conv_w[1024 + ch]; Wl_[256 + i] = p.ml_conv_w[2048 + ch]; Wl_[384 + i] = p.ml_conv_b[ch]; }
  for (int i = tid; i < 512; i += 256) { Wl_[512 + i] = p.ml_wq[head * 512 + i]; Wl_[1024 + i] = p.ml_wk[head * 512 + i] * 0.08838834764831845f; Wl_[1536 + i] = p.ml_wv[head * 512 + i]; }
  if (tid < 64) { for (int j = 0; j < 16; ++j) G.Vs()[tid * G.VP + 64 + j] = (j == 0) ? (bf16_t)0x3f80 : (bf16_t)0; }
  const bf16_t* raw = (const bf16_t*)(p.ws + OFF_MLRAW);
  bf16_t* H = (bf16_t*)(p.ws + OFF_HFB) + (size_t)dir * NTOK * 1024;
  const float ib = p.ml_i_b[dir * 8 + head], fb = p.ml_f_b[dir * 8 + head];
  const int cvi = tid & 15, tg = tid >> 4, ch = head * 128 + cvi * 8;
  float mprev = 0.f;
  u32x4 px[6]; bf16_t pgi = 0, pgf = 0;
#define ML_PREFETCH(c_) do { const int tb_ = dir ? (SEQ - 1 - ((c_) * 64 + tg * 4 + 3)) : ((c_) * 64 + tg * 4); \
    _Pragma("unroll") for (int j = 0; j < 6; ++j) { const int t_ = tb_ - 1 + j; px[j] = (t_ >= 0 && t_ < SEQ) ? ld8(raw + ((size_t)b * SEQ + t_) * 2080 + ch) : (u32x4){0u, 0u, 0u, 0u}; } \
    if (tid < 64) { const int st_ = (c_) * 64 + tid, t_ = dir ? (SEQ - 1 - st_) : st_; const size_t tok_ = (size_t)b * SEQ + t_; pgi = raw[tok_ * 2080 + 2048 + dir * 8 + head]; pgf = raw[tok_ * 2080 + 2064 + dir * 8 + head]; } } while (0)
  ML_PREFETCH(0);
  __syncthreads();
  for (int c = 0; c < SEQ / 64; ++c) {
    {
#pragma unroll
      for (int i = 0; i < 4; ++i) {
        float prv[8], cur[8], nxt[8];
        { const u32x4 a = dir ? px[3 - i] : px[i], bq = dir ? px[4 - i] : px[i + 1], cq = dir ? px[5 - i] : px[i + 2]; unpack8(a, prv); unpack8(bq, cur); unpack8(cq, nxt); }
        float xcv[8], q[8], k[8], v[8];
#pragma unroll
        for (int j4 = 0; j4 < 2; ++j4) {
          const f32x4 w0 = *(const f32x4*)(Wl_ + cvi * 8 + j4 * 4), w1 = *(const f32x4*)(Wl_ + 128 + cvi * 8 + j4 * 4), w2 = *(const f32x4*)(Wl_ + 256 + cvi * 8 + j4 * 4), bb = *(const f32x4*)(Wl_ + 384 + cvi * 8 + j4 * 4);
#pragma unroll
          for (int j = 0; j < 4; ++j) xcv[j4 * 4 + j] = siluf_(bb[j] + w0[j] * prv[j4 * 4 + j] + w1[j] * cur[j4 * 4 + j] + w2[j] * nxt[j4 * 4 + j]);
        }
#pragma unroll
        for (int bl = 0; bl < 2; ++bl) {
          f32x4 aq = (f32x4){0.f, 0.f, 0.f, 0.f}, ak = aq, av = aq;
#pragma unroll
          for (int cc = 0; cc < 4; ++cc) {
            const int wi = (cvi * 2 + bl) * 16 + cc * 4;
            aq += *(const f32x4*)(Wl_ + 512 + wi) * xcv[bl * 4 + cc]; ak += *(const f32x4*)(Wl_ + 1024 + wi) * xcv[bl * 4 + cc]; av += *(const f32x4*)(Wl_ + 1536 + wi) * cur[bl * 4 + cc];
          }
#pragma unroll
          for (int d = 0; d < 4; ++d) { q[bl * 4 + d] = aq[d]; k[bl * 4 + d] = ak[d]; v[bl * 4 + d] = av[d]; }
        }
        const int s = tg * 4 + i;
        *(u32x4*)(G.Qs() + s * G.QP + cvi * 8) = pack8(q);
        *(u32x4*)(G.Ks() + s * G.QP + cvi * 8) = pack8(k);
        if ((cvi >> 3) == half) *(u32x4*)(G.Vs() + s * G.VP + (cvi & 7) * 8) = pack8(v);
        __builtin_amdgcn_sched_barrier(0);
      } }
    if (tid < 64) {
      const int s = tid;
      const float li = bf2f(pgi) + ib;
      const float fx = bf2f(pgf) + fb;
      const float lf = fminf(fx, 0.f) - __logf(1.0f + __expf(-fabsf(fx)));
      const float bc = wave_incl_sum(lf, s);
      const float cc = li - bc;
      const float pm = fmaxf(wave_incl_max(cc, s), mprev);
      const float pml = __shfl(pm, 63), bl = __shfl(bc, 63);
      G.P()[s] = -pm; G.Qv()[s] = -cc; G.I()[s] = mprev - pm; G.Wl()[s] = cc - pml; G.Mt()[s] = bc + pm; if (s == 0) G.gl()[0] = mprev - pml;
      mprev = bl + pml;
    }
    if (c + 1 < SEQ / 64) ML_PREFETCH(c + 1);
    __syncthreads();
    f32x4 y[5];
    G.compute_y(y);
#pragma unroll
    for (int j = 0; j < 4; ++j) {
      const float den = __shfl(y[4][j], G.lane & 48);
      const int s = G.w * 16 + G.fq * 4 + j, st = c * 64 + s, t = dir ? (SEQ - 1 - st) : st;
      const float dn = 1.0f / fmaxf(fabsf(den), __expf(-G.Mt()[s]));
#pragma unroll
      for (int vb = 0; vb < 4; ++vb) H[((size_t)b * SEQ + t) * 1024 + head * 128 + half * 64 + vb * 16 + G.fr] = f2bf(y[vb][j] * dn);
    }
    G.update();
  }
#undef ML_PREFETCH
}

DI void s5_item(const Ctx& c, int item, char* smem) {
  const Params& p = c.p; (void)p;
  constexpr int T = 32, XP = 136;
  const int dir = item >> 7, b = (item >> 3) & 15, gq = item & 7;
  const int tid = TIDX, lane = tid & 63, wave = tid >> 6, fr = lane & 15, fq = lane >> 4;
  const int g = gq * 4 + wave;
  float* Uw = (float*)smem + wave * (T * 16);
  bf16_t* Xw = (bf16_t*)(smem + 4 * T * 16 * 4) + wave * (T * XP);
  const bf16_t* U = (const bf16_t*)(p.ws + OFF_S5U);
  bf16_t* Y = (bf16_t*)(p.ws + OFF_S5Y) + (size_t)dir * NTOK * 512;
  const float dtv = expf(p.s5_log_dt[dir * 32 + g]);
  const float ar = fminf(p.s5_A_re[(dir * 32 + g) * 64 + lane], -1e-4f), ai = p.s5_A_im[(dir * 32 + g) * 64 + lane];
  const float mag = expf(dtv * ar), abr = mag * cosf(dtv * ai), abi = mag * sinf(dtv * ai);
  const float den = ar * ar + ai * ai;
  const float f_r = ((abr - 1.0f) * ar + abi * ai) / den, f_i = (abi * ar - (abr - 1.0f) * ai) / den;
  float bbr[16], bbi[16];
#pragma unroll
  for (int m = 0; m < 16; ++m) { const float br = p.s5_B_re[(g * 64 + lane) * 16 + m], bi = p.s5_B_im[(g * 64 + lane) * 16 + m]; bbr[m] = f_r * br - f_i * bi; bbi[m] = f_r * bi + f_i * br; }
  bf16x8 cf[4];
#pragma unroll
  for (int ks = 0; ks < 4; ++ks)
#pragma unroll
    for (int jj = 0; jj < 8; ++jj) { const int k = ks * 32 + fq * 8 + jj; const size_t base = ((size_t)(dir * 32 + g) * 16 + fr) * 64;
      cf[ks][jj] = (short)f2bf(k < 64 ? p.s5_C_re[base + k] : -p.s5_C_im[base + k - 64]); }
  float xr = 0.f, xi = 0.f;
  u32x4 pu;
#define S5_PREFETCH(c0_) do { const int s_ = lane >> 1, st_ = (c0_) + s_, t_ = dir ? (SEQ - 1 - st_) : st_; pu = ld8(U + ((size_t)b * SEQ + t_) * 512 + g * 16 + (lane & 1) * 8); } while (0)
  S5_PREFETCH(0);
  for (int c0 = 0; c0 < SEQ; c0 += T) {
    __syncthreads();
    { float uf[8]; unpack8(pu, uf); float* d = Uw + (lane >> 1) * 16 + (lane & 1) * 8; *(f32x4*)d = (f32x4){uf[0], uf[1], uf[2], uf[3]}; *(f32x4*)(d + 4) = (f32x4){uf[4], uf[5], uf[6], uf[7]}; }
    __syncthreads();
    if (c0 + T < SEQ) S5_PREFETCH(c0 + T);
#pragma unroll 4
    for (int s = 0; s < T; ++s) {
      float bur = 0.f, bui = 0.f;
#pragma unroll
      for (int m4 = 0; m4 < 4; ++m4) { const f32x4 uv = *(const f32x4*)(Uw + s * 16 + m4 * 4);
#pragma unroll
        for (int j = 0; j < 4; ++j) { bur += bbr[m4 * 4 + j] * uv[j]; bui += bbi[m4 * 4 + j] * uv[j]; } }
      const float nr = abr * xr - abi * xi + bur, ni = abr * xi + abi * xr + bui;
      xr = nr; xi = ni;
      Xw[s * XP + lane] = f2bf(xr); Xw[s * XP + 64 + lane] = f2bf(xi);
    }
    __syncthreads();
#pragma unroll
    for (int mb = 0; mb < 2; ++mb) {
      f32x4 y = (f32x4){0.f, 0.f, 0.f, 0.f};
#pragma unroll
      for (int ks = 0; ks < 4; ++ks) { const bf16x8 xa = *(const bf16x8*)(Xw + (mb * 16 + fr) * XP + ks * 32 + fq * 8); y = MFMA16(xa, cf[ks], y); }
#pragma unroll
      for (int j = 0; j < 4; ++j) { const int s = mb * 16 + fq * 4 + j, st = c0 + s, t = dir ? (SEQ - 1 - st) : st; Y[((size_t)b * SEQ + t) * 512 + g * 16 + fr] = f2bf(y[j]); }
    }
  }
#undef S5_PREFETCH
}

DI void phase_post0(const Ctx& c) {
  const Params& p = c.p; (void)p;
  const int lane = TIDX & 63, wid = TIDX >> 6;
  const int gw = blockIdx.x * 4 + wid, nw = gridDim.x * 4;
  {
    bf16_t* E0 = (bf16_t*)(p.ws + OFF_R1); const bf16_t* E1 = E0 + (size_t)NTOK * 512; const bf16_t* Ab = E1 + (size_t)NTOK * 512;
    const bf16_t* G = (const bf16_t*)(p.ws + OFF_XN); const bf16_t* RKV = (const bf16_t*)(p.ws + OFF_RKV);
    for (int u = gw; u < NTOK * 8; u += nw) {
      const int tok = u >> 3, h = u & 7, c = h * 64 + lane;
      const float y = bf2f(E0[(size_t)tok * 512 + c]) + bf2f(E1[(size_t)tok * 512 + c]);
      const float mean = wave_sum(y) * (1.0f / 64.0f); const float d = y - mean; const float var = wave_sum(d * d) * (1.0f / 64.0f);
      const float yn = d * rsqrtf(var + 64e-5f) * p.rw_ln_w[c];
      const float r = bf2f(RKV[(size_t)tok * 1536 + c]), k = bf2f(RKV[(size_t)tok * 1536 + 512 + c]), v = bf2f(RKV[(size_t)tok * 1536 + 1024 + c]);
      const float a = bf2f(Ab[(size_t)tok * 512 + c]);
      const float k2 = k * (1.0f + (a - 1.0f) * p.rw_k_a[c]);
      const float bonus = wave_sum(r * k2 * p.rw_r_k[c]) * v;
      E0[(size_t)tok * 512 + c] = f2bf((yn + bonus) * bf2f(G[(size_t)tok * 512 + c]));
    }
  }
  {
    bf16_t* raw = (bf16_t*)(p.ws + OFF_R2);
    const bf16_t* Y0 = (const bf16_t*)p.out; const bf16_t* Y1 = Y0 + (size_t)NTOK * 1024;
    const float* cw = p.mb_conv_w; const float* cb = p.mb_conv_b;
    for (int u = gw; u < NTOK * 2; u += nw) {
      const int tok = u >> 1, gq = u & 1, col = gq * 512 + lane * 8, head = col >> 6, t = tok & (SEQ - 1);
      float y0[8], y1[8], z[8], cur[8], prv[8], nxt[8], o[8];
      unpack8(ld8(Y0 + (size_t)tok * 1024 + col), y0); unpack8(ld8(Y1 + (size_t)tok * 1024 + col), y1);
      bf16_t* zp = raw + (size_t)tok * 2592 + col;
      unpack8(ld8(zp), z);
      const bf16_t* rp = zp + 1024;
      unpack8(ld8(rp), cur);
      if (t > 0) unpack8(ld8(rp - 2592), prv); else for (int j = 0; j < 8; ++j) prv[j] = 0.f;
      if (t < SEQ - 1) unpack8(ld8(rp + 2592), nxt); else for (int j = 0; j < 8; ++j) nxt[j] = 0.f;
      const float D = p.mb_D[head];
      float ss = 0.f;
#pragma unroll
      for (int j = 0; j < 8; ++j) { const float xs = siluf_(cb[col + j] + cw[col + j] * prv[j] + cw[1536 + col + j] * cur[j] + cw[3072 + col + j] * nxt[j]);
        const float yy = (y0[j] + y1[j] + D * xs) * siluf_(z[j]); o[j] = yy; ss += yy * yy; }
      ss = wave_sum(ss);
      const float rs = rsqrtf(ss * (1.0f / 512.0f) + 1e-5f);
#pragma unroll
      for (int j = 0; j < 8; ++j) o[j] = o[j] * rs * p.mb_norm_w[col + j];
      *(u32x4*)zp = pack8(o);
    }
  }
}

DI float gelu_tanh(float x) { const float u = 0.7978845608028654f * (x + 0.044715f * x * x * x); return 0.5f * x * (1.0f + tanhf(u)); }

DI void phase_post1(const Ctx& c) {
  const Params& p = c.p; (void)p;
  const int lane = TIDX & 63, wid = TIDX >> 6;
  const int gw = blockIdx.x * 4 + wid, nw = gridDim.x * 4;
  {
    const bf16_t* U = (const bf16_t*)(p.ws + OFF_S5U); const bf16_t* Y0 = (const bf16_t*)(p.ws + OFF_S5Y); const bf16_t* Y1 = Y0 + (size_t)NTOK * 512;
    bf16_t* YG = (bf16_t*)(p.ws + OFF_YG);
    for (int tok = gw; tok < NTOK; tok += nw) {
      const int col = lane * 8; float u[8], a[8], c[8], o[8];
      unpack8(ld8(U + (size_t)tok * 512 + col), u); unpack8(ld8(Y0 + (size_t)tok * 512 + col), a); unpack8(ld8(Y1 + (size_t)tok * 512 + col), c);
#pragma unroll
      for (int j = 0; j < 8; ++j) o[j] = gelu_tanh(p.s5_D[col + j] * u[j] + a[j] + c[j]);
      *(u32x4*)(YG + (size_t)tok * 512 + col) = pack8(o);
    }
  }
  {
    bf16_t* raw = (bf16_t*)(p.ws + OFF_MLRAW);
    const bf16_t* HF = (const bf16_t*)(p.ws + OFF_HFB); const bf16_t* HB = HF + (size_t)NTOK * 1024;
    for (int u = gw; u < NTOK * 8; u += nw) {
      const int tok = u >> 3, head = u & 7, c = head * 128 + lane * 2, t = tok & (SEQ - 1);
      const unsigned hf = *(const unsigned*)(HF + (size_t)tok * 1024 + c), hb = *(const unsigned*)(HB + (size_t)tok * 1024 + c);
      const float h0 = __uint_as_float(hf << 16) + __uint_as_float(hb << 16), h1 = __uint_as_float(hf & 0xffff0000u) + __uint_as_float(hb & 0xffff0000u);
      const float mean = wave_sum(h0 + h1) * (1.0f / 128.0f);
      const float d0 = h0 - mean, d1 = h1 - mean;
      const float var = wave_sum(d0 * d0 + d1 * d1) * (1.0f / 128.0f);
      const float rs = rsqrtf(var + 1e-5f);
      bf16_t* xp = raw + (size_t)tok * 2080 + c;
      const unsigned xc_ = *(const unsigned*)xp;
      const unsigned xp_ = t > 0 ? *(const unsigned*)(xp - 2080) : 0u, xn_ = t < SEQ - 1 ? *(const unsigned*)(xp + 2080) : 0u;
      const unsigned ov = *(const unsigned*)(xp + 1024);
      float o[2];
#pragma unroll
      for (int j = 0; j < 2; ++j) {
        const float cur = j ? __uint_as_float(xc_ & 0xffff0000u) : __uint_as_float(xc_ << 16);
        const float prv = j ? __uint_as_float(xp_ & 0xffff0000u) : __uint_as_float(xp_ << 16);
        const float nxt = j ? __uint_as_float(xn_ & 0xffff0000u) : __uint_as_float(xn_ << 16);
        const float og = j ? __uint_as_float(ov & 0xffff0000u) : __uint_as_float(ov << 16);
        const float xcv = siluf_(p.ml_conv_b[c + j] + p.ml_conv_w[c + j] * prv + p.ml_conv_w[1024 + c + j] * cur + p.ml_conv_w[2048 + c + j] * nxt);
        const float hn = (j ? d1 : d0) * rs * p.ml_norm_w[c + j];
        o[j] = sigmoidf_(og) * hn + p.ml_skip[c + j] * xcv;
      }
      *(unsigned*)(xp + 1024) = pack2(o[0], o[1]);
    }
  }
}

DI void phase_final(const Ctx& c) {
  const Params& p = c.p; (void)p;
  const int lane = TIDX & 63, wid = TIDX >> 6;
  for (int u = blockIdx.x; u < NTOK / 4; u += gridDim.x) {
    float* xr = p.out + (size_t)(u * 4 + wid) * 1024;
    f32x4 v[4]; float ss = 0.f;
#pragma unroll
    for (int i = 0; i < 4; ++i) { v[i] = *(const f32x4*)(xr + i * 256 + lane * 4); ss += v[i][0] * v[i][0] + v[i][1] * v[i][1] + v[i][2] * v[i][2] + v[i][3] * v[i][3]; }
    ss = wave_sum(ss);
    const float rs = rsqrtf(ss * (1.0f / 1024.0f) + 1e-5f);
#pragma unroll
    for (int i = 0; i < 4; ++i) { const f32x4 g = *(const f32x4*)(p.norm_final + i * 256 + lane * 4); *(f32x4*)(xr + i * 256 + lane * 4) = v[i] * rs * g; }
  }
}

constexpr int NPHASE = 20;
#ifdef NO_RW
#define RWK(x)
#else
#define RWK(x) x
#endif
#ifdef NO_MB
#define MBK(x)
#else
#define MBK(x) x
#endif
#ifndef ONLY_PHASE
#define ONLY_PHASE -1
#endif
#define PH(k) case k: if (ONLY_PHASE >= 0 && ONLY_PHASE != k) break;
template <int ph> DI void run_phase(const Ctx& c, char* smem) {
  const Params& p = c.p; (void)p;
  char* ws = p.ws;
  bf16_t* XN = (bf16_t*)(ws + OFF_XN);
  switch (ph) {
    PH(0) phase_prep(c, smem); break;
    PH(1) gemm_phase(smem, XN, 1024, 1 << 30, XN, 1024, (const bf16_t*)(ws + OFF_WABIN), 1024, 35,
                       EpiSplit{(bf16_t*)(ws + OFF_R1), 1792, 1792, (bf16_t*)(ws + OFF_R2), 2592, 2592}, TIDX); break;
    PH(2) phase_rw_shift(c); break;
    PH(3) phase_rw_small_gemms(c, smem); break;
    PH(4) {
      const int G = gridDim.x, bx = blockIdx.x;
      if (G >= 512) { if (bx < 256) { RWK(rwkv_item(c, bx, smem);) } else for (int u = bx - 256; u < 512; u += G - 256) { MBK(mamba_item(c, u, smem);) } }
      else { for (int u = bx; u < 256; u += G) { RWK(rwkv_item(c, u, smem);) } __syncthreads(); for (int u = bx + ((256 - bx + G - 1) / G) * G; u < 768; u += G) { MBK(mamba_item(c, u - 256, smem);) } }
    } break;
    PH(5) phase_post0(c); break;
    PH(6) gemm_phase(smem, (const bf16_t*)(ws + OFF_R1), 512, 512, (const bf16_t*)(ws + OFF_R2), 2592, (const bf16_t*)(ws + OFF_WABOUT), 1536, 8, EpiResid{p.x, p.out}, TIDX); break;
    PH(7) phase_rmsnorm(c, p.out, p.norm_mlp); break;
    PH(8) gemm_phase(smem, XN, 1024, 1 << 30, XN, 1024, (const bf16_t*)(ws + OFF_W1), 1024, 32, EpiRelu2{(bf16_t*)(ws + OFF_R1)}, TIDX); break;
    PH(9) gemm_phase(smem, (const bf16_t*)(ws + OFF_R1), 4096, 1 << 30, XN, 1024, (const bf16_t*)(ws + OFF_W2), 4096, 8, EpiResid{p.out, p.out}, TIDX); break;
    PH(10) phase_rmsnorm(c, p.out, p.norm_mix + 1024); break;
    PH(11) gemm_phase(smem, XN, 1024, 1 << 30, XN, 1024, (const bf16_t*)(ws + OFF_WCDIN), 1024, 21,
                        EpiSplit{(bf16_t*)(ws + OFF_S5U), 512, 512, (bf16_t*)(ws + OFF_MLRAW), 2080, 2080}, TIDX); break;
    PH(12) {
      const int G = gridDim.x, bx = blockIdx.x;
      for (int u = bx; u < 512; u += G) mlstm_item(c, u, smem);
      __syncthreads();
      { int u0 = bx + ((512 - bx + G - 1) / G) * G; for (int u = u0; u < 768; u += G) s5_item(c, u - 512, smem); }
    } break;
    PH(13) phase_post1(c); break;
    PH(14) gemm_phase(smem, (const bf16_t*)(ws + OFF_YG), 512, 1 << 30, XN, 1024, (const bf16_t*)(ws + OFF_WGLU), 512, 4,
                        EpiGlu{(const bf16_t*)(ws + OFF_YG), p.s5_glu_b, (bf16_t*)(ws + OFF_S5Y)}, TIDX); break;
    PH(15) gemm_phase(smem, (const bf16_t*)(ws + OFF_S5Y), 512, 512, (const bf16_t*)(ws + OFF_MLRAW) + 1024, 2080, (const bf16_t*)(ws + OFF_WCDOUT), 1536, 8, EpiResid{p.out, p.out}, TIDX); break;
    PH(16) phase_rmsnorm(c, p.out, p.norm_mlp + 1024); break;
    PH(17) gemm_phase(smem, XN, 1024, 1 << 30, XN, 1024, (const bf16_t*)(ws + OFF_W1) + 4096ull * 1024, 1024, 32, EpiRelu2{(bf16_t*)(ws + OFF_R1)}, TIDX); break;
    PH(18) gemm_phase(smem, (const bf16_t*)(ws + OFF_R1), 4096, 1 << 30, XN, 1024, (const bf16_t*)(ws + OFF_W2) + 4096ull * 1024, 4096, 8, EpiResid{p.out, p.out}, TIDX); break;
    PH(19) phase_final(c); break;
    default: break;
  }
}

DI void grid_barrier(const Ctx& c, unsigned idx) {
  const Params& p = c.p; (void)p;
  asm volatile("s_waitcnt vmcnt(0)" ::: "memory");
  __syncthreads();
  if (TIDX == 0) {
    unsigned* cnt = (unsigned*)(p.ws + OFF_BAR);
    __builtin_amdgcn_fence(__ATOMIC_RELEASE, "agent");
    asm volatile("s_waitcnt vmcnt(0)" ::: "memory");
    __hip_atomic_fetch_add(cnt, 1u, __ATOMIC_RELAXED, __HIP_MEMORY_SCOPE_AGENT);
    const unsigned target = idx * gridDim.x;
    while (__hip_atomic_load(cnt, __ATOMIC_RELAXED, __HIP_MEMORY_SCOPE_AGENT) < target) __builtin_amdgcn_s_sleep(1);
    __builtin_amdgcn_fence(__ATOMIC_ACQUIRE, "agent");
    asm volatile("s_waitcnt vmcnt(0)" ::: "memory");
  }
  __syncthreads();
}
template <int PHI> DI void run_from(const Ctx& c, char* smem, int ph0, int ph1) {
  const Params& p = c.p; (void)p;
  if constexpr (PHI < NPHASE) {
    if (ph0 <= PHI && PHI < ph1) {
      run_phase<PHI>(c, smem);
      if (PHI + 1 < ph1) {
        if constexpr (PHI == 0) { __syncthreads(); cg::this_grid().sync(); }
        else grid_barrier(c, (unsigned)PHI);
      }
    }
    run_from<PHI + 1>(c, smem, ph0, ph1);
  }
}

__global__ void __launch_bounds__(256, 2) mega(Params p, int ph0, int ph1) {
  extern __shared__ __attribute__((aligned(16))) char smem[];
  const Ctx c{p, __builtin_amdgcn_readfirstlane((int)(__builtin_amdgcn_workitem_id_x() >> 6))};
  run_from<0>(c, smem, ph0, ph1);
}

#ifndef ONE_LAUNCH
#define ONE_LAUNCH 1
#endif

extern "C" void kernel_launch(void* const* d_in, const int* in_sizes, int n_in, void* d_out, int out_size, void* d_ws, size_t ws_size,
                              hipStream_t stream) {
  static int grid_blocks = 0;
  if (!grid_blocks) {
    hipFuncSetAttribute((const void*)mega, hipFuncAttributeMaxDynamicSharedMemorySize, LDS_BYTES);
    int dev = 0, cus = 0, per_cu = 0;
    hipGetDevice(&dev);
    hipDeviceGetAttribute(&cus, hipDeviceAttributeMultiprocessorCount, dev);
    hipOccupancyMaxActiveBlocksPerMultiprocessor(&per_cu, mega, 256, LDS_BYTES);
    if (per_cu > 2) per_cu = 2;
    if (per_cu < 1) per_cu = 1;
    grid_blocks = cus * per_cu;
  }
  Params p{};
  const float** pf = (const float**)&p;
  for (int i = 0; i < 45; ++i) pf[i] = (const float*)d_in[i];
  p.out = (float*)d_out;
  p.ws = (char*)d_ws;
#if ONE_LAUNCH
  int ph0 = 0, ph1 = NPHASE;
  void* args[] = {&p, &ph0, &ph1};
  hipError_t e = hipLaunchCooperativeKernel((const void*)mega, dim3(grid_blocks), dim3(256), args, LDS_BYTES, stream);
  if (e != hipSuccess) fprintf(stderr, "cooperative launch failed: %s (grid %d)\n", hipGetErrorString(e), grid_blocks);
#else
  for (int ph = 0; ph < NPHASE; ++ph) hipLaunchKernelGGL(mega, dim3(grid_blocks), dim3(256), LDS_BYTES, stream, p, ph, ph + 1);
#endif
}
```

```cpp
#include <hip/hip_runtime.h>
#include <hip/hip_cooperative_groups.h>
#include <stdint.h>
#include <cstdio>
namespace cg = cooperative_groups;

typedef unsigned short bf16_t;
typedef short bf16x8 __attribute__((ext_vector_type(8)));
typedef float f32x4 __attribute__((ext_vector_type(4)));
typedef unsigned u32x4 __attribute__((ext_vector_type(4)));
typedef unsigned u32x2 __attribute__((ext_vector_type(2)));

#define DI __device__ __forceinline__
#define LANEID() ((int)__builtin_amdgcn_mbcnt_hi(~0u, __builtin_amdgcn_mbcnt_lo(~0u, 0u)))
#define TIDX (c.wid * 64 + LANEID())
#define MFMA16(a, b, c) __builtin_amdgcn_mfma_f32_16x16x32_bf16((a), (b), (c), 0, 0, 0)

constexpr int NTOK = 32768, SEQ = 2048;
constexpr size_t MiB = 1ull << 20;
constexpr size_t OFF_WABIN = 0;
constexpr size_t OFF_WABOUT = OFF_WABIN + 4480ull * 1024 * 2;
constexpr size_t OFF_W1 = OFF_WABOUT + 1024ull * 1536 * 2;
constexpr size_t OFF_W2 = OFF_W1 + 2ull * 4096 * 1024 * 2;
constexpr size_t OFF_WCDIN = OFF_W2 + 2ull * 4096 * 1024 * 2;
constexpr size_t OFF_WCDOUT = OFF_WCDIN + 2688ull * 1024 * 2;
constexpr size_t OFF_WGLU = OFF_WCDOUT + 1024ull * 1536 * 2;
constexpr size_t OFF_WG2 = OFF_WGLU + 512ull * 512 * 2;
constexpr size_t OFF_WW2 = OFF_WG2 + 512ull * 128 * 2;
constexpr size_t OFF_WA2 = OFF_WW2 + 2ull * 512 * 64 * 2;
constexpr size_t OFF_WEND = OFF_WA2 + 512ull * 64 * 2;
static_assert(OFF_WEND <= 56 * MiB, "weights region");
constexpr size_t OFF_XN = 56 * MiB;
constexpr size_t OFF_R1 = 120 * MiB;
constexpr size_t OFF_R2 = 232 * MiB;
constexpr size_t OFF_RKV = 394 * MiB;
constexpr size_t OFF_SM = 490 * MiB;
constexpr size_t OFF_S5U = 120 * MiB;
constexpr size_t OFF_MLRAW = 152 * MiB;
constexpr size_t OFF_S5Y = 282 * MiB;
constexpr size_t OFF_HFB = 346 * MiB;
constexpr size_t OFF_YG = 474 * MiB;
constexpr size_t OFF_BAR = 510 * MiB;
constexpr int LDS_BYTES = 79872;

struct Params {
  const float *x, *norm_mix, *norm_mlp, *norm_final, *mlp_w1, *mlp_w2, *ab_w_in, *ab_w_out, *rw_mu, *rw_w0, *rw_w2, *rw_a0,
      *rw_a2, *rw_g2, *rw_k_k, *rw_k_a, *rw_r_k, *rw_ln_w, *mb_conv_w, *mb_conv_b, *mb_dt_bias, *mb_A_log, *mb_D, *mb_norm_w,
      *cd_w_in, *cd_w_out, *s5_A_re, *s5_A_im, *s5_log_dt, *s5_B_re, *s5_B_im, *s5_C_re, *s5_C_im, *s5_D, *s5_glu_w, *s5_glu_b,
      *ml_conv_w, *ml_conv_b, *ml_wq, *ml_wk, *ml_wv, *ml_i_b, *ml_f_b, *ml_norm_w, *ml_skip;
  float* out;
  char* ws;
};
struct Ctx { const Params& p; int wid; };

DI float bf2f(bf16_t v) { return __uint_as_float(((unsigned)v) << 16); }
typedef float f32x2c __attribute__((ext_vector_type(2)));
typedef __bf16 bf16x2c __attribute__((ext_vector_type(2)));
DI unsigned pack2(float lo, float hi) { const f32x2c v = {lo, hi}; return __builtin_bit_cast(unsigned, __builtin_convertvector(v, bf16x2c)); }
DI bf16_t f2bf(float x) { return (bf16_t)(pack2(x, x) & 0xffffu); }
DI void unpack8(u32x4 w, float* f) {
#pragma unroll
  for (int i = 0; i < 4; ++i) { f[2 * i] = __uint_as_float(w[i] << 16); f[2 * i + 1] = __uint_as_float(w[i] & 0xffff0000u); }
}
DI u32x4 pack8(const float* f) { u32x4 w; w.x = pack2(f[0], f[1]); w.y = pack2(f[2], f[3]); w.z = pack2(f[4], f[5]); w.w = pack2(f[6], f[7]); return w; }
DI u32x4 ld8(const bf16_t* p) { return *(const u32x4*)p; }
template <int CTRL> DI float dpp_mov(float v) { return __int_as_float(__builtin_amdgcn_update_dpp(0, __float_as_int(v), CTRL, 0xF, 0xF, true)); }
DI float sum8(float v) { v += dpp_mov<0xB1>(v); v += dpp_mov<0x4E>(v); v += dpp_mov<0x141>(v); return v; }
DI float wave_sum(float v) {
  v = sum8(v); v += dpp_mov<0x140>(v);
  v += __shfl_xor(v, 16); v += __shfl_xor(v, 32);
  return v;
}
DI float sigmoidf_(float x) { return __builtin_amdgcn_rcpf(1.0f + __expf(-x)); }
DI float siluf_(float x) { return x * __builtin_amdgcn_rcpf(1.0f + __expf(-x)); }
DI float softplusf_(float x) { return x > 20.f ? x : log1pf(expf(x)); }
DI float wave_incl_sum(float v, int lane) {
#pragma unroll
  for (int o = 1; o < 64; o <<= 1) { float t = __shfl_up(v, o); if (lane >= o) v += t; }
  return v;
}
DI float wave_incl_max(float v, int lane) {
#pragma unroll
  for (int o = 1; o < 64; o <<= 1) { float t = __shfl_up(v, o); if (lane >= o) v = fmaxf(v, t); }
  return v;
}

DI bool get_tdesc(const Ctx& c, int i, const float*& src, bf16_t*& dst, int& K, int& Nsrc, int& Npad) {
  const Params& p = c.p; (void)p;
  char* ws = p.ws;
  switch (i) {
    case 0: src = p.ab_w_in; dst = (bf16_t*)(ws + OFF_WABIN); K = 1024; Nsrc = 4384; Npad = 4480; return true;
    case 1: src = p.ab_w_out; dst = (bf16_t*)(ws + OFF_WABOUT); K = 1536; Nsrc = 1024; Npad = 1024; return true;
    case 2: src = p.mlp_w1; dst = (bf16_t*)(ws + OFF_W1); K = 1024; Nsrc = 4096; Npad = 4096; return true;
    case 3: src = p.mlp_w1 + 1024ull * 4096; dst = (bf16_t*)(ws + OFF_W1) + 4096ull * 1024; K = 1024; Nsrc = 4096; Npad = 4096; return true;
    case 4: src = p.mlp_w2; dst = (bf16_t*)(ws + OFF_W2); K = 4096; Nsrc = 1024; Npad = 1024; return true;
    case 5: src = p.mlp_w2 + 4096ull * 1024; dst = (bf16_t*)(ws + OFF_W2) + 4096ull * 1024; K = 4096; Nsrc = 1024; Npad = 1024; return true;
    case 6: src = p.cd_w_in; dst = (bf16_t*)(ws + OFF_WCDIN); K = 1024; Nsrc = 2592; Npad = 2688; return true;
    case 7: src = p.cd_w_out; dst = (bf16_t*)(ws + OFF_WCDOUT); K = 1536; Nsrc = 1024; Npad = 1024; return true;
    case 8: src = p.s5_glu_w; dst = (bf16_t*)(ws + OFF_WGLU); K = 512; Nsrc = 512; Npad = 512; return true;
    case 9: src = p.rw_g2; dst = (bf16_t*)(ws + OFF_WG2); K = 128; Nsrc = 512; Npad = 512; return true;
    case 10: src = p.rw_w2; dst = (bf16_t*)(ws + OFF_WW2); K = 64; Nsrc = 512; Npad = 512; return true;
    case 11: src = p.rw_w2 + 64 * 512; dst = (bf16_t*)(ws + OFF_WW2) + 512 * 64; K = 64; Nsrc = 512; Npad = 512; return true;
    case 12: src = p.rw_a2; dst = (bf16_t*)(ws + OFF_WA2); K = 64; Nsrc = 512; Npad = 512; return true;
    default: return false;
  }
}

DI void rmsnorm_row_to_bf16(const float* __restrict__ xr, const float* __restrict__ w, bf16_t* __restrict__ o, int lane) {
  f32x4 v[4]; float ss = 0.f;
#pragma unroll
  for (int i = 0; i < 4; ++i) { v[i] = *(const f32x4*)(xr + i * 256 + lane * 4); ss += v[i][0] * v[i][0] + v[i][1] * v[i][1] + v[i][2] * v[i][2] + v[i][3] * v[i][3]; }
  ss = wave_sum(ss);
  const float rs = rsqrtf(ss * (1.0f / 1024.0f) + 1e-5f);
#pragma unroll
  for (int i = 0; i < 4; ++i) { const f32x4 g = *(const f32x4*)(w + i * 256 + lane * 4); u32x2 q; q.x = pack2(v[i][0] * rs * g[0], v[i][1] * rs * g[1]); q.y = pack2(v[i][2] * rs * g[2], v[i][3] * rs * g[3]); *(u32x2*)(o + i * 256 + lane * 4) = q; }
}

DI void phase_rmsnorm(const Ctx& c, const float* src, const float* w) {
  const Params& p = c.p; (void)p;
  bf16_t* xn = (bf16_t*)(p.ws + OFF_XN);
  const int lane = TIDX & 63, wid = TIDX >> 6;
  for (int u = blockIdx.x; u < NTOK / 4; u += gridDim.x) { const int row = u * 4 + wid; rmsnorm_row_to_bf16(src + (size_t)row * 1024, w, xn + (size_t)row * 1024, lane); }
}

DI void phase_prep(const Ctx& c, char* smem) {
  const Params& p = c.p; (void)p;
  if (blockIdx.x == 0 && TIDX == 0) __hip_atomic_store((unsigned*)(p.ws + OFF_BAR), 0u, __ATOMIC_RELAXED, __HIP_MEMORY_SCOPE_AGENT);
  float* tile = (float*)smem;
  const int tid = TIDX;
  int ntr = 0;
  for (int i = 0; i < 13; ++i) { const float* s; bf16_t* d; int K, Ns, Np; get_tdesc(c, i, s, d, K, Ns, Np); ntr += (K / 64) * (Np / 64); }
  for (int u = blockIdx.x; u < ntr; u += gridDim.x) {
    const float* src = nullptr; bf16_t* dst = nullptr; int K = 64, Ns = 0, Np = 64, r = u;
    for (int mi = 0; mi < 13; ++mi) { get_tdesc(c, mi, src, dst, K, Ns, Np); const int nt = (K / 64) * (Np / 64); if (r < nt) break; r -= nt; }
    const int nkb = K / 64, kb = r % nkb, nb = r / nkb;
    __syncthreads();
#pragma unroll
    for (int i = 0; i < 16; ++i) { const int k = i * 4 + (tid >> 6), n = tid & 63; const int gn = nb * 64 + n; tile[k * 65 + n] = gn < Ns ? src[(size_t)(kb * 64 + k) * Ns + gn] : 0.f; }
    __syncthreads();
    const int n = tid >> 2, ks = (tid & 3) * 16; float f[16];
#pragma unroll
    for (int j = 0; j < 16; ++j) f[j] = tile[(ks + j) * 65 + n];
    bf16_t* o = dst + (size_t)(nb * 64 + n) * K + kb * 64 + ks;
    *(u32x4*)o = pack8(f); *(u32x4*)(o + 8) = pack8(f + 8);
  }
  phase_rmsnorm(c, p.x, p.norm_mix);
}

template <class Epi>
DI void gemm_tile(char* smem, const bf16_t* __restrict__ A0, int lda0, int ksplit, const bf16_t* __restrict__ A1, int lda1,
                  const bf16_t* __restrict__ Bt, int K, int row0, int col0, const Epi& epi, int tid) {
  constexpr int BK = 32, PITCH = 40, BUF = (256 + 128) * PITCH;
  bf16_t* sbase = (bf16_t*)smem;
  const int lane = tid & 63, wid = tid >> 6, wr = wid >> 1, wc = wid & 1, fr = lane & 15, fq = lane >> 4;
  f32x4 acc[8][4];
#pragma unroll
  for (int m = 0; m < 8; ++m)
#pragma unroll
    for (int n = 0; n < 4; ++n) acc[m][n] = (f32x4){0.f, 0.f, 0.f, 0.f};
  u32x4 ra[2][4], rb[2][2];
  const int nk = K / BK;
  const int sr = tid >> 2, scv = tid & 3;
#define GLOAD(S, kt) do { const int k0_ = (kt) * BK; const bf16_t* Ab_; int lda_, kk_; \
    if (k0_ < ksplit) { Ab_ = A0; lda_ = lda0; kk_ = k0_; } else { Ab_ = A1; lda_ = lda1; kk_ = k0_ - ksplit; } \
    _Pragma("unroll") for (int i_ = 0; i_ < 4; ++i_) ra[S][i_] = *(const u32x4*)(Ab_ + (size_t)(row0 + sr + i_ * 64) * lda_ + kk_ + scv * 8); \
    _Pragma("unroll") for (int i_ = 0; i_ < 2; ++i_) rb[S][i_] = *(const u32x4*)(Bt + (size_t)(col0 + sr + i_ * 64) * K + k0_ + scv * 8); } while (0)
#define LWRITE(S, buf) do { bf16_t* sA_ = sbase + (buf) * BUF; bf16_t* sB_ = sA_ + 256 * PITCH; \
    _Pragma("unroll") for (int i_ = 0; i_ < 4; ++i_) *(u32x4*)(sA_ + (sr + i_ * 64) * PITCH + scv * 8) = ra[S][i_]; \
    _Pragma("unroll") for (int i_ = 0; i_ < 2; ++i_) *(u32x4*)(sB_ + (sr + i_ * 64) * PITCH + scv * 8) = rb[S][i_]; } while (0)
#define COMPUTE(buf) do { const bf16_t* sA_ = sbase + (buf) * BUF; const bf16_t* sB_ = sA_ + 256 * PITCH; \
    bf16x8 bfr[4]; \
    _Pragma("unroll") for (int n = 0; n < 4; ++n) bfr[n] = *(const bf16x8*)(sB_ + (wc * 64 + n * 16 + fr) * PITCH + fq * 8); \
    _Pragma("unroll") for (int m = 0; m < 8; ++m) { const bf16x8 af = *(const bf16x8*)(sA_ + (wr * 128 + m * 16 + fr) * PITCH + fq * 8); \
      _Pragma("unroll") for (int n = 0; n < 4; ++n) acc[m][n] = MFMA16(bfr[n], af, acc[m][n]); } } while (0)
  __syncthreads();
  {
    const int last = nk - 1;
    GLOAD(0, 0);
    __builtin_amdgcn_sched_barrier(0);
    GLOAD(1, 1);
    __builtin_amdgcn_sched_barrier(0);
    LWRITE(0, 0);
    __builtin_amdgcn_sched_barrier(0);
    GLOAD(0, (2 < last ? 2 : last));
    __builtin_amdgcn_sched_barrier(0);
    __syncthreads();
    for (int kt = 0; kt < nk; kt += 2) {
      LWRITE(1, 1);
      __builtin_amdgcn_sched_barrier(0);
      GLOAD(1, (kt + 3 < last ? kt + 3 : last));
      __builtin_amdgcn_sched_barrier(0);
      COMPUTE(0);
      __syncthreads();
      LWRITE(0, 0);
      __builtin_amdgcn_sched_barrier(0);
      GLOAD(0, (kt + 4 < last ? kt + 4 : last));
      __builtin_amdgcn_sched_barrier(0);
      COMPUTE(1);
      __syncthreads();
    }
  }
#undef GLOAD
#undef LWRITE
#undef COMPUTE
#pragma unroll
  for (int m = 0; m < 8; ++m)
#pragma unroll
    for (int n = 0; n < 4; ++n) epi(row0 + wr * 128 + m * 16 + fr, col0 + wc * 64 + n * 16 + fq * 4, acc[m][n]);
}

DI void st_bf16x4(bf16_t* o, f32x4 v) { u32x2 q; q.x = pack2(v[0], v[1]); q.y = pack2(v[2], v[3]); *(u32x2*)o = q; }

struct EpiSplit {
  bf16_t* o0; int ld0, n0; bf16_t* o1; int ld1, n1;
  DI void operator()(int row, int col, f32x4 v) const {
    if (col < n0) st_bf16x4(o0 + (size_t)row * ld0 + col, v);
    else { const int c = col - n0; if (c < n1) st_bf16x4(o1 + (size_t)row * ld1 + c, v); }
  }
};
struct EpiSmall { int mode; const float* b0; bf16_t* o;
  DI void operator()(int row, int col, f32x4 v) const { f32x4 r;
    if (mode == 2) r = v; else { for (int j = 0; j < 4; ++j) r[j] = sigmoidf_(b0[col + j] + v[j]); if (mode == 0) r *= 0.60653066f; }
    st_bf16x4(o + (size_t)row * 512 + col, r); } };
struct EpiStore { bf16_t* o; int ld;
  DI void operator()(int row, int col, f32x4 v) const { st_bf16x4(o + (size_t)row * ld + col, v); } };
struct EpiResid { const float* res; float* o;
  DI void operator()(int row, int col, f32x4 v) const { const f32x4 r = *(const f32x4*)(res + (size_t)row * 1024 + col); *(f32x4*)(o + (size_t)row * 1024 + col) = r + v; } };
struct EpiRelu2 { bf16_t* o;
  DI void operator()(int row, int col, f32x4 v) const { f32x4 r; for (int j = 0; j < 4; ++j) { const float t = fmaxf(v[j], 0.f); r[j] = t * t; } st_bf16x4(o + (size_t)row * 4096 + col, r); } };
struct EpiGlu { const bf16_t* y; const float* b; bf16_t* o;
  DI void operator()(int row, int col, f32x4 v) const { const u32x2 q = *(const u32x2*)(y + (size_t)row * 512 + col); f32x4 r;
    const float y0 = __uint_as_float(q.x << 16), y1 = __uint_as_float(q.x & 0xffff0000u), y2 = __uint_as_float(q.y << 16), y3 = __uint_as_float(q.y & 0xffff0000u);
    r[0] = y0 * sigmoidf_(v[0] + b[col]); r[1] = y1 * sigmoidf_(v[1] + b[col + 1]); r[2] = y2 * sigmoidf_(v[2] + b[col + 2]); r[3] = y3 * sigmoidf_(v[3] + b[col + 3]);
    st_bf16x4(o + (size_t)row * 512 + col, r); } };

template <class Epi>
DI void gemm_phase(char* smem, const bf16_t* A0, int lda0, int ksplit, const bf16_t* A1, int lda1, const bf16_t* Bt, int K, int nN, const Epi& epi, int tid) {
  const int G = gridDim.x;
  if ((G & 7) == 0) {
    const int x = blockIdx.x & 7, l = blockIdx.x >> 3, L = G >> 3, per = 8 * nN, tot = 2 * per;
    for (int q = l; q < tot; q += L) { const int rgl = q / per, rem = q % per, ct = rem >> 3, rt = (x * 2 + rgl) * 8 + (rem & 7);
      gemm_tile(smem, A0, lda0, ksplit, A1, lda1, Bt, K, rt * 256, ct * 128, epi, tid); }
  } else {
    const int ntiles = (NTOK / 256) * nN;
    for (int u = blockIdx.x; u < ntiles; u += G) { const int rt = u / nN, ct = u % nN; gemm_tile(smem, A0, lda0, ksplit, A1, lda1, Bt, K, rt * 256, ct * 128, epi, tid); }
  }
}

DI void phase_rw_shift(const Ctx& c) {
  const Params& p = c.p; (void)p;
  const bf16_t* raw = (const bf16_t*)(p.ws + OFF_R1);
  bf16_t* rkv = (bf16_t*)(p.ws + OFF_RKV); bf16_t* sm = (bf16_t*)(p.ws + OFF_SM);
  const float* mu = p.rw_mu;
  const size_t total = (size_t)NTOK * 224;
  for (size_t i = (size_t)blockIdx.x * 256 + TIDX; i < total; i += (size_t)gridDim.x * 256) {
    const int tok = (int)(i / 224), cv = (int)(i % 224), c = cv * 8, s = tok & (SEQ - 1);
    const bf16_t* rp = raw + (size_t)tok * 1792 + c;
    float cur[8], prv[8], nxt[8], o[8];
    unpack8(ld8(rp), cur);
    if (s > 0) unpack8(ld8(rp - 1792), prv); else for (int j = 0; j < 8; ++j) prv[j] = 0.f;
    if (s < SEQ - 1) unpack8(ld8(rp + 1792), nxt); else for (int j = 0; j < 8; ++j) nxt[j] = 0.f;
#pragma unroll
    for (int j = 0; j < 8; ++j) o[j] = cur[j] + mu[c + j] * (prv[j] - cur[j]) + mu[1792 + c + j] * (nxt[j] - cur[j]);
    if (c < 1536) *(u32x4*)(rkv + (size_t)tok * 1536 + c) = pack8(o);
    else if (c < 1600) { for (int j = 0; j < 8; ++j) o[j] = tanhf(o[j]); *(u32x4*)(sm + (size_t)tok * 256 + (c - 1536)) = pack8(o); }
    else if (c < 1664) *(u32x4*)(sm + (size_t)tok * 256 + 64 + (c - 1600)) = pack8(o);
    else { for (int j = 0; j < 8; ++j) o[j] = sigmoidf_(o[j]); *(u32x4*)(sm + (size_t)tok * 256 + 128 + (c - 1664)) = pack8(o); }
  }
  const bf16_t* mraw = (const bf16_t*)(p.ws + OFF_R2); bf16_t* BC = (bf16_t*)(p.ws + OFF_XN + 32 * MiB);
  const float* cw = p.mb_conv_w; const float* cb = p.mb_conv_b;
  const size_t total2 = (size_t)NTOK * 64;
  for (size_t i = (size_t)blockIdx.x * 256 + TIDX; i < total2; i += (size_t)gridDim.x * 256) {
    const int tok = (int)(i >> 6), cv = (int)(i & 63), xc = 1024 + cv * 8, t = tok & (SEQ - 1);
    const bf16_t* rp = mraw + (size_t)tok * 2592 + 1024 + xc;
    float cur[8], prv[8], nxt[8], o[8];
    unpack8(ld8(rp), cur);
    if (t > 0) unpack8(ld8(rp - 2592), prv); else for (int j = 0; j < 8; ++j) prv[j] = 0.f;
    if (t < SEQ - 1) unpack8(ld8(rp + 2592), nxt); else for (int j = 0; j < 8; ++j) nxt[j] = 0.f;
#pragma unroll
    for (int j = 0; j < 8; ++j) o[j] = siluf_(cb[xc + j] + cw[xc + j] * prv[j] + cw[1536 + xc + j] * cur[j] + cw[3072 + xc + j] * nxt[j]);
    *(u32x4*)(BC + (size_t)tok * 512 + cv * 8) = pack8(o);
  }
}

DI void phase_rw_small_gemms(const Ctx& c, char* smem) {
  const Params& p = c.p; (void)p;
  const int tid = TIDX;
  const bf16_t* sm = (const bf16_t*)(p.ws + OFF_SM);
  bf16_t* E0 = (bf16_t*)(p.ws + OFF_R1); bf16_t* E1 = E0 + (size_t)NTOK * 512; bf16_t* Ab = E1 + (size_t)NTOK * 512;
  bf16_t* G = (bf16_t*)(p.ws + OFF_XN);
  const bf16_t* W2 = (const bf16_t*)(p.ws + OFF_WW2); const bf16_t* A2 = (const bf16_t*)(p.ws + OFF_WA2); const bf16_t* G2 = (const bf16_t*)(p.ws + OFF_WG2);
  gemm_phase(smem, sm, 256, 1 << 30, sm, 256, W2, 64, 4, EpiSmall{0, p.rw_w0, E0}, tid);
  gemm_phase(smem, sm, 256, 1 << 30, sm, 256, W2 + 512 * 64, 64, 4, EpiSmall{0, p.rw_w0 + 512, E1}, tid);
  gemm_phase(smem, sm + 64, 256, 1 << 30, sm, 256, A2, 64, 4, EpiSmall{1, p.rw_a0, Ab}, tid);
  gemm_phase(smem, sm + 128, 256, 1 << 30, sm, 256, G2, 128, 4, EpiSmall{2, p.rw_a0, G}, tid);
}

typedef float f32x2 __attribute__((ext_vector_type(2)));
DI void rwkv_item(const Ctx& c, int item, char* smem) {
  const Params& p = c.p; (void)p;
  constexpr int T = 32;
  const int dir = item >> 7, b = (item >> 3) & 15, h = item & 7;
  const int tid = TIDX, lane = tid & 63, wave = tid >> 6, rp = tid >> 3, kq = tid & 7;
  float* op = (float*)smem;
  float* yo = op + T * 6 * 64;
  const bf16_t* RKV = (const bf16_t*)(p.ws + OFF_RKV);
  bf16_t* E0 = (bf16_t*)(p.ws + OFF_R1); bf16_t* Ed = E0 + (size_t)dir * NTOK * 512; const bf16_t* Ab = E0 + (size_t)2 * NTOK * 512;
  const float kkw = p.rw_k_k[h * 64 + lane], kaw = p.rw_k_a[h * 64 + lane];
  f32x2 S0[4], S1[4];
#pragma unroll
  for (int j = 0; j < 4; ++j) { S0[j] = (f32x2){0.f, 0.f}; S1[j] = (f32x2){0.f, 0.f}; }
  bf16_t pr[8], pk[8], pv[8], pa[8], pe[8];
#define RW_PREFETCH(c0_) do { _Pragma("unroll") for (int i = 0; i < 8; ++i) { const int st_ = (c0_) + wave * 8 + i, t_ = dir ? (SEQ - 1 - st_) : st_; const size_t tok_ = (size_t)b * SEQ + t_; \
    pr[i] = RKV[tok_ * 1536 + h * 64 + lane]; pk[i] = RKV[tok_ * 1536 + 512 + h * 64 + lane]; pv[i] = RKV[tok_ * 1536 + 1024 + h * 64 + lane]; \
    pa[i] = Ab[tok_ * 512 + h * 64 + lane]; pe[i] = Ed[tok_ * 512 + h * 64 + lane]; } } while (0)
  RW_PREFETCH(0);
  for (int c0 = 0; c0 < SEQ; c0 += T) {
    __syncthreads();
#pragma unroll
    for (int i = 0; i < 8; ++i) {
      const int s = wave * 8 + i;
      const float r = bf2f(pr[i]), k = bf2f(pk[i]), v = bf2f(pv[i]), a = bf2f(pa[i]), e = bf2f(pe[i]);
      float kk = k * kkw; const float ss = wave_sum(kk * kk); kk *= rsqrtf(fmaxf(ss, 1e-12f));
      float* o = op + s * 384;
      o[lane] = __expf(-e); o[64 + lane] = k * (1.0f + (a - 1.0f) * kaw); o[128 + lane] = -kk; o[192 + lane] = kk * a; o[256 + lane] = r; o[320 + lane] = v;
    }
    __syncthreads();
    if (c0 + T < SEQ) RW_PREFETCH(c0 + T);
#pragma unroll 2
    for (int s = 0; s < T; ++s) {
      const float* o = op + s * 384 + kq * 8;
      const f32x4 a0 = *(const f32x4*)(o + 128), a1 = *(const f32x4*)(o + 132);
      const f32x2 av[4] = {(f32x2){a0[0], a0[1]}, (f32x2){a0[2], a0[3]}, (f32x2){a1[0], a1[1]}, (f32x2){a1[2], a1[3]}};
      f32x2 t0 = S0[0] * av[0], t1 = S1[0] * av[0];
#pragma unroll
      for (int j = 1; j < 4; ++j) { t0 += S0[j] * av[j]; t1 += S1[j] * av[j]; }
      float sa0 = t0[0] + t0[1], sa1 = t1[0] + t1[1];
      sa0 = sum8(sa0); sa1 = sum8(sa1);
      const f32x2 vv = *(const f32x2*)(op + s * 384 + 320 + rp * 2);
      const f32x4 w0 = *(const f32x4*)(o), w1 = *(const f32x4*)(o + 4), k0 = *(const f32x4*)(o + 64), k1 = *(const f32x4*)(o + 68);
      const f32x4 b0 = *(const f32x4*)(o + 192), b1 = *(const f32x4*)(o + 196), r0 = *(const f32x4*)(o + 256), r1 = *(const f32x4*)(o + 260);
      const f32x2 wv[4] = {(f32x2){w0[0], w0[1]}, (f32x2){w0[2], w0[3]}, (f32x2){w1[0], w1[1]}, (f32x2){w1[2], w1[3]}};
      const f32x2 kv[4] = {(f32x2){k0[0], k0[1]}, (f32x2){k0[2], k0[3]}, (f32x2){k1[0], k1[1]}, (f32x2){k1[2], k1[3]}};
      const f32x2 bv[4] = {(f32x2){b0[0], b0[1]}, (f32x2){b0[2], b0[3]}, (f32x2){b1[0], b1[1]}, (f32x2){b1[2], b1[3]}};
      const f32x2 rv[4] = {(f32x2){r0[0], r0[1]}, (f32x2){r0[2], r0[3]}, (f32x2){r1[0], r1[1]}, (f32x2){r1[2], r1[3]}};
      f32x2 y0 = (f32x2){0.f, 0.f}, y1 = (f32x2){0.f, 0.f};
#pragma unroll
      for (int j = 0; j < 4; ++j) {
        S0[j] = S0[j] * wv[j] + bv[j] * sa0 + kv[j] * vv[0];
        S1[j] = S1[j] * wv[j] + bv[j] * sa1 + kv[j] * vv[1];
        y0 += S0[j] * rv[j]; y1 += S1[j] * rv[j];
      }
      float ya = y0[0] + y0[1], yb = y1[0] + y1[1];
      ya = sum8(ya); yb = sum8(yb);
      if (kq == 0) *(f32x2*)(yo + s * 64 + rp * 2) = (f32x2){ya, yb};
    }
    __syncthreads();
#pragma unroll
    for (int i = 0; i < 8; ++i) { const int idx = tid + i * 256, s = idx >> 6, kx = idx & 63, st = c0 + s, t = dir ? (SEQ - 1 - st) : st; Ed[((size_t)b * SEQ + t) * 512 + h * 64 + kx] = f2bf(yo[idx]); }
  }
#undef RW_PREFETCH
}

template <int DV>
struct Gla {
  static constexpr int NVB = DV / 16, QP = 136, VP = DV + 8, MP = QP;
  static constexpr int BYTES = (64 * QP * 2 + 64 * VP + DV * QP) * 2 + 6 * 64 * 4;
  char* sm;
  DI bf16_t* Qs() const { return (bf16_t*)sm; }
  DI bf16_t* Ks() const { return (bf16_t*)sm + 64 * QP; }
  DI bf16_t* Vs() const { return (bf16_t*)sm + 128 * QP; }
  DI bf16_t* St() const { return (bf16_t*)sm + 128 * QP + 64 * VP; }
  DI bf16_t* Ms() const { return (bf16_t*)sm; }
  DI float* P() const { return (float*)((bf16_t*)sm + 128 * QP + 64 * VP + DV * QP); }
  DI float* Qv() const { return P() + 64; }
  DI float* I() const { return P() + 128; }
  DI float* Wl() const { return P() + 192; }
  DI float* Mt() const { return P() + 256; }
  DI float* gl() const { return P() + 320; }
  f32x4 acc[NVB][2];
  int lane, w, fr, fq;
  DI void init(char* smem, int tid_) {
    sm = smem;
    lane = tid_ & 63; w = tid_ >> 6; fr = lane & 15; fq = lane >> 4;
    for (int i = tid_; i < DV * QP / 2; i += 256) ((unsigned*)St())[i] = 0u;
#pragma unroll
    for (int vb = 0; vb < NVB; ++vb) { acc[vb][0] = (f32x4){0.f, 0.f, 0.f, 0.f}; acc[vb][1] = (f32x4){0.f, 0.f, 0.f, 0.f}; }
  }
  DI bf16x8 gather(const bf16_t* base, int pitch, int r0, int col) const { bf16x8 r;
#pragma unroll
    for (int jj = 0; jj < 8; ++jj) r[jj] = (short)base[(r0 + jj) * pitch + col];
    return r; }
  DI void compute_y(f32x4 (&y)[NVB]) {
    bf16x8 qa[4];
#pragma unroll
    for (int ks = 0; ks < 4; ++ks) qa[ks] = *(const bf16x8*)(Qs() + (w * 16 + fr) * QP + ks * 32 + fq * 8);
#pragma unroll
    for (int nb = 0; nb < 4; ++nb) {
      f32x4 g = (f32x4){0.f, 0.f, 0.f, 0.f};
      if (nb <= w) {
#pragma unroll
        for (int ks = 0; ks < 4; ++ks) { const bf16x8 kb = *(const bf16x8*)(Ks() + (nb * 16 + fr) * QP + ks * 32 + fq * 8); g = MFMA16(qa[ks], kb, g); }
      }
      const int s = nb * 16 + fr; const float qs = Qv()[s];
#pragma unroll
      for (int j = 0; j < 4; ++j) { const int t = w * 16 + fq * 4 + j; const float m = (s <= t) ? g[j] * __expf(P()[t] - qs) : 0.f; Ms()[t * MP + s] = f2bf(m); }
    }
    __syncthreads();
#pragma unroll
    for (int vb = 0; vb < NVB; ++vb) y[vb] = (f32x4){0.f, 0.f, 0.f, 0.f};
#pragma unroll
    for (int ks = 0; ks < 4; ++ks)
      {
#pragma unroll
        for (int vb = 0; vb < NVB; ++vb) { const bf16x8 sb = *(const bf16x8*)(St() + (vb * 16 + fr) * QP + ks * 32 + fq * 8); y[vb] = MFMA16(qa[ks], sb, y[vb]); } __builtin_amdgcn_sched_barrier(0); }
    float sc[4];
#pragma unroll
    for (int j = 0; j < 4; ++j) sc[j] = __expf(I()[w * 16 + fq * 4 + j]);
#pragma unroll
    for (int vb = 0; vb < NVB; ++vb)
#pragma unroll
      for (int j = 0; j < 4; ++j) y[vb][j] *= sc[j];
#pragma unroll
    for (int k2 = 0; k2 < 2; ++k2) {
      if (k2 * 32 <= w * 16 + 15) {
        const bf16x8 ma = *(const bf16x8*)(Ms() + (w * 16 + fr) * MP + k2 * 32 + fq * 8);
#pragma unroll
        for (int vb = 0; vb < NVB; ++vb) { const bf16x8 vf = gather(Vs(), VP, k2 * 32 + fq * 8, vb * 16 + fr); y[vb] = MFMA16(ma, vf, y[vb]); __builtin_amdgcn_sched_barrier(0); }
      }
    }
  }
  DI void update() {
    __syncthreads();
    const float g = __expf(gl()[0]);
#pragma unroll
    for (int vb = 0; vb < NVB; ++vb) { acc[vb][0] *= g; acc[vb][1] *= g; }
#pragma unroll
    for (int k2 = 0; k2 < 2; ++k2) {
      const int s0 = k2 * 32 + fq * 8;
      float wsc[8];
#pragma unroll
      for (int jj = 0; jj < 8; ++jj) wsc[jj] = __expf(Wl()[s0 + jj]);
      const bf16x8 kb0 = gather(Ks(), QP, s0, (2 * w) * 16 + fr), kb1 = gather(Ks(), QP, s0, (2 * w + 1) * 16 + fr);
#pragma unroll
      for (int vb = 0; vb < NVB; ++vb) {
        bf16x8 va;
#pragma unroll
        for (int jj = 0; jj < 8; ++jj) va[jj] = (short)f2bf(bf2f(Vs()[(s0 + jj) * VP + vb * 16 + fr]) * wsc[jj]);
        acc[vb][0] = MFMA16(va, kb0, acc[vb][0]); acc[vb][1] = MFMA16(va, kb1, acc[vb][1]);
        __builtin_amdgcn_sched_barrier(0);
      }
    }
#pragma unroll
    for (int vb = 0; vb < NVB; ++vb)
#pragma unroll
      for (int nn = 0; nn < 2; ++nn)
#pragma unroll
        for (int j = 0; j < 4; ++j) St()[(vb * 16 + fq * 4 + j) * QP + (2 * w + nn) * 16 + fr] = f2bf(acc[vb][nn][j]);
    __syncthreads();
  }
};

DI void mamba_item(const Ctx& c, int item, char* smem) {
  const Params& p = c.p; (void)p;
  const int dir = item >> 8, b = (item >> 4) & 15, head = item & 15, gq = head >> 3;
  const int tid = TIDX;
  Gla<64> G; G.init(smem, tid);
  const bf16_t* raw = (const bf16_t*)(p.ws + OFF_R2);
  const bf16_t* BC = (const bf16_t*)(p.ws + OFF_XN + 32 * MiB);
  bf16_t* Y = (bf16_t*)p.out + (size_t)dir * NTOK * 1024;
  const float Aneg = -expf(p.mb_A_log[dir * 16 + head]), dtb = p.mb_dt_bias[dir * 16 + head];
  const int cvi = tid & 7, tg = tid >> 3, xc = head * 64 + cvi * 8;
  u32x4 px[4]; bf16_t pdt[2] = {0, 0}; bf16_t pdts = 0;
#define MB_LOADBC(c_) do { \
    _Pragma("unroll") for (int i = 0; i < 8; ++i) { const int v_ = tid + i * 256, s_ = v_ >> 5, cv_ = v_ & 31, st_ = (c_) * 64 + s_, t_ = dir ? (SEQ - 1 - st_) : st_; \
      pbc[i] = ld8(BC + ((size_t)b * SEQ + t_) * 512 + (cv_ < 16 ? 256 + gq * 128 + cv_ * 8 : gq * 128 + (cv_ - 16) * 8)); } } while (0)
#define MB_PREFETCH(c_) do { \
    { const int tb_ = dir ? (SEQ - 1 - ((c_) * 64 + tg * 2 + 1)) : ((c_) * 64 + tg * 2); \
      _Pragma("unroll") for (int j = 0; j < 4; ++j) { const int t_ = tb_ - 1 + j; px[j] = (t_ >= 0 && t_ < SEQ) ? ld8(raw + ((size_t)b * SEQ + t_) * 2592 + 1024 + xc) : (u32x4){0u, 0u, 0u, 0u}; } \
      pdt[0] = raw[((size_t)b * SEQ + tb_) * 2592 + 2560 + dir * 16 + head]; pdt[1] = raw[((size_t)b * SEQ + tb_ + 1) * 2592 + 2560 + dir * 16 + head]; } \
    if (tid < 64) { const int st_ = (c_) * 64 + tid, t_ = dir ? (SEQ - 1 - st_) : st_; pdts = raw[((size_t)b * SEQ + t_) * 2592 + 2560 + dir * 16 + head]; } } while (0)
  MB_PREFETCH(0);
  for (int c = 0; c < SEQ / 64; ++c) {
    u32x4 pbc[8];
    MB_LOADBC(c);
    { asm volatile("" ::: "memory");
      float cw0[8], cw1[8], cw2[8], cbv[8];
#pragma unroll
      for (int j = 0; j < 8; ++j) { cw0[j] = p.mb_conv_w[xc + j]; cw1[j] = p.mb_conv_w[1536 + xc + j]; cw2[j] = p.mb_conv_w[3072 + xc + j]; cbv[j] = p.mb_conv_b[xc + j]; }
      float R[4][8];
#pragma unroll
      for (int j = 0; j < 4; ++j) unpack8(px[j], R[j]);
#pragma unroll
      for (int i = 0; i < 2; ++i) {
        const int pi = dir ? (1 - i) : i;
        const float dt = softplusf_(bf2f(pdt[dir ? (1 - i) : i]) + dtb);
        float o[8];
#pragma unroll
        for (int j = 0; j < 8; ++j) o[j] = dt * siluf_(cbv[j] + cw0[j] * R[pi][j] + cw1[j] * R[pi + 1][j] + cw2[j] * R[pi + 2][j]);
        *(u32x4*)(G.Vs() + (tg * 2 + i) * G.VP + cvi * 8) = pack8(o);
      } }
    if (tid < 64) {
      const int s = tid;
      const float dt = softplusf_(bf2f(pdts) + dtb);
      const float cs = wave_incl_sum(dt * Aneg, s); const float csl = __shfl(cs, 63);
      G.P()[s] = cs; G.Qv()[s] = cs; G.I()[s] = cs; G.Wl()[s] = csl - cs; if (s == 0) G.gl()[0] = csl;
    }
#pragma unroll
    for (int i = 0; i < 8; ++i) { const int v = tid + i * 256, s = v >> 5, cv = v & 31; *(u32x4*)((cv < 16 ? G.Qs() : G.Ks()) + s * G.QP + (cv & 15) * 8) = pbc[i]; }
    if (c + 1 < SEQ / 64) MB_PREFETCH(c + 1);
    __syncthreads();
    f32x4 y[4];
    G.compute_y(y);
#pragma unroll
    for (int vb = 0; vb < 4; ++vb)
#pragma unroll
      for (int j = 0; j < 4; ++j) { const int s = G.w * 16 + G.fq * 4 + j, st = c * 64 + s, t = dir ? (SEQ - 1 - st) : st; Y[((size_t)b * SEQ + t) * 1024 + head * 64 + vb * 16 + G.fr] = f2bf(y[vb][j]); }
    G.update();
  }
#undef MB_PREFETCH
#undef MB_LOADBC
}

DI void mlstm_item(const Ctx& c, int item, char* smem) {
  const Params& p = c.p; (void)p;
  const int half = item & 1, head = (item >> 1) & 7, b = (item >> 4) & 15, dir = item >> 8;
  const int tid = TIDX;
  Gla<80> G; G.init(smem, tid);
  float* Wl_ = (float*)(smem + Gla<80>::BYTES);
  for (int i = tid; i < 128; i += 256) { const int ch = head * 128 + i, li = (i >> 3) * 12 + (i & 7); Wl_[li] = p.ml_conv_w[ch]; Wl_[192 + li] = p.ml_conv_w[1024 + ch]; Wl_[384 + li] = p.ml_conv_w[2048 + ch]; Wl_[576 + li] = p.ml_conv_b[ch]; }
  for (int i = tid; i < 512; i += 256) { const int li = (i >> 5) * 36 + (i & 31); Wl_[768 + li] = p.ml_wq[head * 512 + i]; Wl_[768 + 576 + li] = p.ml_wk[head * 512 + i] * 0.08838834764831845f; Wl_[768 + 1152 + li] = p.ml_wv[head * 512 + i]; }
  if (tid < 64) { for (int j = 0; j < 16; ++j) G.Vs()[tid * G.VP + 64 + j] = (j == 0) ? (bf16_t)0x3f80 : (bf16_t)0; }
  const bf16_t* raw = (const bf16_t*)(p.ws + OFF_MLRAW);
  bf16_t* H = (bf16_t*)(p.ws + OFF_HFB) + (size_t)dir * NTOK * 1024;
  const float ib = p.ml_i_b[dir * 8 + head], fb = p.ml_f_b[dir * 8 + head];
  const int cvi = tid & 15, tg = tid >> 4, ch = head * 128 + cvi * 8;
  float mprev = 0.f;
  u32x4 px[6]; bf16_t pgi = 0, pgf = 0;
#define ML_PREFETCH(c_) do { const int tb_ = dir ? (SEQ - 1 - ((c_) * 64 + tg * 4 + 3)) : ((c_) * 64 + tg * 4); \
    _Pragma("unroll") for (int j = 0; j < 6; ++j) { const int t_ = tb_ - 1 + j; px[j] = (t_ >= 0 && t_ < SEQ) ? ld8(raw + ((size_t)b * SEQ + t_) * 2080 + ch) : (u32x4){0u, 0u, 0u, 0u}; } \
    if (tid < 64) { const int st_ = (c_) * 64 + tid, t_ = dir ? (SEQ - 1 - st_) : st_; const size_t tok_ = (size_t)b * SEQ + t_; pgi = raw[tok_ * 2080 + 2048 + dir * 8 + head]; pgf = raw[tok_ * 2080 + 2064 + dir * 8 + head]; } } while (0)
  ML_PREFETCH(0);
  __syncthreads();
  for (int c = 0; c < SEQ / 64; ++c) {
    {
#pragma unroll
      for (int i = 0; i < 4; ++i) {
        float prv[8], cur[8], nxt[8];
        { const u32x4 a = dir ? px[3 - i] : px[i], bq = dir ? px[4 - i] : px[i + 1], cq = dir ? px[5 - i] : px[i + 2]; unpack8(a, prv); unpack8(bq, cur); unpack8(cq, nxt); }
        float xcv[8], q[8], k[8], v[8];
#pragma unroll
        for (int j4 = 0; j4 < 2; ++j4) {
          const f32x4 w0 = *(const f32x4*)(Wl_ + cvi * 12 + j4 * 4), w1 = *(const f32x4*)(Wl_ + 192 + cvi * 12 + j4 * 4), w2 = *(const f32x4*)(Wl_ + 384 + cvi * 12 + j4 * 4), bb = *(const f32x4*)(Wl_ + 576 + cvi * 12 + j4 * 4);
#pragma unroll
          for (int j = 0; j < 4; ++j) xcv[j4 * 4 + j] = siluf_(bb[j] + w0[j] * prv[j4 * 4 + j] + w1[j] * cur[j4 * 4 + j] + w2[j] * nxt[j4 * 4 + j]);
        }
#pragma unroll
        for (int bl = 0; bl < 2; ++bl) {
          f32x4 aq = (f32x4){0.f, 0.f, 0.f, 0.f}, ak = aq, av = aq;
#pragma unroll
          for (int cc = 0; cc < 4; ++cc) {
            const int wi = cvi * 36 + bl * 16 + cc * 4;
            aq += *(const f32x4*)(Wl_ + 768 + wi) * xcv[bl * 4 + cc]; ak += *(const f32x4*)(Wl_ + 768 + 576 + wi) * xcv[bl * 4 + cc]; av += *(const f32x4*)(Wl_ + 768 + 1152 + wi) * cur[bl * 4 + cc];
          }
#pragma unroll
          for (int d = 0; d < 4; ++d) { q[bl * 4 + d] = aq[d]; k[bl * 4 + d] = ak[d]; v[bl * 4 + d] = av[d]; }
        }
        const int s = tg * 4 + i;
        *(u32x4*)(G.Qs() + s * G.QP + cvi * 8) = pack8(q);
        *(u32x4*)(G.Ks() + s * G.QP + cvi * 8) = pack8(k);
        if ((cvi >> 3) == half) *(u32x4*)(G.Vs() + s * G.VP + (cvi & 7) * 8) = pack8(v);
        __builtin_amdgcn_sched_barrier(0);
      } }
    if (tid < 64) {
      const int s = tid;
      const float li = bf2f(pgi) + ib;
      const float fx = bf2f(pgf) + fb;
      const float lf = fminf(fx, 0.f) - __logf(1.0f + __expf(-fabsf(fx)));
      const float bc = wave_incl_sum(lf, s);
      const float cc = li - bc;
      const float pm = fmaxf(wave_incl_max(cc, s), mprev);
      const float pml = __shfl(pm, 63), bl = __shfl(bc, 63);
      G.P()[s] = -pm; G.Qv()[s] = -cc; G.I()[s] = mprev - pm; G.Wl()[s] = cc - pml; G.Mt()[s] = bc + pm; if (s == 0) G.gl()[0] = mprev - pml;
      mprev = bl + pml;
    }
    if (c + 1 < SEQ / 64) ML_PREFETCH(c + 1);
    __syncthreads();
    f32x4 y[5];
    G.compute_y(y);
#pragma unroll
    for (int j = 0; j < 4; ++j) {
      const float den = __shfl(y[4][j], G.lane & 48);
      const int s = G.w * 16 + G.fq * 4 + j, st = c * 64 + s, t = dir ? (SEQ - 1 - st) : st;
      const float dn = 1.0f / fmaxf(fabsf(den), __expf(-G.Mt()[s]));
#pragma unroll
      for (int vb = 0; vb < 4; ++vb) H[((size_t)b * SEQ + t) * 1024 + head * 128 + half * 64 + vb * 16 + G.fr] = f2bf(y[vb][j] * dn);
    }
    G.update();
  }
#undef ML_PREFETCH
}

DI void s5_item(const Ctx& c, int item, char* smem) {
  const Params& p = c.p; (void)p;
  constexpr int T = 16, XP = 136, BP = 132;
  const int dir = item >> 7, b = (item >> 3) & 15, gq = item & 7;
  const int tid = TIDX, lane = tid & 63, wave = tid >> 6, fr = lane & 15, fq = lane >> 4;
  const int g = gq * 4 + wave;
  float* BUw = (float*)smem + wave * (T * BP);
  bf16_t* Xw = (bf16_t*)(smem + 4 * T * BP * 4) + wave * (T * XP);
  const bf16_t* U = (const bf16_t*)(p.ws + OFF_S5U);
  bf16_t* Y = (bf16_t*)(p.ws + OFF_S5Y) + (size_t)dir * NTOK * 512;
  const float dtv = expf(p.s5_log_dt[dir * 32 + g]);
  float abr, abi;
  { const float ar = fminf(p.s5_A_re[(dir * 32 + g) * 64 + lane], -1e-4f), ai = p.s5_A_im[(dir * 32 + g) * 64 + lane];
    const float mag = expf(dtv * ar); abr = mag * cosf(dtv * ai); abi = mag * sinf(dtv * ai); }
  bf16x8 bf_[8];
#pragma unroll
  for (int q = 0; q < 4; ++q) {
    const int pp = q * 16 + fr;
    const float ar = fminf(p.s5_A_re[(dir * 32 + g) * 64 + pp], -1e-4f), ai = p.s5_A_im[(dir * 32 + g) * 64 + pp];
    const float mag = expf(dtv * ar), br_ = mag * cosf(dtv * ai), bi_ = mag * sinf(dtv * ai), den = ar * ar + ai * ai;
    const float f_r = ((br_ - 1.0f) * ar + bi_ * ai) / den, f_i = (bi_ * ar - (br_ - 1.0f) * ai) / den;
    float vr[8], vi[8];
#pragma unroll
    for (int jj = 0; jj < 8; ++jj) {
      float bre = 0.f, bim = 0.f;
      if (fq < 2) { bre = p.s5_B_re[(g * 64 + pp) * 16 + fq * 8 + jj]; bim = p.s5_B_im[(g * 64 + pp) * 16 + fq * 8 + jj]; }
      vr[jj] = f_r * bre - f_i * bim; vi[jj] = f_r * bim + f_i * bre;
    }
    bf_[q] = __builtin_bit_cast(bf16x8, pack8(vr)); bf_[4 + q] = __builtin_bit_cast(bf16x8, pack8(vi));
  }
  bf16x8 cf[4];
#pragma unroll
  for (int ks = 0; ks < 4; ++ks) {
    float cv[8];
#pragma unroll
    for (int jj = 0; jj < 8; ++jj) { const int k = ks * 32 + fq * 8 + jj; const size_t base = ((size_t)(dir * 32 + g) * 16 + fr) * 64; cv[jj] = k < 64 ? p.s5_C_re[base + k] : -p.s5_C_im[base + k - 64]; }
    cf[ks] = __builtin_bit_cast(bf16x8, pack8(cv));
  }
  float xr = 0.f, xi = 0.f;
  u32x4 pu;
#define S5_PREFETCH(c0_) do { const int st_ = (c0_) + fr, t_ = dir ? (SEQ - 1 - st_) : st_; \
    pu = (fq < 2) ? ld8(U + ((size_t)b * SEQ + t_) * 512 + g * 16 + fq * 8) : (u32x4){0u, 0u, 0u, 0u}; } while (0)
  S5_PREFETCH(0);
  for (int c0 = 0; c0 < SEQ; c0 += T) {
    const bf16x8 ua = __builtin_bit_cast(bf16x8, pu);
    if (c0 + T < SEQ) S5_PREFETCH(c0 + T);
    asm volatile("" ::: "memory");
#pragma unroll
    for (int nb = 0; nb < 8; ++nb) {
      f32x4 bu = MFMA16(ua, bf_[nb], ((f32x4){0.f, 0.f, 0.f, 0.f}));
#pragma unroll
      for (int j = 0; j < 4; ++j) BUw[(fq * 4 + j) * BP + nb * 16 + fr] = bu[j];
    }
    asm volatile("" ::: "memory");
#pragma unroll
    for (int s = 0; s < T; ++s) {
      const float bur = BUw[s * BP + lane], bui = BUw[s * BP + 64 + lane];
      const float nr = abr * xr - abi * xi + bur, ni = abr * xi + abi * xr + bui;
      xr = nr; xi = ni;
      const unsigned pk = pack2(xr, xi);
      Xw[s * XP + lane] = (bf16_t)(pk & 0xffffu); Xw[s * XP + 64 + lane] = (bf16_t)(pk >> 16);
    }
    asm volatile("" ::: "memory");
    f32x4 y = (f32x4){0.f, 0.f, 0.f, 0.f};
#pragma unroll
    for (int ks = 0; ks < 4; ++ks) { const bf16x8 xa = *(const bf16x8*)(Xw + fr * XP + ks * 32 + fq * 8); y = MFMA16(xa, cf[ks], y); }
#pragma unroll
    for (int j = 0; j < 4; ++j) { const int st = c0 + fq * 4 + j, t = dir ? (SEQ - 1 - st) : st; Y[((size_t)b * SEQ + t) * 512 + g * 16 + fr] = f2bf(y[j]); }
  }
#undef S5_PREFETCH
}

DI void phase_post0(const Ctx& c) {
  const Params& p = c.p; (void)p;
  const int lane = TIDX & 63, wid = TIDX >> 6;
  const int gw = blockIdx.x * 4 + wid, nw = gridDim.x * 4;
  {
    bf16_t* E0 = (bf16_t*)(p.ws + OFF_R1); const bf16_t* E1 = E0 + (size_t)NTOK * 512; const bf16_t* Ab = E1 + (size_t)NTOK * 512;
    const bf16_t* G = (const bf16_t*)(p.ws + OFF_XN); const bf16_t* RKV = (const bf16_t*)(p.ws + OFF_RKV);
    for (int tok = gw; tok < NTOK; tok += nw) {
      const int c = lane * 8;
      float y0[8], y1[8], r[8], k[8], v[8], a[8], g[8], o[8];
      unpack8(ld8(E0 + (size_t)tok * 512 + c), y0); unpack8(ld8(E1 + (size_t)tok * 512 + c), y1);
      unpack8(ld8(RKV + (size_t)tok * 1536 + c), r); unpack8(ld8(RKV + (size_t)tok * 1536 + 512 + c), k); unpack8(ld8(RKV + (size_t)tok * 1536 + 1024 + c), v);
      unpack8(ld8(Ab + (size_t)tok * 512 + c), a); unpack8(ld8(G + (size_t)tok * 512 + c), g);
      float sy = 0.f, sb = 0.f;
#pragma unroll
      for (int j = 0; j < 8; ++j) { y0[j] += y1[j]; sy += y0[j]; const float k2 = k[j] * (1.0f + (a[j] - 1.0f) * p.rw_k_a[c + j]); sb += r[j] * k2 * p.rw_r_k[c + j]; }
      const float mean = sum8(sy) * (1.0f / 64.0f); sb = sum8(sb);
      float sv = 0.f;
#pragma unroll
      for (int j = 0; j < 8; ++j) { y0[j] -= mean; sv += y0[j] * y0[j]; }
      const float rs = rsqrtf(sum8(sv) * (1.0f / 64.0f) + 64e-5f);
#pragma unroll
      for (int j = 0; j < 8; ++j) o[j] = (y0[j] * rs * p.rw_ln_w[c + j] + sb * v[j]) * g[j];
      *(u32x4*)(E0 + (size_t)tok * 512 + c) = pack8(o);
    }
  }
  {
    bf16_t* raw = (bf16_t*)(p.ws + OFF_R2);
    const bf16_t* Y0 = (const bf16_t*)p.out; const bf16_t* Y1 = Y0 + (size_t)NTOK * 1024;
    const float* cw = p.mb_conv_w; const float* cb = p.mb_conv_b;
    for (int u = gw; u < NTOK * 2; u += nw) {
      const int tok = u >> 1, gq = u & 1, col = gq * 512 + lane * 8, head = col >> 6, t = tok & (SEQ - 1);
      float y0[8], y1[8], z[8], cur[8], prv[8], nxt[8], o[8];
      unpack8(ld8(Y0 + (size_t)tok * 1024 + col), y0); unpack8(ld8(Y1 + (size_t)tok * 1024 + col), y1);
      bf16_t* zp = raw + (size_t)tok * 2592 + col;
      unpack8(ld8(zp), z);
      const bf16_t* rp = zp + 1024;
      unpack8(ld8(rp), cur);
      if (t > 0) unpack8(ld8(rp - 2592), prv); else for (int j = 0; j < 8; ++j) prv[j] = 0.f;
      if (t < SEQ - 1) unpack8(ld8(rp + 2592), nxt); else for (int j = 0; j < 8; ++j) nxt[j] = 0.f;
      const float D = p.mb_D[head];
      float ss = 0.f;
#pragma unroll
      for (int j = 0; j < 8; ++j) { const float xs = siluf_(cb[col + j] + cw[col + j] * prv[j] + cw[1536 + col + j] * cur[j] + cw[3072 + col + j] * nxt[j]);
        const float yy = (y0[j] + y1[j] + D * xs) * siluf_(z[j]); o[j] = yy; ss += yy * yy; }
      ss = wave_sum(ss);
      const float rs = rsqrtf(ss * (1.0f / 512.0f) + 1e-5f);
#pragma unroll
      for (int j = 0; j < 8; ++j) o[j] = o[j] * rs * p.mb_norm_w[col + j];
      *(u32x4*)zp = pack8(o);
    }
  }
}

DI float gelu_tanh(float x) { const float u = 0.7978845608028654f * (x + 0.044715f * x * x * x); return 0.5f * x * (1.0f + tanhf(u)); }

DI void phase_post1(const Ctx& c) {
  const Params& p = c.p; (void)p;
  const int lane = TIDX & 63, wid = TIDX >> 6;
  const int gw = blockIdx.x * 4 + wid, nw = gridDim.x * 4;
  {
    const bf16_t* U = (const bf16_t*)(p.ws + OFF_S5U); const bf16_t* Y0 = (const bf16_t*)(p.ws + OFF_S5Y); const bf16_t* Y1 = Y0 + (size_t)NTOK * 512;
    bf16_t* YG = (bf16_t*)(p.ws + OFF_YG);
    for (int tok = gw; tok < NTOK; tok += nw) {
      const int col = lane * 8; float u[8], a[8], c[8], o[8];
      unpack8(ld8(U + (size_t)tok * 512 + col), u); unpack8(ld8(Y0 + (size_t)tok * 512 + col), a); unpack8(ld8(Y1 + (size_t)tok * 512 + col), c);
#pragma unroll
      for (int j = 0; j < 8; ++j) o[j] = gelu_tanh(p.s5_D[col + j] * u[j] + a[j] + c[j]);
      *(u32x4*)(YG + (size_t)tok * 512 + col) = pack8(o);
    }
  }
  {
    bf16_t* raw = (bf16_t*)(p.ws + OFF_MLRAW);
    const bf16_t* HF = (const bf16_t*)(p.ws + OFF_HFB); const bf16_t* HB = HF + (size_t)NTOK * 1024;
    for (int u = gw; u < NTOK * 2; u += nw) {
      const int tok = u >> 1, c = (u & 1) * 512 + lane * 8, t = tok & (SEQ - 1);
      float hf[8], hb[8], cur[8], prv[8], nxt[8], og[8], o[8];
      unpack8(ld8(HF + (size_t)tok * 1024 + c), hf); unpack8(ld8(HB + (size_t)tok * 1024 + c), hb);
      bf16_t* xp = raw + (size_t)tok * 2080 + c;
      unpack8(ld8(xp), cur);
      if (t > 0) unpack8(ld8(xp - 2080), prv); else for (int j = 0; j < 8; ++j) prv[j] = 0.f;
      if (t < SEQ - 1) unpack8(ld8(xp + 2080), nxt); else for (int j = 0; j < 8; ++j) nxt[j] = 0.f;
      unpack8(ld8(xp + 1024), og);
      float sh = 0.f;
#pragma unroll
      for (int j = 0; j < 8; ++j) { hf[j] += hb[j]; sh += hf[j]; }
      sh = sum8(sh); sh += dpp_mov<0x140>(sh);
      const float mean = sh * (1.0f / 128.0f);
      float sv = 0.f;
#pragma unroll
      for (int j = 0; j < 8; ++j) { hf[j] -= mean; sv += hf[j] * hf[j]; }
      sv = sum8(sv); sv += dpp_mov<0x140>(sv);
      const float rs = rsqrtf(sv * (1.0f / 128.0f) + 1e-5f);
#pragma unroll
      for (int j = 0; j < 8; ++j) {
        const float xcv = siluf_(p.ml_conv_b[c + j] + p.ml_conv_w[c + j] * prv[j] + p.ml_conv_w[1024 + c + j] * cur[j] + p.ml_conv_w[2048 + c + j] * nxt[j]);
        o[j] = sigmoidf_(og[j]) * (hf[j] * rs * p.ml_norm_w[c + j]) + p.ml_skip[c + j] * xcv;
      }
      *(u32x4*)(xp + 1024) = pack8(o);
    }
  }
}

DI void phase_final(const Ctx& c) {
  const Params& p = c.p; (void)p;
  const int lane = TIDX & 63, wid = TIDX >> 6;
  for (int u = blockIdx.x; u < NTOK / 4; u += gridDim.x) {
    float* xr = p.out + (size_t)(u * 4 + wid) * 1024;
    f32x4 v[4]; float ss = 0.f;
#pragma unroll
    for (int i = 0; i < 4; ++i) { v[i] = *(const f32x4*)(xr + i * 256 + lane * 4); ss += v[i][0] * v[i][0] + v[i][1] * v[i][1] + v[i][2] * v[i][2] + v[i][3] * v[i][3]; }
    ss = wave_sum(ss);
    const float rs = rsqrtf(ss * (1.0f / 1024.0f) + 1e-5f);
#pragma unroll
    for (int i = 0; i < 4; ++i) { const f32x4 g = *(const f32x4*)(p.norm_final + i * 256 + lane * 4); *(f32x4*)(xr + i * 256 + lane * 4) = v[i] * rs * g; }
  }
}

constexpr int NPHASE = 20;
#ifdef NO_RW
#define RWK(x)
#else
#define RWK(x) x
#endif
#ifdef NO_MB
#define MBK(x)
#else
#define MBK(x) x
#endif
#ifndef ONLY_PHASE
#define ONLY_PHASE -1
#endif
#define PH(k) case k: if (ONLY_PHASE >= 0 && ONLY_PHASE != k) break;
template <int ph> DI void run_phase(const Ctx& c, char* smem) {
  const Params& p = c.p; (void)p;
  char* ws = p.ws;
  bf16_t* XN = (bf16_t*)(ws + OFF_XN);
  switch (ph) {
    PH(0) phase_prep(c, smem); break;
    PH(1) gemm_phase(smem, XN, 1024, 1 << 30, XN, 1024, (const bf16_t*)(ws + OFF_WABIN), 1024, 35,
                       EpiSplit{(bf16_t*)(ws + OFF_R1), 1792, 1792, (bf16_t*)(ws + OFF_R2), 2592, 2592}, TIDX); break;
    PH(2) phase_rw_shift(c); break;
    PH(3) phase_rw_small_gemms(c, smem); break;
    PH(4) {
      const int G = gridDim.x, bx = blockIdx.x;
      if (G >= 512) { if (bx < 256) { RWK(rwkv_item(c, bx, smem);) } else for (int u = bx - 256; u < 512; u += G - 256) { MBK(mamba_item(c, u, smem);) } }
      else { for (int u = bx; u < 256; u += G) { RWK(rwkv_item(c, u, smem);) } __syncthreads(); for (int u = bx + ((256 - bx + G - 1) / G) * G; u < 768; u += G) { MBK(mamba_item(c, u - 256, smem);) } }
    } break;
    PH(5) phase_post0(c); break;
    PH(6) gemm_phase(smem, (const bf16_t*)(ws + OFF_R1), 512, 512, (const bf16_t*)(ws + OFF_R2), 2592, (const bf16_t*)(ws + OFF_WABOUT), 1536, 8, EpiResid{p.x, p.out}, TIDX); break;
    PH(7) phase_rmsnorm(c, p.out, p.norm_mlp); break;
    PH(8) gemm_phase(smem, XN, 1024, 1 << 30, XN, 1024, (const bf16_t*)(ws + OFF_W1), 1024, 32, EpiRelu2{(bf16_t*)(ws + OFF_R1)}, TIDX); break;
    PH(9) gemm_phase(smem, (const bf16_t*)(ws + OFF_R1), 4096, 1 << 30, XN, 1024, (const bf16_t*)(ws + OFF_W2), 4096, 8, EpiResid{p.out, p.out}, TIDX); break;
    PH(10) phase_rmsnorm(c, p.out, p.norm_mix + 1024); break;
    PH(11) gemm_phase(smem, XN, 1024, 1 << 30, XN, 1024, (const bf16_t*)(ws + OFF_WCDIN), 1024, 21,
                        EpiSplit{(bf16_t*)(ws + OFF_S5U), 512, 512, (bf16_t*)(ws + OFF_MLRAW), 2080, 2080}, TIDX); break;
    PH(12) {
      const int G = gridDim.x, bx = blockIdx.x;
      if (G >= 512) { if (bx >= 256 && bx < 512) s5_item(c, bx - 256, smem); __syncthreads(); for (int u = bx; u < 512; u += G) mlstm_item(c, u, smem); }
      else { for (int u = bx; u < 512; u += G) mlstm_item(c, u, smem);
        __syncthreads();
        { int u0 = bx + ((512 - bx + G - 1) / G) * G; for (int u = u0; u < 768; u += G) s5_item(c, u - 512, smem); } }
    } break;
    PH(13) phase_post1(c); break;
    PH(14) gemm_phase(smem, (const bf16_t*)(ws + OFF_YG), 512, 1 << 30, XN, 1024, (const bf16_t*)(ws + OFF_WGLU), 512, 4,
                        EpiGlu{(const bf16_t*)(ws + OFF_YG), p.s5_glu_b, (bf16_t*)(ws + OFF_S5Y)}, TIDX); break;
    PH(15) gemm_phase(smem, (const bf16_t*)(ws + OFF_S5Y), 512, 512, (const bf16_t*)(ws + OFF_MLRAW) + 1024, 2080, (const bf16_t*)(ws + OFF_WCDOUT), 1536, 8, EpiResid{p.out, p.out}, TIDX); break;
    PH(16) phase_rmsnorm(c, p.out, p.norm_mlp + 1024); break;
    PH(17) gemm_phase(smem, XN, 1024, 1 << 30, XN, 1024, (const bf16_t*)(ws + OFF_W1) + 4096ull * 1024, 1024, 32, EpiRelu2{(bf16_t*)(ws + OFF_R1)}, TIDX); break;
    PH(18) gemm_phase(smem, (const bf16_t*)(ws + OFF_R1), 4096, 1 << 30, XN, 1024, (const bf16_t*)(ws + OFF_W2) + 4096ull * 1024, 4096, 8, EpiResid{p.out, p.out}, TIDX); break;
    PH(19) phase_final(c); break;
    default: break;
  }
}

DI void grid_barrier(const Ctx& c, unsigned idx) {
  const Params& p = c.p; (void)p;
  asm volatile("s_waitcnt vmcnt(0)" ::: "memory");
  __syncthreads();
  if (TIDX == 0) {
    unsigned* cnt = (unsigned*)(p.ws + OFF_BAR);
    __builtin_amdgcn_fence(__ATOMIC_RELEASE, "agent");
    asm volatile("s_waitcnt vmcnt(0)" ::: "memory");
    __hip_atomic_fetch_add(cnt, 1u, __ATOMIC_RELAXED, __HIP_MEMORY_SCOPE_AGENT);
    const unsigned target = idx * gridDim.x;
    while (__hip_atomic_load(cnt, __ATOMIC_RELAXED, __HIP_MEMORY_SCOPE_AGENT) < target) __builtin_amdgcn_s_sleep(1);
    __builtin_amdgcn_fence(__ATOMIC_ACQUIRE, "agent");
    asm volatile("s_waitcnt vmcnt(0)" ::: "memory");
  }
  __syncthreads();
}
template <int PHI> DI void run_from(const Ctx& c, char* smem, int ph0, int ph1) {
  const Params& p = c.p; (void)p;
  if constexpr (PHI < NPHASE) {
    if (ph0 <= PHI && PHI < ph1) {
      run_phase<PHI>(c, smem);
      if (PHI + 1 < ph1) {
        if constexpr (PHI == 0) { __syncthreads(); cg::this_grid().sync(); }
        else grid_barrier(c, (unsigned)PHI);
      }
    }
    run_from<PHI + 1>(c, smem, ph0, ph1);
  }
}

__global__ void __launch_bounds__(256, 2) mega(Params p, int ph0, int ph1) {
  extern __shared__ __attribute__((aligned(16))) char smem[];
  const Ctx c{p, __builtin_amdgcn_readfirstlane((int)(__builtin_amdgcn_workitem_id_x() >> 6))};
  run_from<0>(c, smem, ph0, ph1);
}

#ifndef ONE_LAUNCH
#define ONE_LAUNCH 1
#endif

extern "C" void kernel_launch(void* const* d_in, const int* in_sizes, int n_in, void* d_out, int out_size, void* d_ws, size_t ws_size,
                              hipStream_t stream) {
  static int grid_blocks = 0;
  if (!grid_blocks) {
    hipFuncSetAttribute((const void*)mega, hipFuncAttributeMaxDynamicSharedMemorySize, LDS_BYTES);
    int dev = 0, cus = 0, per_cu = 0;
    hipGetDevice(&dev);
    hipDeviceGetAttribute(&cus, hipDeviceAttributeMultiprocessorCount, dev);
    hipOccupancyMaxActiveBlocksPerMultiprocessor(&per_cu, mega, 256, LDS_BYTES);
    if (per_cu > 2) per_cu = 2;
    if (per_cu < 1) per_cu = 1;
    grid_blocks = cus * per_cu;
  }
  Params p{};
  const float** pf = (const float**)&p;
  for (int i = 0; i < 45; ++i) pf[i] = (const float*)d_in[i];
  p.out = (float*)d_out;
  p.ws = (char*)d_ws;
#if ONE_LAUNCH
  int ph0 = 0, ph1 = NPHASE;
  void* args[] = {&p, &ph0, &ph1};
  hipError_t e = hipLaunchCooperativeKernel((const void*)mega, dim3(grid_blocks), dim3(256), args, LDS_BYTES, stream);
  if (e != hipSuccess) fprintf(stderr, "cooperative launch failed: %s (grid %d)\n", hipGetErrorString(e), grid_blocks);
#else
  for (int ph = 0; ph < NPHASE; ++ph) hipLaunchKernelGGL(mega, dim3(grid_blocks), dim3(256), LDS_BYTES, stream, p, ph, ph + 1);
#endif
}
```

```cpp
#include <hip/hip_runtime.h>
#include <hip/hip_cooperative_groups.h>
#include <stdint.h>
#include <cstdio>
namespace cg = cooperative_groups;

typedef unsigned short bf16_t;
typedef short bf16x8 __attribute__((ext_vector_type(8)));
typedef float f32x4 __attribute__((ext_vector_type(4)));
typedef unsigned u32x4 __attribute__((ext_vector_type(4)));
typedef unsigned u32x2 __attribute__((ext_vector_type(2)));

#define DI __device__ __forceinline__
#define LANEID() ((int)__builtin_amdgcn_mbcnt_hi(~0u, __builtin_amdgcn_mbcnt_lo(~0u, 0u)))
#define TIDX (c.wid * 64 + LANEID())
#define MFMA16(a, b, c) __builtin_amdgcn_mfma_f32_16x16x32_bf16((a), (b), (c), 0, 0, 0)

constexpr int NTOK = 32768, SEQ = 2048;
constexpr size_t MiB = 1ull << 20;
constexpr size_t OFF_WABIN = 0;
constexpr size_t OFF_WABOUT = OFF_WABIN + 4480ull * 1024 * 2;
constexpr size_t OFF_W1 = OFF_WABOUT + 1024ull * 1536 * 2;
constexpr size_t OFF_W2 = OFF_W1 + 2ull * 4096 * 1024 * 2;
constexpr size_t OFF_WCDIN = OFF_W2 + 2ull * 4096 * 1024 * 2;
constexpr size_t OFF_WCDOUT = OFF_WCDIN + 2688ull * 1024 * 2;
constexpr size_t OFF_WGLU = OFF_WCDOUT + 1024ull * 1536 * 2;
constexpr size_t OFF_WG2 = OFF_WGLU + 512ull * 512 * 2;
constexpr size_t OFF_WW2 = OFF_WG2 + 512ull * 128 * 2;
constexpr size_t OFF_WA2 = OFF_WW2 + 2ull * 512 * 64 * 2;
constexpr size_t OFF_WEND = OFF_WA2 + 512ull * 64 * 2;
static_assert(OFF_WEND <= 56 * MiB, "weights region");
constexpr size_t OFF_XN = 56 * MiB;
constexpr size_t OFF_R1 = 120 * MiB;
constexpr size_t OFF_R2 = 232 * MiB;
constexpr size_t OFF_RKV = 394 * MiB;
constexpr size_t OFF_SM = 490 * MiB;
constexpr size_t OFF_S5U = 120 * MiB;
constexpr size_t OFF_MLRAW = 152 * MiB;
constexpr size_t OFF_S5Y = 282 * MiB;
constexpr size_t OFF_HFB = 346 * MiB;
constexpr size_t OFF_YG = 474 * MiB;
constexpr size_t OFF_BAR = 510 * MiB;
constexpr int LDS_BYTES = 79872;

struct Params {
  const float *x, *norm_mix, *norm_mlp, *norm_final, *mlp_w1, *mlp_w2, *ab_w_in, *ab_w_out, *rw_mu, *rw_w0, *rw_w2, *rw_a0,
      *rw_a2, *rw_g2, *rw_k_k, *rw_k_a, *rw_r_k, *rw_ln_w, *mb_conv_w, *mb_conv_b, *mb_dt_bias, *mb_A_log, *mb_D, *mb_norm_w,
      *cd_w_in, *cd_w_out, *s5_A_re, *s5_A_im, *s5_log_dt, *s5_B_re, *s5_B_im, *s5_C_re, *s5_C_im, *s5_D, *s5_glu_w, *s5_glu_b,
      *ml_conv_w, *ml_conv_b, *ml_wq, *ml_wk, *ml_wv, *ml_i_b, *ml_f_b, *ml_norm_w, *ml_skip;
  float* out;
  char* ws;
};
struct Ctx { const Params& p; int wid; };

DI float bf2f(bf16_t v) { return __uint_as_float(((unsigned)v) << 16); }
typedef float f32x2c __attribute__((ext_vector_type(2)));
typedef __bf16 bf16x2c __attribute__((ext_vector_type(2)));
DI unsigned pack2(float lo, float hi) { const f32x2c v = {lo, hi}; return __builtin_bit_cast(unsigned, __builtin_convertvector(v, bf16x2c)); }
DI bf16_t f2bf(float x) { return (bf16_t)(pack2(x, x) & 0xffffu); }
DI void unpack8(u32x4 w, float* f) {
#pragma unroll
  for (int i = 0; i < 4; ++i) { f[2 * i] = __uint_as_float(w[i] << 16); f[2 * i + 1] = __uint_as_float(w[i] & 0xffff0000u); }
}
DI u32x4 pack8(const float* f) { u32x4 w; w.x = pack2(f[0], f[1]); w.y = pack2(f[2], f[3]); w.z = pack2(f[4], f[5]); w.w = pack2(f[6], f[7]); return w; }
DI u32x4 ld8(const bf16_t* p) { return *(const u32x4*)p; }
template <int CTRL> DI float dpp_mov(float v) { return __int_as_float(__builtin_amdgcn_update_dpp(0, __float_as_int(v), CTRL, 0xF, 0xF, true)); }
DI float sum8(float v) { v += dpp_mov<0xB1>(v); v += dpp_mov<0x4E>(v); v += dpp_mov<0x141>(v); return v; }
DI float wave_sum(float v) {
  v = sum8(v); v += dpp_mov<0x140>(v);
  v += __shfl_xor(v, 16); v += __shfl_xor(v, 32);
  return v;
}
DI float sigmoidf_(float x) { return __builtin_amdgcn_rcpf(1.0f + __expf(-x)); }
DI float siluf_(float x) { return x * __builtin_amdgcn_rcpf(1.0f + __expf(-x)); }
DI float softplusf_(float x) { return x > 20.f ? x : log1pf(expf(x)); }
DI float wave_incl_sum(float v, int lane) {
#pragma unroll
  for (int o = 1; o < 64; o <<= 1) { float t = __shfl_up(v, o); if (lane >= o) v += t; }
  return v;
}
DI float wave_incl_max(float v, int lane) {
#pragma unroll
  for (int o = 1; o < 64; o <<= 1) { float t = __shfl_up(v, o); if (lane >= o) v = fmaxf(v, t); }
  return v;
}

DI bool get_tdesc(const Ctx& c, int i, const float*& src, bf16_t*& dst, int& K, int& Nsrc, int& Npad) {
  const Params& p = c.p; (void)p;
  char* ws = p.ws;
  switch (i) {
    case 0: src = p.ab_w_in; dst = (bf16_t*)(ws + OFF_WABIN); K = 1024; Nsrc = 4384; Npad = 4480; return true;
    case 1: src = p.ab_w_out; dst = (bf16_t*)(ws + OFF_WABOUT); K = 1536; Nsrc = 1024; Npad = 1024; return true;
    case 2: src = p.mlp_w1; dst = (bf16_t*)(ws + OFF_W1); K = 1024; Nsrc = 4096; Npad = 4096; return true;
    case 3: src = p.mlp_w1 + 1024ull * 4096; dst = (bf16_t*)(ws + OFF_W1) + 4096ull * 1024; K = 1024; Nsrc = 4096; Npad = 4096; return true;
    case 4: src = p.mlp_w2; dst = (bf16_t*)(ws + OFF_W2); K = 4096; Nsrc = 1024; Npad = 1024; return true;
    case 5: src = p.mlp_w2 + 4096ull * 1024; dst = (bf16_t*)(ws + OFF_W2) + 4096ull * 1024; K = 4096; Nsrc = 1024; Npad = 1024; return true;
    case 6: src = p.cd_w_in; dst = (bf16_t*)(ws + OFF_WCDIN); K = 1024; Nsrc = 2592; Npad = 2688; return true;
    case 7: src = p.cd_w_out; dst = (bf16_t*)(ws + OFF_WCDOUT); K = 1536; Nsrc = 1024; Npad = 1024; return true;
    case 8: src = p.s5_glu_w; dst = (bf16_t*)(ws + OFF_WGLU); K = 512; Nsrc = 512; Npad = 512; return true;
    case 9: src = p.rw_g2; dst = (bf16_t*)(ws + OFF_WG2); K = 128; Nsrc = 512; Npad = 512; return true;
    case 10: src = p.rw_w2; dst = (bf16_t*)(ws + OFF_WW2); K = 64; Nsrc = 512; Npad = 512; return true;
    case 11: src = p.rw_w2 + 64 * 512; dst = (bf16_t*)(ws + OFF_WW2) + 512 * 64; K = 64; Nsrc = 512; Npad = 512; return true;
    case 12: src = p.rw_a2; dst = (bf16_t*)(ws + OFF_WA2); K = 64; Nsrc = 512; Npad = 512; return true;
    default: return false;
  }
}

DI void rmsnorm_row_to_bf16(const float* __restrict__ xr, const float* __restrict__ w, bf16_t* __restrict__ o, int lane) {
  f32x4 v[4]; float ss = 0.f;
#pragma unroll
  for (int i = 0; i < 4; ++i) { v[i] = *(const f32x4*)(xr + i * 256 + lane * 4); ss += v[i][0] * v[i][0] + v[i][1] * v[i][1] + v[i][2] * v[i][2] + v[i][3] * v[i][3]; }
  ss = wave_sum(ss);
  const float rs = rsqrtf(ss * (1.0f / 1024.0f) + 1e-5f);
#pragma unroll
  for (int i = 0; i < 4; ++i) { const f32x4 g = *(const f32x4*)(w + i * 256 + lane * 4); u32x2 q; q.x = pack2(v[i][0] * rs * g[0], v[i][1] * rs * g[1]); q.y = pack2(v[i][2] * rs * g[2], v[i][3] * rs * g[3]); *(u32x2*)(o + i * 256 + lane * 4) = q; }
}

DI void phase_rmsnorm(const Ctx& c, const float* src, const float* w) {
  const Params& p = c.p; (void)p;
  bf16_t* xn = (bf16_t*)(p.ws + OFF_XN);
  const int lane = TIDX & 63, wid = TIDX >> 6;
  for (int u = blockIdx.x; u < NTOK / 4; u += gridDim.x) { const int row = u * 4 + wid; rmsnorm_row_to_bf16(src + (size_t)row * 1024, w, xn + (size_t)row * 1024, lane); }
}

DI void phase_prep(const Ctx& c, char* smem) {
  const Params& p = c.p; (void)p;
  if (blockIdx.x == 0 && TIDX == 0) { for (int i_ = 0; i_ < 17; ++i_) __hip_atomic_store((unsigned*)(p.ws + OFF_BAR) + 64 * i_, 0u, __ATOMIC_RELAXED, __HIP_MEMORY_SCOPE_AGENT); }
  float* tile = (float*)smem;
  const int tid = TIDX;
  int ntr = 0;
  for (int i = 0; i < 13; ++i) { const float* s; bf16_t* d; int K, Ns, Np; get_tdesc(c, i, s, d, K, Ns, Np); ntr += (K / 64) * (Np / 64); }
  for (int u = blockIdx.x; u < ntr; u += gridDim.x) {
    const float* src = nullptr; bf16_t* dst = nullptr; int K = 64, Ns = 0, Np = 64, r = u;
    for (int mi = 0; mi < 13; ++mi) { get_tdesc(c, mi, src, dst, K, Ns, Np); const int nt = (K / 64) * (Np / 64); if (r < nt) break; r -= nt; }
    const int nkb = K / 64, kb = r % nkb, nb = r / nkb;
    __syncthreads();
#pragma unroll
    for (int i = 0; i < 16; ++i) { const int k = i * 4 + (tid >> 6), n = tid & 63; const int gn = nb * 64 + n; tile[k * 65 + n] = gn < Ns ? src[(size_t)(kb * 64 + k) * Ns + gn] : 0.f; }
    __syncthreads();
    const int n = tid >> 2, ks = (tid & 3) * 16; float f[16];
#pragma unroll
    for (int j = 0; j < 16; ++j) f[j] = tile[(ks + j) * 65 + n];
    bf16_t* o = dst + (size_t)(nb * 64 + n) * K + kb * 64 + ks;
    *(u32x4*)o = pack8(f); *(u32x4*)(o + 8) = pack8(f + 8);
  }
  phase_rmsnorm(c, p.x, p.norm_mix);
}

template <class Epi>
DI void gemm_tile(char* smem, const bf16_t* __restrict__ A0, int lda0, int ksplit, const bf16_t* __restrict__ A1, int lda1,
                  const bf16_t* __restrict__ Bt, int K, int row0, int col0, const Epi& epi, int tid) {
  constexpr int BK = 32, PITCH = 40, BUF = (256 + 128) * PITCH;
  bf16_t* sbase = (bf16_t*)smem;
  const int lane = tid & 63, wid = tid >> 6, wr = wid >> 1, wc = wid & 1, fr = lane & 15, fq = lane >> 4;
  f32x4 acc[8][4];
#pragma unroll
  for (int m = 0; m < 8; ++m)
#pragma unroll
    for (int n = 0; n < 4; ++n) acc[m][n] = (f32x4){0.f, 0.f, 0.f, 0.f};
  u32x4 ra[2][4], rb[2][2];
  const int nk = K / BK;
  const int sr = tid >> 2, scv = tid & 3;
#define GLOAD(S, kt) do { const int k0_ = (kt) * BK; const bf16_t* Ab_; int lda_, kk_; \
    if (k0_ < ksplit) { Ab_ = A0; lda_ = lda0; kk_ = k0_; } else { Ab_ = A1; lda_ = lda1; kk_ = k0_ - ksplit; } \
    _Pragma("unroll") for (int i_ = 0; i_ < 4; ++i_) ra[S][i_] = *(const u32x4*)(Ab_ + (size_t)(row0 + sr + i_ * 64) * lda_ + kk_ + scv * 8); \
    _Pragma("unroll") for (int i_ = 0; i_ < 2; ++i_) rb[S][i_] = *(const u32x4*)(Bt + (size_t)(col0 + sr + i_ * 64) * K + k0_ + scv * 8); } while (0)
#define LWRITE(S, buf) do { bf16_t* sA_ = sbase + (buf) * BUF; bf16_t* sB_ = sA_ + 256 * PITCH; \
    _Pragma("unroll") for (int i_ = 0; i_ < 4; ++i_) *(u32x4*)(sA_ + (sr + i_ * 64) * PITCH + scv * 8) = ra[S][i_]; \
    _Pragma("unroll") for (int i_ = 0; i_ < 2; ++i_) *(u32x4*)(sB_ + (sr + i_ * 64) * PITCH + scv * 8) = rb[S][i_]; } while (0)
#define COMPUTE(buf) do { const bf16_t* sA_ = sbase + (buf) * BUF; const bf16_t* sB_ = sA_ + 256 * PITCH; \
    bf16x8 bfr[4]; \
    _Pragma("unroll") for (int n = 0; n < 4; ++n) bfr[n] = *(const bf16x8*)(sB_ + (wc * 64 + n * 16 + fr) * PITCH + fq * 8); \
    bf16x8 af[8]; \
    _Pragma("unroll") for (int m = 0; m < 8; ++m) af[m] = *(const bf16x8*)(sA_ + (wr * 128 + m * 16 + fr) * PITCH + fq * 8); \
    __builtin_amdgcn_s_setprio(1); \
    _Pragma("unroll") for (int m = 0; m < 8; ++m) { \
      _Pragma("unroll") for (int n = 0; n < 4; ++n) acc[m][n] = MFMA16(bfr[n], af[m], acc[m][n]); } \
    __builtin_amdgcn_s_setprio(0); } while (0)
  __syncthreads();
  {
    const int last = nk - 1;
    GLOAD(0, 0);
    __builtin_amdgcn_sched_barrier(0);
    GLOAD(1, 1);
    __builtin_amdgcn_sched_barrier(0);
    LWRITE(0, 0);
    __builtin_amdgcn_sched_barrier(0);
    GLOAD(0, (2 < last ? 2 : last));
    __builtin_amdgcn_sched_barrier(0);
    __syncthreads();
    for (int kt = 0; kt < nk; kt += 2) {
      LWRITE(1, 1);
      __builtin_amdgcn_sched_barrier(0);
      GLOAD(1, (kt + 3 < last ? kt + 3 : last));
      __builtin_amdgcn_sched_barrier(0);
      COMPUTE(0);
      __syncthreads();
      LWRITE(0, 0);
      __builtin_amdgcn_sched_barrier(0);
      GLOAD(0, (kt + 4 < last ? kt + 4 : last));
      __builtin_amdgcn_sched_barrier(0);
      COMPUTE(1);
      __syncthreads();
    }
  }
#undef GLOAD
#undef LWRITE
#undef COMPUTE
#pragma unroll
  for (int m = 0; m < 8; ++m)
#pragma unroll
    for (int n = 0; n < 4; ++n) epi(row0 + wr * 128 + m * 16 + fr, col0 + wc * 64 + n * 16 + fq * 4, acc[m][n]);
}

DI void st_bf16x4(bf16_t* o, f32x4 v) { u32x2 q; q.x = pack2(v[0], v[1]); q.y = pack2(v[2], v[3]); *(u32x2*)o = q; }

struct EpiSplit {
  bf16_t* o0; int ld0, n0; bf16_t* o1; int ld1, n1;
  DI void operator()(int row, int col, f32x4 v) const {
    if (col < n0) st_bf16x4(o0 + (size_t)row * ld0 + col, v);
    else { const int c = col - n0; if (c < n1) st_bf16x4(o1 + (size_t)row * ld1 + c, v); }
  }
};
struct EpiSmall { int mode; const float* b0; bf16_t* o;
  DI void operator()(int row, int col, f32x4 v) const { f32x4 r;
    if (mode == 2) r = v; else { for (int j = 0; j < 4; ++j) r[j] = sigmoidf_(b0[col + j] + v[j]); if (mode == 0) r *= 0.60653066f; }
    st_bf16x4(o + (size_t)row * 512 + col, r); } };
struct EpiStore { bf16_t* o; int ld;
  DI void operator()(int row, int col, f32x4 v) const { st_bf16x4(o + (size_t)row * ld + col, v); } };
struct EpiResid { const float* res; float* o;
  DI void operator()(int row, int col, f32x4 v) const { const f32x4 r = *(const f32x4*)(res + (size_t)row * 1024 + col); *(f32x4*)(o + (size_t)row * 1024 + col) = r + v; } };
struct EpiRelu2 { bf16_t* o;
  DI void operator()(int row, int col, f32x4 v) const { f32x4 r; for (int j = 0; j < 4; ++j) { const float t = fmaxf(v[j], 0.f); r[j] = t * t; } st_bf16x4(o + (size_t)row * 4096 + col, r); } };
struct EpiGlu { const bf16_t* y; const float* b; bf16_t* o;
  DI void operator()(int row, int col, f32x4 v) const { const u32x2 q = *(const u32x2*)(y + (size_t)row * 512 + col); f32x4 r;
    const float y0 = __uint_as_float(q.x << 16), y1 = __uint_as_float(q.x & 0xffff0000u), y2 = __uint_as_float(q.y << 16), y3 = __uint_as_float(q.y & 0xffff0000u);
    r[0] = y0 * sigmoidf_(v[0] + b[col]); r[1] = y1 * sigmoidf_(v[1] + b[col + 1]); r[2] = y2 * sigmoidf_(v[2] + b[col + 2]); r[3] = y3 * sigmoidf_(v[3] + b[col + 3]);
    st_bf16x4(o + (size_t)row * 512 + col, r); } };

template <class Epi>
DI void gemm_phase(char* smem, const bf16_t* A0, int lda0, int ksplit, const bf16_t* A1, int lda1, const bf16_t* Bt, int K, int nN, const Epi& epi, int tid) {
  const int G = gridDim.x;
  if ((G & 7) == 0) {
    const int x = blockIdx.x & 7, l = blockIdx.x >> 3, L = G >> 3, per = 8 * nN, tot = 2 * per;
    for (int q = l; q < tot; q += L) { const int rgl = q / per, rem = q % per, ct = rem >> 3, rt = (x * 2 + rgl) * 8 + (rem & 7);
      gemm_tile(smem, A0, lda0, ksplit, A1, lda1, Bt, K, rt * 256, ct * 128, epi, tid); }
  } else {
    const int ntiles = (NTOK / 256) * nN;
    for (int u = blockIdx.x; u < ntiles; u += G) { const int rt = u / nN, ct = u % nN; gemm_tile(smem, A0, lda0, ksplit, A1, lda1, Bt, K, rt * 256, ct * 128, epi, tid); }
  }
}

DI void phase_rw_shift(const Ctx& c) {
  const Params& p = c.p; (void)p;
  const bf16_t* raw = (const bf16_t*)(p.ws + OFF_R1);
  bf16_t* rkv = (bf16_t*)(p.ws + OFF_RKV); bf16_t* sm = (bf16_t*)(p.ws + OFF_SM);
  const float* mu = p.rw_mu;
  const size_t total = (size_t)NTOK * 224;
  for (size_t i = (size_t)blockIdx.x * 256 + TIDX; i < total; i += (size_t)gridDim.x * 256) {
    const int tok = (int)(i / 224), cv = (int)(i % 224), c = cv * 8, s = tok & (SEQ - 1);
    const bf16_t* rp = raw + (size_t)tok * 1792 + c;
    float cur[8], prv[8], nxt[8], o[8];
    unpack8(ld8(rp), cur);
    if (s > 0) unpack8(ld8(rp - 1792), prv); else for (int j = 0; j < 8; ++j) prv[j] = 0.f;
    if (s < SEQ - 1) unpack8(ld8(rp + 1792), nxt); else for (int j = 0; j < 8; ++j) nxt[j] = 0.f;
#pragma unroll
    for (int j = 0; j < 8; ++j) o[j] = cur[j] + mu[c + j] * (prv[j] - cur[j]) + mu[1792 + c + j] * (nxt[j] - cur[j]);
    if (c < 1536) *(u32x4*)(rkv + (size_t)tok * 1536 + c) = pack8(o);
    else if (c < 1600) { for (int j = 0; j < 8; ++j) o[j] = tanhf(o[j]); *(u32x4*)(sm + (size_t)tok * 256 + (c - 1536)) = pack8(o); }
    else if (c < 1664) *(u32x4*)(sm + (size_t)tok * 256 + 64 + (c - 1600)) = pack8(o);
    else { for (int j = 0; j < 8; ++j) o[j] = sigmoidf_(o[j]); *(u32x4*)(sm + (size_t)tok * 256 + 128 + (c - 1664)) = pack8(o); }
  }
  const bf16_t* mraw = (const bf16_t*)(p.ws + OFF_R2); bf16_t* BC = (bf16_t*)(p.ws + OFF_XN + 32 * MiB);
  const float* cw = p.mb_conv_w; const float* cb = p.mb_conv_b;
  const size_t total2 = (size_t)NTOK * 64;
  for (size_t i = (size_t)blockIdx.x * 256 + TIDX; i < total2; i += (size_t)gridDim.x * 256) {
    const int tok = (int)(i >> 6), cv = (int)(i & 63), xc = 1024 + cv * 8, t = tok & (SEQ - 1);
    const bf16_t* rp = mraw + (size_t)tok * 2592 + 1024 + xc;
    float cur[8], prv[8], nxt[8], o[8];
    unpack8(ld8(rp), cur);
    if (t > 0) unpack8(ld8(rp - 2592), prv); else for (int j = 0; j < 8; ++j) prv[j] = 0.f;
    if (t < SEQ - 1) unpack8(ld8(rp + 2592), nxt); else for (int j = 0; j < 8; ++j) nxt[j] = 0.f;
#pragma unroll
    for (int j = 0; j < 8; ++j) o[j] = siluf_(cb[xc + j] + cw[xc + j] * prv[j] + cw[1536 + xc + j] * cur[j] + cw[3072 + xc + j] * nxt[j]);
    *(u32x4*)(BC + (size_t)tok * 512 + cv * 8) = pack8(o);
  }
}

DI void phase_rw_small_gemms(const Ctx& c, char* smem) {
  const Params& p = c.p; (void)p;
  const int tid = TIDX;
  const bf16_t* sm = (const bf16_t*)(p.ws + OFF_SM);
  bf16_t* E0 = (bf16_t*)(p.ws + OFF_R1); bf16_t* E1 = E0 + (size_t)NTOK * 512; bf16_t* Ab = E1 + (size_t)NTOK * 512;
  bf16_t* G = (bf16_t*)(p.ws + OFF_XN);
  const bf16_t* W2 = (const bf16_t*)(p.ws + OFF_WW2); const bf16_t* A2 = (const bf16_t*)(p.ws + OFF_WA2); const bf16_t* G2 = (const bf16_t*)(p.ws + OFF_WG2);
  gemm_phase(smem, sm, 256, 1 << 30, sm, 256, W2, 64, 4, EpiSmall{0, p.rw_w0, E0}, tid);
  gemm_phase(smem, sm, 256, 1 << 30, sm, 256, W2 + 512 * 64, 64, 4, EpiSmall{0, p.rw_w0 + 512, E1}, tid);
  gemm_phase(smem, sm + 64, 256, 1 << 30, sm, 256, A2, 64, 4, EpiSmall{1, p.rw_a0, Ab}, tid);
  gemm_phase(smem, sm + 128, 256, 1 << 30, sm, 256, G2, 128, 4, EpiSmall{2, p.rw_a0, G}, tid);
}

typedef float f32x2 __attribute__((ext_vector_type(2)));
DI void rwkv_item(const Ctx& c, int item, char* smem) {
  const Params& p = c.p; (void)p;
  constexpr int T = 32;
  const int dir = item >> 7, b = (item >> 3) & 15, h = item & 7;
  const int tid = TIDX, lane = tid & 63, wave = tid >> 6, rp = tid >> 3, kq = tid & 7;
  float* op = (float*)smem;
  float* yo = op + T * 6 * 64;
  const bf16_t* RKV = (const bf16_t*)(p.ws + OFF_RKV);
  bf16_t* E0 = (bf16_t*)(p.ws + OFF_R1); bf16_t* Ed = E0 + (size_t)dir * NTOK * 512; const bf16_t* Ab = E0 + (size_t)2 * NTOK * 512;
  const float kkw = p.rw_k_k[h * 64 + lane], kaw = p.rw_k_a[h * 64 + lane];
  f32x2 S0[4], S1[4];
#pragma unroll
  for (int j = 0; j < 4; ++j) { S0[j] = (f32x2){0.f, 0.f}; S1[j] = (f32x2){0.f, 0.f}; }
  bf16_t pr[8], pk[8], pv[8], pa[8], pe[8];
#define RW_PREFETCH(c0_) do { _Pragma("unroll") for (int i = 0; i < 8; ++i) { const int st_ = (c0_) + wave * 8 + i, t_ = dir ? (SEQ - 1 - st_) : st_; const size_t tok_ = (size_t)b * SEQ + t_; \
    pr[i] = RKV[tok_ * 1536 + h * 64 + lane]; pk[i] = RKV[tok_ * 1536 + 512 + h * 64 + lane]; pv[i] = RKV[tok_ * 1536 + 1024 + h * 64 + lane]; \
    pa[i] = Ab[tok_ * 512 + h * 64 + lane]; pe[i] = Ed[tok_ * 512 + h * 64 + lane]; } } while (0)
  RW_PREFETCH(0);
  for (int c0 = 0; c0 < SEQ; c0 += T) {
    __syncthreads();
#pragma unroll
    for (int i = 0; i < 8; ++i) {
      const int s = wave * 8 + i;
      const float r = bf2f(pr[i]), k = bf2f(pk[i]), v = bf2f(pv[i]), a = bf2f(pa[i]), e = bf2f(pe[i]);
      float kk = k * kkw; const float ss = wave_sum(kk * kk); kk *= rsqrtf(fmaxf(ss, 1e-12f));
      float* o = op + s * 384;
      o[lane] = __expf(-e); o[64 + lane] = k * (1.0f + (a - 1.0f) * kaw); o[128 + lane] = -kk; o[192 + lane] = kk * a; o[256 + lane] = r; o[320 + lane] = v;
    }
    __syncthreads();
    if (c0 + T < SEQ) RW_PREFETCH(c0 + T);
#pragma unroll 2
    for (int s = 0; s < T; ++s) {
      const float* o = op + s * 384 + kq * 8;
      const f32x4 a0 = *(const f32x4*)(o + 128), a1 = *(const f32x4*)(o + 132);
      const f32x2 av[4] = {(f32x2){a0[0], a0[1]}, (f32x2){a0[2], a0[3]}, (f32x2){a1[0], a1[1]}, (f32x2){a1[2], a1[3]}};
      f32x2 t0 = S0[0] * av[0], t1 = S1[0] * av[0];
#pragma unroll
      for (int j = 1; j < 4; ++j) { t0 += S0[j] * av[j]; t1 += S1[j] * av[j]; }
      float sa0 = t0[0] + t0[1], sa1 = t1[0] + t1[1];
      sa0 = sum8(sa0); sa1 = sum8(sa1);
      const f32x2 vv = *(const f32x2*)(op + s * 384 + 320 + rp * 2);
      const f32x4 w0 = *(const f32x4*)(o), w1 = *(const f32x4*)(o + 4), k0 = *(const f32x4*)(o + 64), k1 = *(const f32x4*)(o + 68);
      const f32x4 b0 = *(const f32x4*)(o + 192), b1 = *(const f32x4*)(o + 196), r0 = *(const f32x4*)(o + 256), r1 = *(const f32x4*)(o + 260);
      const f32x2 wv[4] = {(f32x2){w0[0], w0[1]}, (f32x2){w0[2], w0[3]}, (f32x2){w1[0], w1[1]}, (f32x2){w1[2], w1[3]}};
      const f32x2 kv[4] = {(f32x2){k0[0], k0[1]}, (f32x2){k0[2], k0[3]}, (f32x2){k1[0], k1[1]}, (f32x2){k1[2], k1[3]}};
      const f32x2 bv[4] = {(f32x2){b0[0], b0[1]}, (f32x2){b0[2], b0[3]}, (f32x2){b1[0], b1[1]}, (f32x2){b1[2], b1[3]}};
      const f32x2 rv[4] = {(f32x2){r0[0], r0[1]}, (f32x2){r0[2], r0[3]}, (f32x2){r1[0], r1[1]}, (f32x2){r1[2], r1[3]}};
      f32x2 y0 = (f32x2){0.f, 0.f}, y1 = (f32x2){0.f, 0.f};
#pragma unroll
      for (int j = 0; j < 4; ++j) {
        S0[j] = S0[j] * wv[j] + bv[j] * sa0 + kv[j] * vv[0];
        S1[j] = S1[j] * wv[j] + bv[j] * sa1 + kv[j] * vv[1];
        y0 += S0[j] * rv[j]; y1 += S1[j] * rv[j];
      }
      float ya = y0[0] + y0[1], yb = y1[0] + y1[1];
      ya = sum8(ya); yb = sum8(yb);
      if (kq == 0) *(f32x2*)(yo + s * 64 + rp * 2) = (f32x2){ya, yb};
    }
    __syncthreads();
#pragma unroll
    for (int i = 0; i < 8; ++i) { const int idx = tid + i * 256, s = idx >> 6, kx = idx & 63, st = c0 + s, t = dir ? (SEQ - 1 - st) : st; Ed[((size_t)b * SEQ + t) * 512 + h * 64 + kx] = f2bf(yo[idx]); }
  }
#undef RW_PREFETCH
}

template <int DV>
struct Gla {
  static constexpr int NVB = DV / 16, QP = 136, VP = DV + 8, MP = QP;
  static constexpr int BYTES = (64 * QP * 2 + 64 * VP + DV * QP) * 2 + 6 * 64 * 4;
  char* sm;
  DI bf16_t* Qs() const { return (bf16_t*)sm; }
  DI bf16_t* Ks() const { return (bf16_t*)sm + 64 * QP; }
  DI bf16_t* Vs() const { return (bf16_t*)sm + 128 * QP; }
  DI bf16_t* St() const { return (bf16_t*)sm + 128 * QP + 64 * VP; }
  DI bf16_t* Ms() const { return (bf16_t*)sm; }
  DI float* P() const { return (float*)((bf16_t*)sm + 128 * QP + 64 * VP + DV * QP); }
  DI float* Qv() const { return P() + 64; }
  DI float* I() const { return P() + 128; }
  DI float* Wl() const { return P() + 192; }
  DI float* Mt() const { return P() + 256; }
  DI float* gl() const { return P() + 320; }
  f32x4 acc[NVB][2];
  int lane, w, fr, fq;
  DI void init(char* smem, int tid_) {
    sm = smem;
    lane = tid_ & 63; w = tid_ >> 6; fr = lane & 15; fq = lane >> 4;
    for (int i = tid_; i < DV * QP / 2; i += 256) ((unsigned*)St())[i] = 0u;
#pragma unroll
    for (int vb = 0; vb < NVB; ++vb) { acc[vb][0] = (f32x4){0.f, 0.f, 0.f, 0.f}; acc[vb][1] = (f32x4){0.f, 0.f, 0.f, 0.f}; }
  }
  DI bf16x8 gather(const bf16_t* base, int pitch, int r0, int col) const { bf16x8 r;
#pragma unroll
    for (int jj = 0; jj < 8; ++jj) r[jj] = (short)base[(r0 + jj) * pitch + col];
    return r; }
  DI void compute_y(f32x4 (&y)[NVB]) {
    bf16x8 qa[4];
#pragma unroll
    for (int ks = 0; ks < 4; ++ks) qa[ks] = *(const bf16x8*)(Qs() + (w * 16 + fr) * QP + ks * 32 + fq * 8);
#pragma unroll
    for (int nb = 0; nb < 4; ++nb) {
      f32x4 g = (f32x4){0.f, 0.f, 0.f, 0.f};
      if (nb <= w) {
#pragma unroll
        for (int ks = 0; ks < 4; ++ks) { const bf16x8 kb = *(const bf16x8*)(Ks() + (nb * 16 + fr) * QP + ks * 32 + fq * 8); g = MFMA16(qa[ks], kb, g); }
      }
      const int s = nb * 16 + fr; const float qs = Qv()[s];
#pragma unroll
      for (int j = 0; j < 4; ++j) { const int t = w * 16 + fq * 4 + j; const float m = (s <= t) ? g[j] * __expf(P()[t] - qs) : 0.f; Ms()[t * MP + s] = f2bf(m); }
    }
    __syncthreads();
#pragma unroll
    for (int vb = 0; vb < NVB; ++vb) y[vb] = (f32x4){0.f, 0.f, 0.f, 0.f};
#pragma unroll
    for (int ks = 0; ks < 4; ++ks)
      {
#pragma unroll
        for (int vb = 0; vb < NVB; ++vb) { const bf16x8 sb = *(const bf16x8*)(St() + (vb * 16 + fr) * QP + ks * 32 + fq * 8); y[vb] = MFMA16(qa[ks], sb, y[vb]); } __builtin_amdgcn_sched_barrier(0); }
    float sc[4];
#pragma unroll
    for (int j = 0; j < 4; ++j) sc[j] = __expf(I()[w * 16 + fq * 4 + j]);
#pragma unroll
    for (int vb = 0; vb < NVB; ++vb)
#pragma unroll
      for (int j = 0; j < 4; ++j) y[vb][j] *= sc[j];
#pragma unroll
    for (int k2 = 0; k2 < 2; ++k2) {
      if (k2 * 32 <= w * 16 + 15) {
        const bf16x8 ma = *(const bf16x8*)(Ms() + (w * 16 + fr) * MP + k2 * 32 + fq * 8);
#pragma unroll
        for (int vb = 0; vb < NVB; ++vb) { const bf16x8 vf = gather(Vs(), VP, k2 * 32 + fq * 8, vb * 16 + fr); y[vb] = MFMA16(ma, vf, y[vb]); __builtin_amdgcn_sched_barrier(0); }
      }
    }
  }
  DI void update() {
    __syncthreads();
    const float g = __expf(gl()[0]);
#pragma unroll
    for (int vb = 0; vb < NVB; ++vb) { acc[vb][0] *= g; acc[vb][1] *= g; }
#pragma unroll
    for (int k2 = 0; k2 < 2; ++k2) {
      const int s0 = k2 * 32 + fq * 8;
      float wsc[8];
#pragma unroll
      for (int jj = 0; jj < 8; ++jj) wsc[jj] = __expf(Wl()[s0 + jj]);
      const bf16x8 kb0 = gather(Ks(), QP, s0, (2 * w) * 16 + fr), kb1 = gather(Ks(), QP, s0, (2 * w + 1) * 16 + fr);
#pragma unroll
      for (int vb = 0; vb < NVB; ++vb) {
        bf16x8 va;
#pragma unroll
        for (int jj = 0; jj < 8; ++jj) va[jj] = (short)f2bf(bf2f(Vs()[(s0 + jj) * VP + vb * 16 + fr]) * wsc[jj]);
        acc[vb][0] = MFMA16(va, kb0, acc[vb][0]); acc[vb][1] = MFMA16(va, kb1, acc[vb][1]);
        __builtin_amdgcn_sched_barrier(0);
      }
    }
#pragma unroll
    for (int vb = 0; vb < NVB; ++vb)
#pragma unroll
      for (int nn = 0; nn < 2; ++nn)
#pragma unroll
        for (int j = 0; j < 4; ++j) St()[(vb * 16 + fq * 4 + j) * QP + (2 * w + nn) * 16 + fr] = f2bf(acc[vb][nn][j]);
    __syncthreads();
  }
};

DI void mamba_item(const Ctx& c, int item, char* smem) {
  const Params& p = c.p; (void)p;
  const int dir = item >> 8, b = (item >> 4) & 15, head = item & 15, gq = head >> 3;
  const int tid = TIDX;
  Gla<64> G; G.init(smem, tid);
  const bf16_t* raw = (const bf16_t*)(p.ws + OFF_R2);
  const bf16_t* BC = (const bf16_t*)(p.ws + OFF_XN + 32 * MiB);
  bf16_t* Y = (bf16_t*)p.out + (size_t)dir * NTOK * 1024;
  const float Aneg = -expf(p.mb_A_log[dir * 16 + head]), dtb = p.mb_dt_bias[dir * 16 + head];
  const int cvi = tid & 7, tg = tid >> 3, xc = head * 64 + cvi * 8;
  u32x4 px[4]; bf16_t pdt[2] = {0, 0}; bf16_t pdts = 0;
#define MB_LOADBC(c_) do { \
    _Pragma("unroll") for (int i = 0; i < 8; ++i) { const int v_ = tid + i * 256, s_ = v_ >> 5, cv_ = v_ & 31, st_ = (c_) * 64 + s_, t_ = dir ? (SEQ - 1 - st_) : st_; \
      pbc[i] = ld8(BC + ((size_t)b * SEQ + t_) * 512 + (cv_ < 16 ? 256 + gq * 128 + cv_ * 8 : gq * 128 + (cv_ - 16) * 8)); } } while (0)
#define MB_PREFETCH(c_) do { \
    { const int tb_ = dir ? (SEQ - 1 - ((c_) * 64 + tg * 2 + 1)) : ((c_) * 64 + tg * 2); \
      _Pragma("unroll") for (int j = 0; j < 4; ++j) { const int t_ = tb_ - 1 + j; px[j] = (t_ >= 0 && t_ < SEQ) ? ld8(raw + ((size_t)b * SEQ + t_) * 2592 + 1024 + xc) : (u32x4){0u, 0u, 0u, 0u}; } \
      pdt[0] = raw[((size_t)b * SEQ + tb_) * 2592 + 2560 + dir * 16 + head]; pdt[1] = raw[((size_t)b * SEQ + tb_ + 1) * 2592 + 2560 + dir * 16 + head]; } \
    if (tid < 64) { const int st_ = (c_) * 64 + tid, t_ = dir ? (SEQ - 1 - st_) : st_; pdts = raw[((size_t)b * SEQ + t_) * 2592 + 2560 + dir * 16 + head]; } } while (0)
  MB_PREFETCH(0);
  for (int c = 0; c < SEQ / 64; ++c) {
    u32x4 pbc[8];
    MB_LOADBC(c);
    { asm volatile("" ::: "memory");
      float cw0[8], cw1[8], cw2[8], cbv[8];
#pragma unroll
      for (int j = 0; j < 8; ++j) { cw0[j] = p.mb_conv_w[xc + j]; cw1[j] = p.mb_conv_w[1536 + xc + j]; cw2[j] = p.mb_conv_w[3072 + xc + j]; cbv[j] = p.mb_conv_b[xc + j]; }
      float R[4][8];
#pragma unroll
      for (int j = 0; j < 4; ++j) unpack8(px[j], R[j]);
#pragma unroll
      for (int i = 0; i < 2; ++i) {
        const int pi = dir ? (1 - i) : i;
        const float dt = softplusf_(bf2f(pdt[dir ? (1 - i) : i]) + dtb);
        float o[8];
#pragma unroll
        for (int j = 0; j < 8; ++j) o[j] = dt * siluf_(cbv[j] + cw0[j] * R[pi][j] + cw1[j] * R[pi + 1][j] + cw2[j] * R[pi + 2][j]);
        *(u32x4*)(G.Vs() + (tg * 2 + i) * G.VP + cvi * 8) = pack8(o);
      } }
    if (tid < 64) {
      const int s = tid;
      const float dt = softplusf_(bf2f(pdts) + dtb);
      const float cs = wave_incl_sum(dt * Aneg, s); const float csl = __shfl(cs, 63);
      G.P()[s] = cs; G.Qv()[s] = cs; G.I()[s] = cs; G.Wl()[s] = csl - cs; if (s == 0) G.gl()[0] = csl;
    }
#pragma unroll
    for (int i = 0; i < 8; ++i) { const int v = tid + i * 256, s = v >> 5, cv = v & 31; *(u32x4*)((cv < 16 ? G.Qs() : G.Ks()) + s * G.QP + (cv & 15) * 8) = pbc[i]; }
    if (c + 1 < SEQ / 64) MB_PREFETCH(c + 1);
    __syncthreads();
    f32x4 y[4];
    G.compute_y(y);
#pragma unroll
    for (int vb = 0; vb < 4; ++vb)
#pragma unroll
      for (int j = 0; j < 4; ++j) { const int s = G.w * 16 + G.fq * 4 + j, st = c * 64 + s, t = dir ? (SEQ - 1 - st) : st; Y[((size_t)b * SEQ + t) * 1024 + head * 64 + vb * 16 + G.fr] = f2bf(y[vb][j]); }
    G.update();
  }
#undef MB_PREFETCH
#undef MB_LOADBC
}

DI void mlstm_item(const Ctx& c, int item, char* smem) {
  const Params& p = c.p; (void)p;
  const int half = item & 1, head = (item >> 1) & 7, b = (item >> 4) & 15, dir = item >> 8;
  const int tid = TIDX;
  Gla<80> G; G.init(smem, tid);
  float* Wl_ = (float*)(smem + Gla<80>::BYTES);
  for (int i = tid; i < 128; i += 256) { const int ch = head * 128 + i, li = (i >> 3) * 12 + (i & 7); Wl_[li] = p.ml_conv_w[ch]; Wl_[192 + li] = p.ml_conv_w[1024 + ch]; Wl_[384 + li] = p.ml_conv_w[2048 + ch]; Wl_[576 + li] = p.ml_conv_b[ch]; }
  for (int i = tid; i < 512; i += 256) { const int li = (i >> 5) * 36 + (i & 31); Wl_[768 + li] = p.ml_wq[head * 512 + i]; Wl_[768 + 576 + li] = p.ml_wk[head * 512 + i] * 0.08838834764831845f; Wl_[768 + 1152 + li] = p.ml_wv[head * 512 + i]; }
  if (tid < 64) { for (int j = 0; j < 16; ++j) G.Vs()[tid * G.VP + 64 + j] = (j == 0) ? (bf16_t)0x3f80 : (bf16_t)0; }
  const bf16_t* raw = (const bf16_t*)(p.ws + OFF_MLRAW);
  bf16_t* H = (bf16_t*)(p.ws + OFF_HFB) + (size_t)dir * NTOK * 1024;
  const float ib = p.ml_i_b[dir * 8 + head], fb = p.ml_f_b[dir * 8 + head];
  const int cvi = tid & 15, tg = tid >> 4, ch = head * 128 + cvi * 8;
  float mprev = 0.f;
  u32x4 px[6]; bf16_t pgi = 0, pgf = 0;
#define ML_PREFETCH(c_) do { const int tb_ = dir ? (SEQ - 1 - ((c_) * 64 + tg * 4 + 3)) : ((c_) * 64 + tg * 4); \
    _Pragma("unroll") for (int j = 0; j < 6; ++j) { const int t_ = tb_ - 1 + j; px[j] = (t_ >= 0 && t_ < SEQ) ? ld8(raw + ((size_t)b * SEQ + t_) * 2080 + ch) : (u32x4){0u, 0u, 0u, 0u}; } \
    if (tid < 64) { const int st_ = (c_) * 64 + tid, t_ = dir ? (SEQ - 1 - st_) : st_; const size_t tok_ = (size_t)b * SEQ + t_; pgi = raw[tok_ * 2080 + 2048 + dir * 8 + head]; pgf = raw[tok_ * 2080 + 2064 + dir * 8 + head]; } } while (0)
  ML_PREFETCH(0);
  __syncthreads();
  for (int c = 0; c < SEQ / 64; ++c) {
    {
#pragma unroll
      for (int i = 0; i < 4; ++i) {
        float prv[8], cur[8], nxt[8];
        { const u32x4 a = dir ? px[3 - i] : px[i], bq = dir ? px[4 - i] : px[i + 1], cq = dir ? px[5 - i] : px[i + 2]; unpack8(a, prv); unpack8(bq, cur); unpack8(cq, nxt); }
        float xcv[8], q[8], k[8], v[8];
#pragma unroll
        for (int j4 = 0; j4 < 2; ++j4) {
          const f32x4 w0 = *(const f32x4*)(Wl_ + cvi * 12 + j4 * 4), w1 = *(const f32x4*)(Wl_ + 192 + cvi * 12 + j4 * 4), w2 = *(const f32x4*)(Wl_ + 384 + cvi * 12 + j4 * 4), bb = *(const f32x4*)(Wl_ + 576 + cvi * 12 + j4 * 4);
#pragma unroll
          for (int j = 0; j < 4; ++j) xcv[j4 * 4 + j] = siluf_(bb[j] + w0[j] * prv[j4 * 4 + j] + w1[j] * cur[j4 * 4 + j] + w2[j] * nxt[j4 * 4 + j]);
        }
#pragma unroll
        for (int bl = 0; bl < 2; ++bl) {
          f32x4 aq = (f32x4){0.f, 0.f, 0.f, 0.f}, ak = aq, av = aq;
#pragma unroll
          for (int cc = 0; cc < 4; ++cc) {
            const int wi = cvi * 36 + bl * 16 + cc * 4;
            aq += *(const f32x4*)(Wl_ + 768 + wi) * xcv[bl * 4 + cc]; ak += *(const f32x4*)(Wl_ + 768 + 576 + wi) * xcv[bl * 4 + cc]; av += *(const f32x4*)(Wl_ + 768 + 1152 + wi) * cur[bl * 4 + cc];
          }
#pragma unroll
          for (int d = 0; d < 4; ++d) { q[bl * 4 + d] = aq[d]; k[bl * 4 + d] = ak[d]; v[bl * 4 + d] = av[d]; }
        }
        const int s = tg * 4 + i;
        *(u32x4*)(G.Qs() + s * G.QP + cvi * 8) = pack8(q);
        *(u32x4*)(G.Ks() + s * G.QP + cvi * 8) = pack8(k);
        if ((cvi >> 3) == half) *(u32x4*)(G.Vs() + s * G.VP + (cvi & 7) * 8) = pack8(v);
        __builtin_amdgcn_sched_barrier(0);
      } }
    if (tid < 64) {
      const int s = tid;
      const float li = bf2f(pgi) + ib;
      const float fx = bf2f(pgf) + fb;
      const float lf = fminf(fx, 0.f) - __logf(1.0f + __expf(-fabsf(fx)));
      const float bc = wave_incl_sum(lf, s);
      const float cc = li - bc;
      const float pm = fmaxf(wave_incl_max(cc, s), mprev);
      const float pml = __shfl(pm, 63), bl = __shfl(bc, 63);
      G.P()[s] = -pm; G.Qv()[s] = -cc; G.I()[s] = mprev - pm; G.Wl()[s] = cc - pml; G.Mt()[s] = bc + pm; if (s == 0) G.gl()[0] = mprev - pml;
      mprev = bl + pml;
    }
    if (c + 1 < SEQ / 64) ML_PREFETCH(c + 1);
    __syncthreads();
    f32x4 y[5];
    G.compute_y(y);
#pragma unroll
    for (int j = 0; j < 4; ++j) {
      const float den = __shfl(y[4][j], G.lane & 48);
      const int s = G.w * 16 + G.fq * 4 + j, st = c * 64 + s, t = dir ? (SEQ - 1 - st) : st;
      const float dn = 1.0f / fmaxf(fabsf(den), __expf(-G.Mt()[s]));
#pragma unroll
      for (int vb = 0; vb < 4; ++vb) H[((size_t)b * SEQ + t) * 1024 + head * 128 + half * 64 + vb * 16 + G.fr] = f2bf(y[vb][j] * dn);
    }
    G.update();
  }
#undef ML_PREFETCH
}

DI void s5_item(const Ctx& c, int item, char* smem) {
  const Params& p = c.p; (void)p;
  constexpr int T = 16, XP = 136, BP = 132;
  const int dir = item >> 7, b = (item >> 3) & 15, gq = item & 7;
  const int tid = TIDX, lane = tid & 63, wave = tid >> 6, fr = lane & 15, fq = lane >> 4;
  const int g = gq * 4 + wave;
  float* BUw = (float*)smem + wave * (T * BP);
  bf16_t* Xw = (bf16_t*)(smem + 4 * T * BP * 4) + wave * (T * XP);
  const bf16_t* U = (const bf16_t*)(p.ws + OFF_S5U);
  bf16_t* Y = (bf16_t*)(p.ws + OFF_S5Y) + (size_t)dir * NTOK * 512;
  const float dtv = expf(p.s5_log_dt[dir * 32 + g]);
  float abr, abi;
  { const float ar = fminf(p.s5_A_re[(dir * 32 + g) * 64 + lane], -1e-4f), ai = p.s5_A_im[(dir * 32 + g) * 64 + lane];
    const float mag = expf(dtv * ar); abr = mag * cosf(dtv * ai); abi = mag * sinf(dtv * ai); }
  bf16x8 bf_[8];
#pragma unroll
  for (int q = 0; q < 4; ++q) {
    const int pp = q * 16 + fr;
    const float ar = fminf(p.s5_A_re[(dir * 32 + g) * 64 + pp], -1e-4f), ai = p.s5_A_im[(dir * 32 + g) * 64 + pp];
    const float mag = expf(dtv * ar), br_ = mag * cosf(dtv * ai), bi_ = mag * sinf(dtv * ai), den = ar * ar + ai * ai;
    const float f_r = ((br_ - 1.0f) * ar + bi_ * ai) / den, f_i = (bi_ * ar - (br_ - 1.0f) * ai) / den;
    float vr[8], vi[8];
#pragma unroll
    for (int jj = 0; jj < 8; ++jj) {
      float bre = 0.f, bim = 0.f;
      if (fq < 2) { bre = p.s5_B_re[(g * 64 + pp) * 16 + fq * 8 + jj]; bim = p.s5_B_im[(g * 64 + pp) * 16 + fq * 8 + jj]; }
      vr[jj] = f_r * bre - f_i * bim; vi[jj] = f_r * bim + f_i * bre;
    }
    bf_[q] = __builtin_bit_cast(bf16x8, pack8(vr)); bf_[4 + q] = __builtin_bit_cast(bf16x8, pack8(vi));
  }
  bf16x8 cf[4];
#pragma unroll
  for (int ks = 0; ks < 4; ++ks) {
    float cv[8];
#pragma unroll
    for (int jj = 0; jj < 8; ++jj) { const int k = ks * 32 + fq * 8 + jj; const size_t base = ((size_t)(dir * 32 + g) * 16 + fr) * 64; cv[jj] = k < 64 ? p.s5_C_re[base + k] : -p.s5_C_im[base + k - 64]; }
    cf[ks] = __builtin_bit_cast(bf16x8, pack8(cv));
  }
  float xr = 0.f, xi = 0.f;
  u32x4 pu;
#define S5_PREFETCH(c0_) do { const int st_ = (c0_) + fr, t_ = dir ? (SEQ - 1 - st_) : st_; \
    pu = (fq < 2) ? ld8(U + ((size_t)b * SEQ + t_) * 512 + g * 16 + fq * 8) : (u32x4){0u, 0u, 0u, 0u}; } while (0)
  S5_PREFETCH(0);
  for (int c0 = 0; c0 < SEQ; c0 += T) {
    const bf16x8 ua = __builtin_bit_cast(bf16x8, pu);
    if (c0 + T < SEQ) S5_PREFETCH(c0 + T);
    asm volatile("" ::: "memory");
#pragma unroll
    for (int nb = 0; nb < 8; ++nb) {
      f32x4 bu = MFMA16(ua, bf_[nb], ((f32x4){0.f, 0.f, 0.f, 0.f}));
#pragma unroll
      for (int j = 0; j < 4; ++j) BUw[(fq * 4 + j) * BP + nb * 16 + fr] = bu[j];
    }
    asm volatile("" ::: "memory");
#pragma unroll
    for (int s = 0; s < T; ++s) {
      const float bur = BUw[s * BP + lane], bui = BUw[s * BP + 64 + lane];
      const float nr = abr * xr - abi * xi + bur, ni = abr * xi + abi * xr + bui;
      xr = nr; xi = ni;
      const unsigned pk = pack2(xr, xi);
      Xw[s * XP + lane] = (bf16_t)(pk & 0xffffu); Xw[s * XP + 64 + lane] = (bf16_t)(pk >> 16);
    }
    asm volatile("" ::: "memory");
    f32x4 y = (f32x4){0.f, 0.f, 0.f, 0.f};
#pragma unroll
    for (int ks = 0; ks < 4; ++ks) { const bf16x8 xa = *(const bf16x8*)(Xw + fr * XP + ks * 32 + fq * 8); y = MFMA16(xa, cf[ks], y); }
#pragma unroll
    for (int j = 0; j < 4; ++j) { const int st = c0 + fq * 4 + j, t = dir ? (SEQ - 1 - st) : st; Y[((size_t)b * SEQ + t) * 512 + g * 16 + fr] = f2bf(y[j]); }
  }
#undef S5_PREFETCH
}

DI void phase_post0(const Ctx& c) {
  const Params& p = c.p; (void)p;
  const int lane = TIDX & 63, wid = TIDX >> 6;
  const int gw = blockIdx.x * 4 + wid, nw = gridDim.x * 4;
  {
    bf16_t* E0 = (bf16_t*)(p.ws + OFF_R1); const bf16_t* E1 = E0 + (size_t)NTOK * 512; const bf16_t* Ab = E1 + (size_t)NTOK * 512;
    const bf16_t* G = (const bf16_t*)(p.ws + OFF_XN); const bf16_t* RKV = (const bf16_t*)(p.ws + OFF_RKV);
    for (int tok = gw; tok < NTOK; tok += nw) {
      const int c = lane * 8;
      float y0[8], y1[8], r[8], k[8], v[8], a[8], g[8], o[8];
      unpack8(ld8(E0 + (size_t)tok * 512 + c), y0); unpack8(ld8(E1 + (size_t)tok * 512 + c), y1);
      unpack8(ld8(RKV + (size_t)tok * 1536 + c), r); unpack8(ld8(RKV + (size_t)tok * 1536 + 512 + c), k); unpack8(ld8(RKV + (size_t)tok * 1536 + 1024 + c), v);
      unpack8(ld8(Ab + (size_t)tok * 512 + c), a); unpack8(ld8(G + (size_t)tok * 512 + c), g);
      float sy = 0.f, sb = 0.f;
#pragma unroll
      for (int j = 0; j < 8; ++j) { y0[j] += y1[j]; sy += y0[j]; const float k2 = k[j] * (1.0f + (a[j] - 1.0f) * p.rw_k_a[c + j]); sb += r[j] * k2 * p.rw_r_k[c + j]; }
      const float mean = sum8(sy) * (1.0f / 64.0f); sb = sum8(sb);
      float sv = 0.f;
#pragma unroll
      for (int j = 0; j < 8; ++j) { y0[j] -= mean; sv += y0[j] * y0[j]; }
      const float rs = rsqrtf(sum8(sv) * (1.0f / 64.0f) + 64e-5f);
#pragma unroll
      for (int j = 0; j < 8; ++j) o[j] = (y0[j] * rs * p.rw_ln_w[c + j] + sb * v[j]) * g[j];
      *(u32x4*)(E0 + (size_t)tok * 512 + c) = pack8(o);
    }
  }
  {
    bf16_t* raw = (bf16_t*)(p.ws + OFF_R2);
    const bf16_t* Y0 = (const bf16_t*)p.out; const bf16_t* Y1 = Y0 + (size_t)NTOK * 1024;
    const float* cw = p.mb_conv_w; const float* cb = p.mb_conv_b;
    for (int u = gw; u < NTOK * 2; u += nw) {
      const int tok = u >> 1, gq = u & 1, col = gq * 512 + lane * 8, head = col >> 6, t = tok & (SEQ - 1);
      float y0[8], y1[8], z[8], cur[8], prv[8], nxt[8], o[8];
      unpack8(ld8(Y0 + (size_t)tok * 1024 + col), y0); unpack8(ld8(Y1 + (size_t)tok * 1024 + col), y1);
      bf16_t* zp = raw + (size_t)tok * 2592 + col;
      unpack8(ld8(zp), z);
      const bf16_t* rp = zp + 1024;
      unpack8(ld8(rp), cur);
      if (t > 0) unpack8(ld8(rp - 2592), prv); else for (int j = 0; j < 8; ++j) prv[j] = 0.f;
      if (t < SEQ - 1) unpack8(ld8(rp + 2592), nxt); else for (int j = 0; j < 8; ++j) nxt[j] = 0.f;
      const float D = p.mb_D[head];
      float ss = 0.f;
#pragma unroll
      for (int j = 0; j < 8; ++j) { const float xs = siluf_(cb[col + j] + cw[col + j] * prv[j] + cw[1536 + col + j] * cur[j] + cw[3072 + col + j] * nxt[j]);
        const float yy = (y0[j] + y1[j] + D * xs) * siluf_(z[j]); o[j] = yy; ss += yy * yy; }
      ss = wave_sum(ss);
      const float rs = rsqrtf(ss * (1.0f / 512.0f) + 1e-5f);
#pragma unroll
      for (int j = 0; j < 8; ++j) o[j] = o[j] * rs * p.mb_norm_w[col + j];
      *(u32x4*)zp = pack8(o);
    }
  }
}

DI float gelu_tanh(float x) { const float u = 0.7978845608028654f * (x + 0.044715f * x * x * x); return 0.5f * x * (1.0f + tanhf(u)); }

DI void phase_post1(const Ctx& c) {
  const Params& p = c.p; (void)p;
  const int lane = TIDX & 63, wid = TIDX >> 6;
  const int gw = blockIdx.x * 4 + wid, nw = gridDim.x * 4;
  {
    const bf16_t* U = (const bf16_t*)(p.ws + OFF_S5U); const bf16_t* Y0 = (const bf16_t*)(p.ws + OFF_S5Y); const bf16_t* Y1 = Y0 + (size_t)NTOK * 512;
    bf16_t* YG = (bf16_t*)(p.ws + OFF_YG);
    for (int tok = gw; tok < NTOK; tok += nw) {
      const int col = lane * 8; float u[8], a[8], c[8], o[8];
      unpack8(ld8(U + (size_t)tok * 512 + col), u); unpack8(ld8(Y0 + (size_t)tok * 512 + col), a); unpack8(ld8(Y1 + (size_t)tok * 512 + col), c);
#pragma unroll
      for (int j = 0; j < 8; ++j) o[j] = gelu_tanh(p.s5_D[col + j] * u[j] + a[j] + c[j]);
      *(u32x4*)(YG + (size_t)tok * 512 + col) = pack8(o);
    }
  }
  {
    bf16_t* raw = (bf16_t*)(p.ws + OFF_MLRAW);
    const bf16_t* HF = (const bf16_t*)(p.ws + OFF_HFB); const bf16_t* HB = HF + (size_t)NTOK * 1024;
    for (int u = gw; u < NTOK * 2; u += nw) {
      const int tok = u >> 1, c = (u & 1) * 512 + lane * 8, t = tok & (SEQ - 1);
      float hf[8], hb[8], cur[8], prv[8], nxt[8], og[8], o[8];
      unpack8(ld8(HF + (size_t)tok * 1024 + c), hf); unpack8(ld8(HB + (size_t)tok * 1024 + c), hb);
      bf16_t* xp = raw + (size_t)tok * 2080 + c;
      unpack8(ld8(xp), cur);
      if (t > 0) unpack8(ld8(xp - 2080), prv); else for (int j = 0; j < 8; ++j) prv[j] = 0.f;
      if (t < SEQ - 1) unpack8(ld8(xp + 2080), nxt); else for (int j = 0; j < 8; ++j) nxt[j] = 0.f;
      unpack8(ld8(xp + 1024), og);
      float sh = 0.f;
#pragma unroll
      for (int j = 0; j < 8; ++j) { hf[j] += hb[j]; sh += hf[j]; }
      sh = sum8(sh); sh += dpp_mov<0x140>(sh);
      const float mean = sh * (1.0f / 128.0f);
      float sv = 0.f;
#pragma unroll
      for (int j = 0; j < 8; ++j) { hf[j] -= mean; sv += hf[j] * hf[j]; }
      sv = sum8(sv); sv += dpp_mov<0x140>(sv);
      const float rs = rsqrtf(sv * (1.0f / 128.0f) + 1e-5f);
#pragma unroll
      for (int j = 0; j < 8; ++j) {
        const float xcv = siluf_(p.ml_conv_b[c + j] + p.ml_conv_w[c + j] * prv[j] + p.ml_conv_w[1024 + c + j] * cur[j] + p.ml_conv_w[2048 + c + j] * nxt[j]);
        o[j] = sigmoidf_(og[j]) * (hf[j] * rs * p.ml_norm_w[c + j]) + p.ml_skip[c + j] * xcv;
      }
      *(u32x4*)(xp + 1024) = pack8(o);
    }
  }
}

DI void phase_final(const Ctx& c) {
  const Params& p = c.p; (void)p;
  const int lane = TIDX & 63, wid = TIDX >> 6;
  for (int u = blockIdx.x; u < NTOK / 4; u += gridDim.x) {
    float* xr = p.out + (size_t)(u * 4 + wid) * 1024;
    f32x4 v[4]; float ss = 0.f;
#pragma unroll
    for (int i = 0; i < 4; ++i) { v[i] = *(const f32x4*)(xr + i * 256 + lane * 4); ss += v[i][0] * v[i][0] + v[i][1] * v[i][1] + v[i][2] * v[i][2] + v[i][3] * v[i][3]; }
    ss = wave_sum(ss);
    const float rs = rsqrtf(ss * (1.0f / 1024.0f) + 1e-5f);
#pragma unroll
    for (int i = 0; i < 4; ++i) { const f32x4 g = *(const f32x4*)(p.norm_final + i * 256 + lane * 4); *(f32x4*)(xr + i * 256 + lane * 4) = v[i] * rs * g; }
  }
}

constexpr int NPHASE = 20;
#ifdef NO_RW
#define RWK(x)
#else
#define RWK(x) x
#endif
#ifdef NO_MB
#define MBK(x)
#else
#define MBK(x) x
#endif
#ifndef ONLY_PHASE
#define ONLY_PHASE -1
#endif
#define PH(k) case k: if (ONLY_PHASE >= 0 && ONLY_PHASE != k) break;
template <int ph> DI void run_phase(const Ctx& c, char* smem) {
  const Params& p = c.p; (void)p;
  char* ws = p.ws;
  bf16_t* XN = (bf16_t*)(ws + OFF_XN);
  switch (ph) {
    PH(0) phase_prep(c, smem); break;
    PH(1) gemm_phase(smem, XN, 1024, 1 << 30, XN, 1024, (const bf16_t*)(ws + OFF_WABIN), 1024, 35,
                       EpiSplit{(bf16_t*)(ws + OFF_R1), 1792, 1792, (bf16_t*)(ws + OFF_R2), 2592, 2592}, TIDX); break;
    PH(2) phase_rw_shift(c); break;
    PH(3) phase_rw_small_gemms(c, smem); break;
    PH(4) {
      const int G = gridDim.x, bx = blockIdx.x;
      if (G >= 512) { if (bx < 256) { RWK(rwkv_item(c, bx, smem);) } else for (int u = bx - 256; u < 512; u += G - 256) { MBK(mamba_item(c, u, smem);) } }
      else { for (int u = bx; u < 256; u += G) { RWK(rwkv_item(c, u, smem);) } __syncthreads(); for (int u = bx + ((256 - bx + G - 1) / G) * G; u < 768; u += G) { MBK(mamba_item(c, u - 256, smem);) } }
    } break;
    PH(5) phase_post0(c); break;
    PH(6) gemm_phase(smem, (const bf16_t*)(ws + OFF_R1), 512, 512, (const bf16_t*)(ws + OFF_R2), 2592, (const bf16_t*)(ws + OFF_WABOUT), 1536, 8, EpiResid{p.x, p.out}, TIDX); break;
    PH(7) phase_rmsnorm(c, p.out, p.norm_mlp); break;
    PH(8) gemm_phase(smem, XN, 1024, 1 << 30, XN, 1024, (const bf16_t*)(ws + OFF_W1), 1024, 32, EpiRelu2{(bf16_t*)(ws + OFF_R1)}, TIDX); break;
    PH(9) gemm_phase(smem, (const bf16_t*)(ws + OFF_R1), 4096, 1 << 30, XN, 1024, (const bf16_t*)(ws + OFF_W2), 4096, 8, EpiResid{p.out, p.out}, TIDX); break;
    PH(10) phase_rmsnorm(c, p.out, p.norm_mix + 1024); break;
    PH(11) gemm_phase(smem, XN, 1024, 1 << 30, XN, 1024, (const bf16_t*)(ws + OFF_WCDIN), 1024, 21,
                        EpiSplit{(bf16_t*)(ws + OFF_S5U), 512, 512, (bf16_t*)(ws + OFF_MLRAW), 2080, 2080}, TIDX); break;
    PH(12) {
      const int G = gridDim.x, bx = blockIdx.x;
      if (G >= 512) { if (bx >= 256 && bx < 512) s5_item(c, bx - 256, smem); __syncthreads(); for (int u = bx; u < 512; u += G) mlstm_item(c, u, smem); }
      else { for (int u = bx; u < 512; u += G) mlstm_item(c, u, smem);
        __syncthreads();
        { int u0 = bx + ((512 - bx + G - 1) / G) * G; for (int u = u0; u < 768; u += G) s5_item(c, u - 512, smem); } }
    } break;
    PH(13) phase_post1(c); break;
    PH(14) gemm_phase(smem, (const bf16_t*)(ws + OFF_YG), 512, 1 << 30, XN, 1024, (const bf16_t*)(ws + OFF_WGLU), 512, 4,
                        EpiGlu{(const bf16_t*)(ws + OFF_YG), p.s5_glu_b, (bf16_t*)(ws + OFF_S5Y)}, TIDX); break;
    PH(15) gemm_phase(smem, (const bf16_t*)(ws + OFF_S5Y), 512, 512, (const bf16_t*)(ws + OFF_MLRAW) + 1024, 2080, (const bf16_t*)(ws + OFF_WCDOUT), 1536, 8, EpiResid{p.out, p.out}, TIDX); break;
    PH(16) phase_rmsnorm(c, p.out, p.norm_mlp + 1024); break;
    PH(17) gemm_phase(smem, XN, 1024, 1 << 30, XN, 1024, (const bf16_t*)(ws + OFF_W1) + 4096ull * 1024, 1024, 32, EpiRelu2{(bf16_t*)(ws + OFF_R1)}, TIDX); break;
    PH(18) gemm_phase(smem, (const bf16_t*)(ws + OFF_R1), 4096, 1 << 30, XN, 1024, (const bf16_t*)(ws + OFF_W2) + 4096ull * 1024, 4096, 8, EpiResid{p.out, p.out}, TIDX); break;
    PH(19) phase_final(c); break;
    default: break;
  }
}

DI void grid_barrier(const Ctx& c, unsigned idx) {
  const Params& p = c.p; (void)p;
  asm volatile("s_waitcnt vmcnt(0)" ::: "memory");
  __syncthreads();
  if (TIDX == 0) {
    unsigned* bar = (unsigned*)(p.ws + OFF_BAR);
    const unsigned G = gridDim.x, grp = blockIdx.x & 7u;
    const unsigned gsz = (G >> 3) + ((grp < (G & 7u)) ? 1u : 0u);
    const unsigned ngrp = G < 8u ? G : 8u;
    __builtin_amdgcn_fence(__ATOMIC_RELEASE, "agent");
    asm volatile("s_waitcnt vmcnt(0)" ::: "memory");
    const unsigned old = __hip_atomic_fetch_add(bar + 64 * (1 + grp), 1u, __ATOMIC_RELAXED, __HIP_MEMORY_SCOPE_AGENT);
    if (old + 1u == idx * gsz) {
      __builtin_amdgcn_fence(__ATOMIC_ACQ_REL, "agent");
      asm volatile("s_waitcnt vmcnt(0)" ::: "memory");
      const unsigned og = __hip_atomic_fetch_add(bar, 1u, __ATOMIC_RELAXED, __HIP_MEMORY_SCOPE_AGENT);
      if (og + 1u == idx * ngrp) {
        for (unsigned g_ = 0; g_ < ngrp; ++g_) __hip_atomic_store(bar + 64 * (9 + g_), idx, __ATOMIC_RELAXED, __HIP_MEMORY_SCOPE_AGENT);
      }
    }
    while (__hip_atomic_load(bar + 64 * (9 + grp), __ATOMIC_RELAXED, __HIP_MEMORY_SCOPE_AGENT) < idx) __builtin_amdgcn_s_sleep(1);
    __builtin_amdgcn_fence(__ATOMIC_ACQUIRE, "agent");
    asm volatile("s_waitcnt vmcnt(0)" ::: "memory");
  }
  __syncthreads();
}

template <int PHI> DI void run_from(const Ctx& c, char* smem, int ph0, int ph1) {
  const Params& p = c.p; (void)p;
  if constexpr (PHI < NPHASE) {
    if (ph0 <= PHI && PHI < ph1) {
      run_phase<PHI>(c, smem);
      if (PHI + 1 < ph1) {
        if constexpr (PHI == 0) { __syncthreads(); cg::this_grid().sync(); }
        else grid_barrier(c, (unsigned)PHI);
      }
    }
    run_from<PHI + 1>(c, smem, ph0, ph1);
  }
}

__global__ void __launch_bounds__(256, 2) mega(Params p, int ph0, int ph1) {
  extern __shared__ __attribute__((aligned(16))) char smem[];
  const Ctx c{p, __builtin_amdgcn_readfirstlane((int)(__builtin_amdgcn_workitem_id_x() >> 6))};
  run_from<0>(c, smem, ph0, ph1);
}

#ifndef ONE_LAUNCH
#define ONE_LAUNCH 1
#endif

extern "C" void kernel_launch(void* const* d_in, const int* in_sizes, int n_in, void* d_out, int out_size, void* d_ws, size_t ws_size,
                              hipStream_t stream) {
  static int grid_blocks = 0;
  if (!grid_blocks) {
    hipFuncSetAttribute((const void*)mega, hipFuncAttributeMaxDynamicSharedMemorySize, LDS_BYTES);
    int dev = 0, cus = 0, per_cu = 0;
    hipGetDevice(&dev);
    hipDeviceGetAttribute(&cus, hipDeviceAttributeMultiprocessorCount, dev);
    hipOccupancyMaxActiveBlocksPerMultiprocessor(&per_cu, mega, 256, LDS_BYTES);
    if (per_cu > 2) per_cu = 2;
    if (per_cu < 1) per_cu = 1;
    grid_blocks = cus * per_cu;
  }
  Params p{};
  const float** pf = (const float**)&p;
  for (int i = 0; i < 45; ++i) pf[i] = (const float*)d_in[i];
  p.out = (float*)d_out;
  p.ws = (char*)d_ws;
#if ONE_LAUNCH
  int ph0 = 0, ph1 = NPHASE;
  void* args[] = {&p, &ph0, &ph1};
  hipError_t e = hipLaunchCooperativeKernel((const void*)mega, dim3(grid_blocks), dim3(256), args, LDS_BYTES, stream);
  if (e != hipSuccess) fprintf(stderr, "cooperative launch failed: %s (grid %d)\n", hipGetErrorString(e), grid_blocks);
#else
  for (int ph = 0; ph < NPHASE; ++ph) hipLaunchKernelGGL(mega, dim3(grid_blocks), dim3(256), LDS_BYTES, stream, p, ph, ph + 1);
#endif
}
```

```cpp
#include <hip/hip_runtime.h>
#include <hip/hip_cooperative_groups.h>
#include <stdint.h>
#include <cstdio>
namespace cg = cooperative_groups;

typedef unsigned short bf16_t;
typedef short bf16x8 __attribute__((ext_vector_type(8)));
typedef float f32x4 __attribute__((ext_vector_type(4)));
typedef unsigned u32x4 __attribute__((ext_vector_type(4)));
typedef unsigned u32x2 __attribute__((ext_vector_type(2)));

#define DI __device__ __forceinline__
#define LANEID() ((int)__builtin_amdgcn_mbcnt_hi(~0u, __builtin_amdgcn_mbcnt_lo(~0u, 0u)))
#define TIDX (c.wid * 64 + LANEID())
#define MFMA16(a, b, c) __builtin_amdgcn_mfma_f32_16x16x32_bf16((a), (b), (c), 0, 0, 0)

constexpr int NTOK = 32768, SEQ = 2048;
constexpr size_t MiB = 1ull << 20;
constexpr size_t OFF_WABIN = 0;
constexpr size_t OFF_WABOUT = OFF_WABIN + 4480ull * 1024 * 2;
constexpr size_t OFF_W1 = OFF_WABOUT + 1024ull * 1536 * 2;
constexpr size_t OFF_W2 = OFF_W1 + 2ull * 4096 * 1024 * 2;
constexpr size_t OFF_WCDIN = OFF_W2 + 2ull * 4096 * 1024 * 2;
constexpr size_t OFF_WCDOUT = OFF_WCDIN + 2688ull * 1024 * 2;
constexpr size_t OFF_WGLU = OFF_WCDOUT + 1024ull * 1536 * 2;
constexpr size_t OFF_WG2 = OFF_WGLU + 512ull * 512 * 2;
constexpr size_t OFF_WW2 = OFF_WG2 + 512ull * 128 * 2;
constexpr size_t OFF_WA2 = OFF_WW2 + 2ull * 512 * 64 * 2;
constexpr size_t OFF_WEND = OFF_WA2 + 512ull * 64 * 2;
static_assert(OFF_WEND <= 56 * MiB, "weights region");
constexpr size_t OFF_XN = 56 * MiB;
constexpr size_t OFF_R1 = 120 * MiB;
constexpr size_t OFF_R2 = 232 * MiB;
constexpr size_t OFF_RKV = 394 * MiB;
constexpr size_t OFF_SM = 490 * MiB;
constexpr size_t OFF_S5U = 120 * MiB;
constexpr size_t OFF_MLRAW = 152 * MiB;
constexpr size_t OFF_S5Y = 282 * MiB;
constexpr size_t OFF_HFB = 346 * MiB;
constexpr size_t OFF_YG = 474 * MiB;
constexpr size_t OFF_BAR = 510 * MiB;
constexpr int LDS_BYTES = 79872;

struct Params {
  const float *x, *norm_mix, *norm_mlp, *norm_final, *mlp_w1, *mlp_w2, *ab_w_in, *ab_w_out, *rw_mu, *rw_w0, *rw_w2, *rw_a0,
      *rw_a2, *rw_g2, *rw_k_k, *rw_k_a, *rw_r_k, *rw_ln_w, *mb_conv_w, *mb_conv_b, *mb_dt_bias, *mb_A_log, *mb_D, *mb_norm_w,
      *cd_w_in, *cd_w_out, *s5_A_re, *s5_A_im, *s5_log_dt, *s5_B_re, *s5_B_im, *s5_C_re, *s5_C_im, *s5_D, *s5_glu_w, *s5_glu_b,
      *ml_conv_w, *ml_conv_b, *ml_wq, *ml_wk, *ml_wv, *ml_i_b, *ml_f_b, *ml_norm_w, *ml_skip;
  float* out;
  char* ws;
};
struct Ctx { const Params& p; int wid; };

DI float bf2f(bf16_t v) { return __uint_as_float(((unsigned)v) << 16); }
typedef float f32x2c __attribute__((ext_vector_type(2)));
typedef __bf16 bf16x2c __attribute__((ext_vector_type(2)));
DI unsigned pack2(float lo, float hi) { const f32x2c v = {lo, hi}; return __builtin_bit_cast(unsigned, __builtin_convertvector(v, bf16x2c)); }
DI bf16_t f2bf(float x) { return (bf16_t)(pack2(x, x) & 0xffffu); }
DI void unpack8(u32x4 w, float* f) {
#pragma unroll
  for (int i = 0; i < 4; ++i) { f[2 * i] = __uint_as_float(w[i] << 16); f[2 * i + 1] = __uint_as_float(w[i] & 0xffff0000u); }
}
DI u32x4 pack8(const float* f) { u32x4 w; w.x = pack2(f[0], f[1]); w.y = pack2(f[2], f[3]); w.z = pack2(f[4], f[5]); w.w = pack2(f[6], f[7]); return w; }
DI u32x4 ld8(const bf16_t* p) { return *(const u32x4*)p; }
template <int CTRL> DI float dpp_mov(float v) { return __int_as_float(__builtin_amdgcn_update_dpp(0, __float_as_int(v), CTRL, 0xF, 0xF, true)); }
DI float sum8(float v) { v += dpp_mov<0xB1>(v); v += dpp_mov<0x4E>(v); v += dpp_mov<0x141>(v); return v; }
DI float wave_sum(float v) {
  v = sum8(v); v += dpp_mov<0x140>(v);
  v += __shfl_xor(v, 16); v += __shfl_xor(v, 32);
  return v;
}
DI float sigmoidf_(float x) { return __builtin_amdgcn_rcpf(1.0f + __expf(-x)); }
DI float siluf_(float x) { return x * __builtin_amdgcn_rcpf(1.0f + __expf(-x)); }
DI float softplusf_(float x) { return x > 20.f ? x : log1pf(expf(x)); }
template <int CTRL, int ROWMASK> DI float dpp_id(float idv, float v) { return __int_as_float(__builtin_amdgcn_update_dpp(__float_as_int(idv), __float_as_int(v), CTRL, ROWMASK, 0xF, false)); }
DI float wave_incl_sum(float v, int lane) {
  (void)lane;
  v += dpp_id<0x111, 0xF>(0.f, v); v += dpp_id<0x112, 0xF>(0.f, v); v += dpp_id<0x114, 0xF>(0.f, v); v += dpp_id<0x118, 0xF>(0.f, v);
  v += dpp_id<0x142, 0xA>(0.f, v); v += dpp_id<0x143, 0xC>(0.f, v);
  return v;
}
DI float wave_incl_max(float v, int lane) {
  (void)lane;
  const float ninf = -3.0e38f;
  v = fmaxf(v, dpp_id<0x111, 0xF>(ninf, v)); v = fmaxf(v, dpp_id<0x112, 0xF>(ninf, v)); v = fmaxf(v, dpp_id<0x114, 0xF>(ninf, v)); v = fmaxf(v, dpp_id<0x118, 0xF>(ninf, v));
  v = fmaxf(v, dpp_id<0x142, 0xA>(ninf, v)); v = fmaxf(v, dpp_id<0x143, 0xC>(ninf, v));
  return v;
}

DI bool get_tdesc(const Ctx& c, int i, const float*& src, bf16_t*& dst, int& K, int& Nsrc, int& Npad) {
  const Params& p = c.p; (void)p;
  char* ws = p.ws;
  switch (i) {
    case 0: src = p.ab_w_in; dst = (bf16_t*)(ws + OFF_WABIN); K = 1024; Nsrc = 4384; Npad = 4480; return true;
    case 1: src = p.ab_w_out; dst = (bf16_t*)(ws + OFF_WABOUT); K = 1536; Nsrc = 1024; Npad = 1024; return true;
    case 2: src = p.mlp_w1; dst = (bf16_t*)(ws + OFF_W1); K = 1024; Nsrc = 4096; Npad = 4096; return true;
    case 3: src = p.mlp_w1 + 1024ull * 4096; dst = (bf16_t*)(ws + OFF_W1) + 4096ull * 1024; K = 1024; Nsrc = 4096; Npad = 4096; return true;
    case 4: src = p.mlp_w2; dst = (bf16_t*)(ws + OFF_W2); K = 4096; Nsrc = 1024; Npad = 1024; return true;
    case 5: src = p.mlp_w2 + 4096ull * 1024; dst = (bf16_t*)(ws + OFF_W2) + 4096ull * 1024; K = 4096; Nsrc = 1024; Npad = 1024; return true;
    case 6: src = p.cd_w_in; dst = (bf16_t*)(ws + OFF_WCDIN); K = 1024; Nsrc = 2592; Npad = 2688; return true;
    case 7: src = p.cd_w_out; dst = (bf16_t*)(ws + OFF_WCDOUT); K = 1536; Nsrc = 1024; Npad = 1024; return true;
    case 8: src = p.s5_glu_w; dst = (bf16_t*)(ws + OFF_WGLU); K = 512; Nsrc = 512; Npad = 512; return true;
    case 9: src = p.rw_g2; dst = (bf16_t*)(ws + OFF_WG2); K = 128; Nsrc = 512; Npad = 512; return true;
    case 10: src = p.rw_w2; dst = (bf16_t*)(ws + OFF_WW2); K = 64; Nsrc = 512; Npad = 512; return true;
    case 11: src = p.rw_w2 + 64 * 512; dst = (bf16_t*)(ws + OFF_WW2) + 512 * 64; K = 64; Nsrc = 512; Npad = 512; return true;
    case 12: src = p.rw_a2; dst = (bf16_t*)(ws + OFF_WA2); K = 64; Nsrc = 512; Npad = 512; return true;
    default: return false;
  }
}

DI void phase_rmsnorm(const Ctx& c, const float* src, const float* w) {
  const Params& p = c.p; (void)p;
  bf16_t* xn = (bf16_t*)(p.ws + OFF_XN);
  const int lane = TIDX & 63, wid = TIDX >> 6;
  f32x4 g[4];
#pragma unroll
  for (int i = 0; i < 4; ++i) g[i] = *(const f32x4*)(w + i * 256 + lane * 4);
  for (int u = blockIdx.x; u < NTOK / 8; u += gridDim.x) {
    const int row = u * 8 + wid * 2;
    const float* xr = src + (size_t)row * 1024;
    f32x4 v[2][4];
#pragma unroll
    for (int r = 0; r < 2; ++r)
#pragma unroll
      for (int i = 0; i < 4; ++i) v[r][i] = *(const f32x4*)(xr + r * 1024 + i * 256 + lane * 4);
#pragma unroll
    for (int r = 0; r < 2; ++r) {
      float ss = 0.f;
#pragma unroll
      for (int i = 0; i < 4; ++i) ss += v[r][i][0] * v[r][i][0] + v[r][i][1] * v[r][i][1] + v[r][i][2] * v[r][i][2] + v[r][i][3] * v[r][i][3];
      ss = wave_sum(ss);
      const float rs = rsqrtf(ss * (1.0f / 1024.0f) + 1e-5f);
      bf16_t* o = xn + (size_t)(row + r) * 1024;
#pragma unroll
      for (int i = 0; i < 4; ++i) { u32x2 q; q.x = pack2(v[r][i][0] * rs * g[i][0], v[r][i][1] * rs * g[i][1]); q.y = pack2(v[r][i][2] * rs * g[i][2], v[r][i][3] * rs * g[i][3]); *(u32x2*)(o + i * 256 + lane * 4) = q; }
    }
  }
}

DI void phase_prep(const Ctx& c, char* smem) {
  const Params& p = c.p; (void)p;
  if (blockIdx.x == 0 && TIDX == 0) { for (int i_ = 0; i_ < 17; ++i_) __hip_atomic_store((unsigned*)(p.ws + OFF_BAR) + 64 * i_, 0u, __ATOMIC_RELAXED, __HIP_MEMORY_SCOPE_AGENT); }
  float* tile = (float*)smem;
  const int tid = TIDX;
  int ntr = 0;
  for (int i = 0; i < 13; ++i) { const float* s; bf16_t* d; int K, Ns, Np; get_tdesc(c, i, s, d, K, Ns, Np); ntr += (K / 64) * (Np / 64); }
  for (int u = blockIdx.x; u < ntr; u += gridDim.x) {
    const float* src = nullptr; bf16_t* dst = nullptr; int K = 64, Ns = 0, Np = 64, r = u;
    for (int mi = 0; mi < 13; ++mi) { get_tdesc(c, mi, src, dst, K, Ns, Np); const int nt = (K / 64) * (Np / 64); if (r < nt) break; r -= nt; }
    const int nkb = K / 64, kb = r % nkb, nb = r / nkb;
    __syncthreads();
#pragma unroll
    for (int i = 0; i < 16; ++i) { const int k = i * 4 + (tid >> 6), n = tid & 63; const int gn = nb * 64 + n; tile[k * 65 + n] = gn < Ns ? src[(size_t)(kb * 64 + k) * Ns + gn] : 0.f; }
    __syncthreads();
    const int n = tid >> 2, ks = (tid & 3) * 16; float f[16];
#pragma unroll
    for (int j = 0; j < 16; ++j) f[j] = tile[(ks + j) * 65 + n];
    bf16_t* o = dst + (size_t)(nb * 64 + n) * K + kb * 64 + ks;
    *(u32x4*)o = pack8(f); *(u32x4*)(o + 8) = pack8(f + 8);
  }
  phase_rmsnorm(c, p.x, p.norm_mix);
}

template <class Epi>
DI void gemm_tile(char* smem, const bf16_t* __restrict__ A0, int lda0, int ksplit, const bf16_t* __restrict__ A1, int lda1,
                  const bf16_t* __restrict__ Bt, int K, int row0, int col0, const Epi& epi, int tid) {
  constexpr int BK = 32, PITCH = 40, BUF = (256 + 128) * PITCH;
  bf16_t* sbase = (bf16_t*)smem;
  const int lane = tid & 63, wid = tid >> 6, wr = wid >> 1, wc = wid & 1, fr = lane & 15, fq = lane >> 4;
  f32x4 acc[8][4];
#pragma unroll
  for (int m = 0; m < 8; ++m)
#pragma unroll
    for (int n = 0; n < 4; ++n) acc[m][n] = (f32x4){0.f, 0.f, 0.f, 0.f};
  u32x4 ra[2][4], rb[2][2];
  const int nk = K / BK;
  const int sr = tid >> 2, scv = tid & 3;
#define GLOAD(S, kt) do { const int k0_ = (kt) * BK; const bf16_t* Ab_; int lda_, kk_; \
    if (k0_ < ksplit) { Ab_ = A0; lda_ = lda0; kk_ = k0_; } else { Ab_ = A1; lda_ = lda1; kk_ = k0_ - ksplit; } \
    _Pragma("unroll") for (int i_ = 0; i_ < 4; ++i_) ra[S][i_] = *(const u32x4*)(Ab_ + (size_t)(row0 + sr + i_ * 64) * lda_ + kk_ + scv * 8); \
    _Pragma("unroll") for (int i_ = 0; i_ < 2; ++i_) rb[S][i_] = *(const u32x4*)(Bt + (size_t)(col0 + sr + i_ * 64) * K + k0_ + scv * 8); } while (0)
#define LWRITE(S, buf) do { bf16_t* sA_ = sbase + (buf) * BUF; bf16_t* sB_ = sA_ + 256 * PITCH; \
    _Pragma("unroll") for (int i_ = 0; i_ < 4; ++i_) *(u32x4*)(sA_ + (sr + i_ * 64) * PITCH + scv * 8) = ra[S][i_]; \
    _Pragma("unroll") for (int i_ = 0; i_ < 2; ++i_) *(u32x4*)(sB_ + (sr + i_ * 64) * PITCH + scv * 8) = rb[S][i_]; } while (0)
#define COMPUTE(buf) do { const bf16_t* sA_ = sbase + (buf) * BUF; const bf16_t* sB_ = sA_ + 256 * PITCH; \
    bf16x8 bfr[4]; \
    _Pragma("unroll") for (int n = 0; n < 4; ++n) bfr[n] = *(const bf16x8*)(sB_ + (wc * 64 + n * 16 + fr) * PITCH + fq * 8); \
    bf16x8 af[8]; \
    _Pragma("unroll") for (int m = 0; m < 8; ++m) af[m] = *(const bf16x8*)(sA_ + (wr * 128 + m * 16 + fr) * PITCH + fq * 8); \
    __builtin_amdgcn_s_setprio(1); \
    _Pragma("unroll") for (int m = 0; m < 8; ++m) { \
      _Pragma("unroll") for (int n = 0; n < 4; ++n) acc[m][n] = MFMA16(bfr[n], af[m], acc[m][n]); } \
    __builtin_amdgcn_s_setprio(0); } while (0)
  __syncthreads();
  {
    const int last = nk - 1;
    GLOAD(0, 0);
    __builtin_amdgcn_sched_barrier(0);
    GLOAD(1, 1);
    __builtin_amdgcn_sched_barrier(0);
    LWRITE(0, 0);
    __builtin_amdgcn_sched_barrier(0);
    GLOAD(0, (2 < last ? 2 : last));
    __builtin_amdgcn_sched_barrier(0);
    __syncthreads();
    for (int kt = 0; kt < nk; kt += 2) {
      LWRITE(1, 1);
      __builtin_amdgcn_sched_barrier(0);
      GLOAD(1, (kt + 3 < last ? kt + 3 : last));
      __builtin_amdgcn_sched_barrier(0);
      COMPUTE(0);
      __syncthreads();
      LWRITE(0, 0);
      __builtin_amdgcn_sched_barrier(0);
      GLOAD(0, (kt + 4 < last ? kt + 4 : last));
      __builtin_amdgcn_sched_barrier(0);
      COMPUTE(1);
      __syncthreads();
    }
  }
#undef GLOAD
#undef LWRITE
#undef COMPUTE
#pragma unroll
  for (int m = 0; m < 8; ++m)
#pragma unroll
    for (int n = 0; n < 4; ++n) epi(row0 + wr * 128 + m * 16 + fr, col0 + wc * 64 + n * 16 + fq * 4, acc[m][n]);
}

DI void st_bf16x4(bf16_t* o, f32x4 v) { u32x2 q; q.x = pack2(v[0], v[1]); q.y = pack2(v[2], v[3]); *(u32x2*)o = q; }

struct EpiSplit {
  bf16_t* o0; int ld0, n0; bf16_t* o1; int ld1, n1;
  DI void operator()(int row, int col, f32x4 v) const {
    if (col < n0) st_bf16x4(o0 + (size_t)row * ld0 + col, v);
    else { const int c = col - n0; if (c < n1) st_bf16x4(o1 + (size_t)row * ld1 + c, v); }
  }
};
struct EpiSmall { int mode; const float* b0; bf16_t* o;
  DI void operator()(int row, int col, f32x4 v) const { f32x4 r;
    if (mode == 2) r = v; else { for (int j = 0; j < 4; ++j) r[j] = sigmoidf_(b0[col + j] + v[j]); if (mode == 0) r *= 0.60653066f; }
    st_bf16x4(o + (size_t)row * 512 + col, r); } };
struct EpiStore { bf16_t* o; int ld;
  DI void operator()(int row, int col, f32x4 v) const { st_bf16x4(o + (size_t)row * ld + col, v); } };
struct EpiResid { const float* res; float* o;
  DI void operator()(int row, int col, f32x4 v) const { const f32x4 r = *(const f32x4*)(res + (size_t)row * 1024 + col); *(f32x4*)(o + (size_t)row * 1024 + col) = r + v; } };
struct EpiRelu2 { bf16_t* o;
  DI void operator()(int row, int col, f32x4 v) const { f32x4 r; for (int j = 0; j < 4; ++j) { const float t = fmaxf(v[j], 0.f); r[j] = t * t; } st_bf16x4(o + (size_t)row * 4096 + col, r); } };
struct EpiGlu { const bf16_t* y; const float* b; bf16_t* o;
  DI void operator()(int row, int col, f32x4 v) const { const u32x2 q = *(const u32x2*)(y + (size_t)row * 512 + col); f32x4 r;
    const float y0 = __uint_as_float(q.x << 16), y1 = __uint_as_float(q.x & 0xffff0000u), y2 = __uint_as_float(q.y << 16), y3 = __uint_as_float(q.y & 0xffff0000u);
    r[0] = y0 * sigmoidf_(v[0] + b[col]); r[1] = y1 * sigmoidf_(v[1] + b[col + 1]); r[2] = y2 * sigmoidf_(v[2] + b[col + 2]); r[3] = y3 * sigmoidf_(v[3] + b[col + 3]);
    st_bf16x4(o + (size_t)row * 512 + col, r); } };

template <class Epi>
DI void gemm_phase(char* smem, const bf16_t* A0, int lda0, int ksplit, const bf16_t* A1, int lda1, const bf16_t* Bt, int K, int nN, const Epi& epi, int tid) {
  const int G = gridDim.x;
  if ((G & 7) == 0) {
    const int x = blockIdx.x & 7, l = blockIdx.x >> 3, L = G >> 3, per = 8 * nN, tot = 2 * per;
    for (int q = l; q < tot; q += L) { const int rgl = q / per, rem = q % per, ct = rem >> 3, rt = (x * 2 + rgl) * 8 + (rem & 7);
      gemm_tile(smem, A0, lda0, ksplit, A1, lda1, Bt, K, rt * 256, ct * 128, epi, tid); }
  } else {
    const int ntiles = (NTOK / 256) * nN;
    for (int u = blockIdx.x; u < ntiles; u += G) { const int rt = u / nN, ct = u % nN; gemm_tile(smem, A0, lda0, ksplit, A1, lda1, Bt, K, rt * 256, ct * 128, epi, tid); }
  }
}

DI void phase_rw_shift(const Ctx& c) {
  const Params& p = c.p; (void)p;
  const bf16_t* raw = (const bf16_t*)(p.ws + OFF_R1);
  bf16_t* rkv = (bf16_t*)(p.ws + OFF_RKV); bf16_t* sm = (bf16_t*)(p.ws + OFF_SM);
  const float* mu = p.rw_mu;
  const int gtid = blockIdx.x * 256 + TIDX, gstride = gridDim.x * 256;
  for (int u = gtid; u < (NTOK / 4) * 224; u += gstride) {
    const int tq = u / 224, cv = u - tq * 224, col = cv * 8, tok0 = tq * 4, s0 = tok0 & (SEQ - 1);
    const bf16_t* rp = raw + (size_t)tok0 * 1792 + col;
    u32x4 R[6];
#pragma unroll
    for (int j = 0; j < 6; ++j) { const int sj = s0 - 1 + j; R[j] = (sj >= 0 && sj < SEQ) ? ld8(rp + (j - 1) * 1792) : (u32x4){0u, 0u, 0u, 0u}; }
    float m0[8], m1[8];
#pragma unroll
    for (int j = 0; j < 8; ++j) { m0[j] = mu[col + j]; m1[j] = mu[1792 + col + j]; }
#pragma unroll
    for (int i = 0; i < 4; ++i) {
      float prv[8], cur[8], nxt[8], o[8];
      unpack8(R[i], prv); unpack8(R[i + 1], cur); unpack8(R[i + 2], nxt);
#pragma unroll
      for (int j = 0; j < 8; ++j) o[j] = cur[j] + m0[j] * (prv[j] - cur[j]) + m1[j] * (nxt[j] - cur[j]);
      const size_t tok = (size_t)tok0 + i;
      if (col < 1536) *(u32x4*)(rkv + tok * 1536 + col) = pack8(o);
      else if (col < 1600) { for (int j = 0; j < 8; ++j) o[j] = tanhf(o[j]); *(u32x4*)(sm + tok * 256 + (col - 1536)) = pack8(o); }
      else if (col < 1664) *(u32x4*)(sm + tok * 256 + 64 + (col - 1600)) = pack8(o);
      else { for (int j = 0; j < 8; ++j) o[j] = sigmoidf_(o[j]); *(u32x4*)(sm + tok * 256 + 128 + (col - 1664)) = pack8(o); }
    }
  }
  const bf16_t* mraw = (const bf16_t*)(p.ws + OFF_R2); bf16_t* BC = (bf16_t*)(p.ws + OFF_XN + 32 * MiB);
  const float* cw = p.mb_conv_w; const float* cb = p.mb_conv_b;
  for (int u = gtid; u < (NTOK / 4) * 64; u += gstride) {
    const int tq = u >> 6, cv = u & 63, xc = 1024 + cv * 8, tok0 = tq * 4, s0 = tok0 & (SEQ - 1);
    const bf16_t* rp = mraw + (size_t)tok0 * 2592 + 1024 + xc;
    u32x4 R[6];
#pragma unroll
    for (int j = 0; j < 6; ++j) { const int sj = s0 - 1 + j; R[j] = (sj >= 0 && sj < SEQ) ? ld8(rp + (j - 1) * 2592) : (u32x4){0u, 0u, 0u, 0u}; }
    float w0[8], w1[8], w2[8], bb[8];
#pragma unroll
    for (int j = 0; j < 8; ++j) { w0[j] = cw[xc + j]; w1[j] = cw[1536 + xc + j]; w2[j] = cw[3072 + xc + j]; bb[j] = cb[xc + j]; }
#pragma unroll
    for (int i = 0; i < 4; ++i) {
      float prv[8], cur[8], nxt[8], o[8];
      unpack8(R[i], prv); unpack8(R[i + 1], cur); unpack8(R[i + 2], nxt);
#pragma unroll
      for (int j = 0; j < 8; ++j) o[j] = siluf_(bb[j] + w0[j] * prv[j] + w1[j] * cur[j] + w2[j] * nxt[j]);
      *(u32x4*)(BC + ((size_t)tok0 + i) * 512 + cv * 8) = pack8(o);
    }
  }
}

DI void phase_rw_small_gemms(const Ctx& c, char* smem) {
  const Params& p = c.p; (void)p;
  const int tid = TIDX;
  const bf16_t* sm = (const bf16_t*)(p.ws + OFF_SM);
  bf16_t* E0 = (bf16_t*)(p.ws + OFF_R1); bf16_t* E1 = E0 + (size_t)NTOK * 512; bf16_t* Ab = E1 + (size_t)NTOK * 512;
  bf16_t* G = (bf16_t*)(p.ws + OFF_XN);
  const bf16_t* W2 = (const bf16_t*)(p.ws + OFF_WW2); const bf16_t* A2 = (const bf16_t*)(p.ws + OFF_WA2); const bf16_t* G2 = (const bf16_t*)(p.ws + OFF_WG2);
  gemm_phase(smem, sm, 256, 1 << 30, sm, 256, W2, 64, 4, EpiSmall{0, p.rw_w0, E0}, tid);
  gemm_phase(smem, sm, 256, 1 << 30, sm, 256, W2 + 512 * 64, 64, 4, EpiSmall{0, p.rw_w0 + 512, E1}, tid);
  gemm_phase(smem, sm + 64, 256, 1 << 30, sm, 256, A2, 64, 4, EpiSmall{1, p.rw_a0, Ab}, tid);
  gemm_phase(smem, sm + 128, 256, 1 << 30, sm, 256, G2, 128, 4, EpiSmall{2, p.rw_a0, G}, tid);
}

typedef float f32x2 __attribute__((ext_vector_type(2)));
DI void rwkv_item(const Ctx& c, int item, char* smem) {
  const Params& p = c.p; (void)p;
  constexpr int T = 32;
  const int dir = item >> 7, b = (item >> 3) & 15, h = item & 7;
  const int tid = TIDX, lane = tid & 63, wave = tid >> 6, rp = tid >> 3, kq = tid & 7;
  float* op = (float*)smem;
  float* yo = op + T * 6 * 64;
  const bf16_t* RKV = (const bf16_t*)(p.ws + OFF_RKV);
  bf16_t* E0 = (bf16_t*)(p.ws + OFF_R1); bf16_t* Ed = E0 + (size_t)dir * NTOK * 512; const bf16_t* Ab = E0 + (size_t)2 * NTOK * 512;
  const float kkw = p.rw_k_k[h * 64 + lane], kaw = p.rw_k_a[h * 64 + lane];
  f32x2 S0[4], S1[4];
#pragma unroll
  for (int j = 0; j < 4; ++j) { S0[j] = (f32x2){0.f, 0.f}; S1[j] = (f32x2){0.f, 0.f}; }
  bf16_t pr[8], pk[8], pv[8], pa[8], pe[8];
#define RW_PREFETCH(c0_) do { _Pragma("unroll") for (int i = 0; i < 8; ++i) { const int st_ = (c0_) + wave * 8 + i, t_ = dir ? (SEQ - 1 - st_) : st_; const size_t tok_ = (size_t)b * SEQ + t_; \
    pr[i] = RKV[tok_ * 1536 + h * 64 + lane]; pk[i] = RKV[tok_ * 1536 + 512 + h * 64 + lane]; pv[i] = RKV[tok_ * 1536 + 1024 + h * 64 + lane]; \
    pa[i] = Ab[tok_ * 512 + h * 64 + lane]; pe[i] = Ed[tok_ * 512 + h * 64 + lane]; } } while (0)
  RW_PREFETCH(0);
  for (int c0 = 0; c0 < SEQ; c0 += T) {
    __syncthreads();
#pragma unroll
    for (int i = 0; i < 8; ++i) {
      const int s = wave * 8 + i;
      const float r = bf2f(pr[i]), k = bf2f(pk[i]), v = bf2f(pv[i]), a = bf2f(pa[i]), e = bf2f(pe[i]);
      float kk = k * kkw; const float ss = wave_sum(kk * kk); kk *= rsqrtf(fmaxf(ss, 1e-12f));
      float* o = op + s * 384;
      o[lane] = __expf(-e); o[64 + lane] = k * (1.0f + (a - 1.0f) * kaw); o[128 + lane] = -kk; o[192 + lane] = kk * a; o[256 + lane] = r; o[320 + lane] = v;
    }
    __syncthreads();
    if (c0 + T < SEQ) RW_PREFETCH(c0 + T);
#pragma unroll 2
    for (int s = 0; s < T; ++s) {
      const float* o = op + s * 384 + kq * 8;
      const f32x4 a0 = *(const f32x4*)(o + 128), a1 = *(const f32x4*)(o + 132);
      const f32x2 av[4] = {(f32x2){a0[0], a0[1]}, (f32x2){a0[2], a0[3]}, (f32x2){a1[0], a1[1]}, (f32x2){a1[2], a1[3]}};
      f32x2 t0 = S0[0] * av[0], t1 = S1[0] * av[0];
#pragma unroll
      for (int j = 1; j < 4; ++j) { t0 += S0[j] * av[j]; t1 += S1[j] * av[j]; }
      float sa0 = t0[0] + t0[1], sa1 = t1[0] + t1[1];
      sa0 = sum8(sa0); sa1 = sum8(sa1);
      const f32x2 vv = *(const f32x2*)(op + s * 384 + 320 + rp * 2);
      const f32x4 w0 = *(const f32x4*)(o), w1 = *(const f32x4*)(o + 4), k0 = *(const f32x4*)(o + 64), k1 = *(const f32x4*)(o + 68);
      const f32x4 b0 = *(const f32x4*)(o + 192), b1 = *(const f32x4*)(o + 196), r0 = *(const f32x4*)(o + 256), r1 = *(const f32x4*)(o + 260);
      const f32x2 wv[4] = {(f32x2){w0[0], w0[1]}, (f32x2){w0[2], w0[3]}, (f32x2){w1[0], w1[1]}, (f32x2){w1[2], w1[3]}};
      const f32x2 kv[4] = {(f32x2){k0[0], k0[1]}, (f32x2){k0[2], k0[3]}, (f32x2){k1[0], k1[1]}, (f32x2){k1[2], k1[3]}};
      const f32x2 bv[4] = {(f32x2){b0[0], b0[1]}, (f32x2){b0[2], b0[3]}, (f32x2){b1[0], b1[1]}, (f32x2){b1[2], b1[3]}};
      const f32x2 rv[4] = {(f32x2){r0[0], r0[1]}, (f32x2){r0[2], r0[3]}, (f32x2){r1[0], r1[1]}, (f32x2){r1[2], r1[3]}};
      f32x2 y0 = (f32x2){0.f, 0.f}, y1 = (f32x2){0.f, 0.f};
#pragma unroll
      for (int j = 0; j < 4; ++j) {
        S0[j] = S0[j] * wv[j] + bv[j] * sa0 + kv[j] * vv[0];
        S1[j] = S1[j] * wv[j] + bv[j] * sa1 + kv[j] * vv[1];
        y0 += S0[j] * rv[j]; y1 += S1[j] * rv[j];
      }
      float ya = y0[0] + y0[1], yb = y1[0] + y1[1];
      ya = sum8(ya); yb = sum8(yb);
      if (kq == 0) *(f32x2*)(yo + s * 64 + rp * 2) = (f32x2){ya, yb};
    }
    __syncthreads();
#pragma unroll
    for (int i = 0; i < 8; ++i) { const int idx = tid + i * 256, s = idx >> 6, kx = idx & 63, st = c0 + s, t = dir ? (SEQ - 1 - st) : st; Ed[((size_t)b * SEQ + t) * 512 + h * 64 + kx] = f2bf(yo[idx]); }
  }
#undef RW_PREFETCH
}

template <int DV>
struct Gla {
  static constexpr int NVB = DV / 16, QP = 136, VP = DV + 8, MP = QP;
  static constexpr int BYTES = (64 * QP * 2 + 64 * VP + DV * QP) * 2 + 6 * 64 * 4;
  char* sm;
  DI bf16_t* Qs() const { return (bf16_t*)sm; }
  DI bf16_t* Ks() const { return (bf16_t*)sm + 64 * QP; }
  DI bf16_t* Vs() const { return (bf16_t*)sm + 128 * QP; }
  DI bf16_t* St() const { return (bf16_t*)sm + 128 * QP + 64 * VP; }
  DI bf16_t* Ms() const { return (bf16_t*)sm; }
  DI float* P() const { return (float*)((bf16_t*)sm + 128 * QP + 64 * VP + DV * QP); }
  DI float* Qv() const { return P() + 64; }
  DI float* I() const { return P() + 128; }
  DI float* Wl() const { return P() + 192; }
  DI float* Mt() const { return P() + 256; }
  DI float* gl() const { return P() + 320; }
  f32x4 acc[NVB][2];
  int lane, w, fr, fq;
  DI void init(char* smem, int tid_) {
    sm = smem;
    lane = tid_ & 63; w = tid_ >> 6; fr = lane & 15; fq = lane >> 4;
    for (int i = tid_; i < DV * QP / 2; i += 256) ((unsigned*)St())[i] = 0u;
#pragma unroll
    for (int vb = 0; vb < NVB; ++vb) { acc[vb][0] = (f32x4){0.f, 0.f, 0.f, 0.f}; acc[vb][1] = (f32x4){0.f, 0.f, 0.f, 0.f}; }
  }
  DI bf16x8 gather(const bf16_t* base, int pitch, int r0, int col) const { bf16x8 r;
#pragma unroll
    for (int jj = 0; jj < 8; ++jj) r[jj] = (short)base[(r0 + jj) * pitch + col];
    return r; }
  DI void compute_y(f32x4 (&y)[NVB]) {
    bf16x8 qa[4];
#pragma unroll
    for (int ks = 0; ks < 4; ++ks) qa[ks] = *(const bf16x8*)(Qs() + (w * 16 + fr) * QP + ks * 32 + fq * 8);
#pragma unroll
    for (int nb = 0; nb < 4; ++nb) {
      f32x4 g = (f32x4){0.f, 0.f, 0.f, 0.f};
      if (nb <= w) {
#pragma unroll
        for (int ks = 0; ks < 4; ++ks) { const bf16x8 kb = *(const bf16x8*)(Ks() + (nb * 16 + fr) * QP + ks * 32 + fq * 8); g = MFMA16(qa[ks], kb, g); }
      }
      const int s = nb * 16 + fr; const float qs = Qv()[s];
#pragma unroll
      for (int j = 0; j < 4; ++j) { const int t = w * 16 + fq * 4 + j; const float m = (s <= t) ? g[j] * __expf(P()[t] - qs) : 0.f; Ms()[t * MP + s] = f2bf(m); }
    }
    __syncthreads();
#pragma unroll
    for (int vb = 0; vb < NVB; ++vb) y[vb] = (f32x4){0.f, 0.f, 0.f, 0.f};
#pragma unroll
    for (int ks = 0; ks < 4; ++ks)
      {
#pragma unroll
        for (int vb = 0; vb < NVB; ++vb) { const bf16x8 sb = *(const bf16x8*)(St() + (vb * 16 + fr) * QP + ks * 32 + fq * 8); y[vb] = MFMA16(qa[ks], sb, y[vb]); } __builtin_amdgcn_sched_barrier(0); }
    float sc[4];
#pragma unroll
    for (int j = 0; j < 4; ++j) sc[j] = __expf(I()[w * 16 + fq * 4 + j]);
#pragma unroll
    for (int vb = 0; vb < NVB; ++vb)
#pragma unroll
      for (int j = 0; j < 4; ++j) y[vb][j] *= sc[j];
#pragma unroll
    for (int k2 = 0; k2 < 2; ++k2) {
      if (k2 * 32 <= w * 16 + 15) {
        const bf16x8 ma = *(const bf16x8*)(Ms() + (w * 16 + fr) * MP + k2 * 32 + fq * 8);
#pragma unroll
        for (int vb = 0; vb < NVB; ++vb) { const bf16x8 vf = gather(Vs(), VP, k2 * 32 + fq * 8, vb * 16 + fr); y[vb] = MFMA16(ma, vf, y[vb]); __builtin_amdgcn_sched_barrier(0); }
      }
    }
  }
  DI void update() {
    __syncthreads();
    const float g = __expf(gl()[0]);
#pragma unroll
    for (int vb = 0; vb < NVB; ++vb) { acc[vb][0] *= g; acc[vb][1] *= g; }
#pragma unroll
    for (int k2 = 0; k2 < 2; ++k2) {
      const int s0 = k2 * 32 + fq * 8;
      float wsc[8];
#pragma unroll
      for (int jj = 0; jj < 8; ++jj) wsc[jj] = __expf(Wl()[s0 + jj]);
      const bf16x8 kb0 = gather(Ks(), QP, s0, (2 * w) * 16 + fr), kb1 = gather(Ks(), QP, s0, (2 * w + 1) * 16 + fr);
#pragma unroll
      for (int vb = 0; vb < NVB; ++vb) {
        bf16x8 va;
#pragma unroll
        for (int jj = 0; jj < 8; ++jj) va[jj] = (short)f2bf(bf2f(Vs()[(s0 + jj) * VP + vb * 16 + fr]) * wsc[jj]);
        acc[vb][0] = MFMA16(va, kb0, acc[vb][0]); acc[vb][1] = MFMA16(va, kb1, acc[vb][1]);
        __builtin_amdgcn_sched_barrier(0);
      }
    }
#pragma unroll
    for (int vb = 0; vb < NVB; ++vb)
#pragma unroll
      for (int nn = 0; nn < 2; ++nn)
#pragma unroll
        for (int j = 0; j < 4; ++j) St()[(vb * 16 + fq * 4 + j) * QP + (2 * w + nn) * 16 + fr] = f2bf(acc[vb][nn][j]);
    __syncthreads();
  }
};

DI void mamba_item(const Ctx& c, int item, char* smem) {
  const Params& p = c.p; (void)p;
  const int dir = item >> 8, b = (item >> 4) & 15, head = item & 15, gq = head >> 3;
  const int tid = TIDX;
  Gla<64> G; G.init(smem, tid);
  const bf16_t* raw = (const bf16_t*)(p.ws + OFF_R2);
  const bf16_t* BC = (const bf16_t*)(p.ws + OFF_XN + 32 * MiB);
  bf16_t* Y = (bf16_t*)p.out + (size_t)dir * NTOK * 1024;
  const float Aneg = -expf(p.mb_A_log[dir * 16 + head]), dtb = p.mb_dt_bias[dir * 16 + head];
  const int cvi = tid & 7, tg = tid >> 3, xc = head * 64 + cvi * 8;
  u32x4 px[4]; bf16_t pdt[2] = {0, 0}; bf16_t pdts = 0;
#define MB_LOADBC(c_) do { \
    _Pragma("unroll") for (int i = 0; i < 8; ++i) { const int v_ = tid + i * 256, s_ = v_ >> 5, cv_ = v_ & 31, st_ = (c_) * 64 + s_, t_ = dir ? (SEQ - 1 - st_) : st_; \
      pbc[i] = ld8(BC + ((size_t)b * SEQ + t_) * 512 + (cv_ < 16 ? 256 + gq * 128 + cv_ * 8 : gq * 128 + (cv_ - 16) * 8)); } } while (0)
#define MB_PREFETCH(c_) do { \
    { const int tb_ = dir ? (SEQ - 1 - ((c_) * 64 + tg * 2 + 1)) : ((c_) * 64 + tg * 2); \
      _Pragma("unroll") for (int j = 0; j < 4; ++j) { const int t_ = tb_ - 1 + j; px[j] = (t_ >= 0 && t_ < SEQ) ? ld8(raw + ((size_t)b * SEQ + t_) * 2592 + 1024 + xc) : (u32x4){0u, 0u, 0u, 0u}; } \
      pdt[0] = raw[((size_t)b * SEQ + tb_) * 2592 + 2560 + dir * 16 + head]; pdt[1] = raw[((size_t)b * SEQ + tb_ + 1) * 2592 + 2560 + dir * 16 + head]; } \
    if (tid < 64) { const int st_ = (c_) * 64 + tid, t_ = dir ? (SEQ - 1 - st_) : st_; pdts = raw[((size_t)b * SEQ + t_) * 2592 + 2560 + dir * 16 + head]; } } while (0)
  MB_PREFETCH(0);
  for (int c = 0; c < SEQ / 64; ++c) {
    u32x4 pbc[8];
    MB_LOADBC(c);
    { asm volatile("" ::: "memory");
      float cw0[8], cw1[8], cw2[8], cbv[8];
#pragma unroll
      for (int j = 0; j < 8; ++j) { cw0[j] = p.mb_conv_w[xc + j]; cw1[j] = p.mb_conv_w[1536 + xc + j]; cw2[j] = p.mb_conv_w[3072 + xc + j]; cbv[j] = p.mb_conv_b[xc + j]; }
      float R[4][8];
#pragma unroll
      for (int j = 0; j < 4; ++j) unpack8(px[j], R[j]);
#pragma unroll
      for (int i = 0; i < 2; ++i) {
        const int pi = dir ? (1 - i) : i;
        const float dt = softplusf_(bf2f(pdt[dir ? (1 - i) : i]) + dtb);
        float o[8];
#pragma unroll
        for (int j = 0; j < 8; ++j) o[j] = dt * siluf_(cbv[j] + cw0[j] * R[pi][j] + cw1[j] * R[pi + 1][j] + cw2[j] * R[pi + 2][j]);
        *(u32x4*)(G.Vs() + (tg * 2 + i) * G.VP + cvi * 8) = pack8(o);
      } }
    if (tid < 64) {
      const int s = tid;
      const float dt = softplusf_(bf2f(pdts) + dtb);
      const float cs = wave_incl_sum(dt * Aneg, s); const float csl = __shfl(cs, 63);
      G.P()[s] = cs; G.Qv()[s] = cs; G.I()[s] = cs; G.Wl()[s] = csl - cs; if (s == 0) G.gl()[0] = csl;
    }
#pragma unroll
    for (int i = 0; i < 8; ++i) { const int v = tid + i * 256, s = v >> 5, cv = v & 31; *(u32x4*)((cv < 16 ? G.Qs() : G.Ks()) + s * G.QP + (cv & 15) * 8) = pbc[i]; }
    if (c + 1 < SEQ / 64) MB_PREFETCH(c + 1);
    __syncthreads();
    f32x4 y[4];
    G.compute_y(y);
#pragma unroll
    for (int vb = 0; vb < 4; ++vb)
#pragma unroll
      for (int j = 0; j < 4; ++j) { const int s = G.w * 16 + G.fq * 4 + j, st = c * 64 + s, t = dir ? (SEQ - 1 - st) : st; Y[((size_t)b * SEQ + t) * 1024 + head * 64 + vb * 16 + G.fr] = f2bf(y[vb][j]); }
    G.update();
  }
#undef MB_PREFETCH
#undef MB_LOADBC
}

DI void mlstm_item(const Ctx& c, int item, char* smem) {
  const Params& p = c.p; (void)p;
  const int half = item & 1, head = (item >> 1) & 7, b = (item >> 4) & 15, dir = item >> 8;
  const int tid = TIDX;
  Gla<80> G; G.init(smem, tid);
  float* Wl_ = (float*)(smem + Gla<80>::BYTES);
  for (int i = tid; i < 128; i += 256) { const int ch = head * 128 + i, li = (i >> 3) * 12 + (i & 7); Wl_[li] = p.ml_conv_w[ch]; Wl_[192 + li] = p.ml_conv_w[1024 + ch]; Wl_[384 + li] = p.ml_conv_w[2048 + ch]; Wl_[576 + li] = p.ml_conv_b[ch]; }
  for (int i = tid; i < 512; i += 256) { const int li = (i >> 5) * 36 + (i & 31); Wl_[768 + li] = p.ml_wq[head * 512 + i]; Wl_[768 + 576 + li] = p.ml_wk[head * 512 + i] * 0.08838834764831845f; Wl_[768 + 1152 + li] = p.ml_wv[head * 512 + i]; }
  if (tid < 64) { for (int j = 0; j < 16; ++j) G.Vs()[tid * G.VP + 64 + j] = (j == 0) ? (bf16_t)0x3f80 : (bf16_t)0; }
  const bf16_t* raw = (const bf16_t*)(p.ws + OFF_MLRAW);
  bf16_t* H = (bf16_t*)(p.ws + OFF_HFB) + (size_t)dir * NTOK * 1024;
  const float ib = p.ml_i_b[dir * 8 + head], fb = p.ml_f_b[dir * 8 + head];
  const int cvi = tid & 15, tg = tid >> 4, ch = head * 128 + cvi * 8;
  float mprev = 0.f;
  u32x4 px[6]; bf16_t pgi = 0, pgf = 0;
#define ML_PREFETCH(c_) do { const int tb_ = dir ? (SEQ - 1 - ((c_) * 64 + tg * 4 + 3)) : ((c_) * 64 + tg * 4); \
    _Pragma("unroll") for (int j = 0; j < 6; ++j) { const int t_ = tb_ - 1 + j; px[j] = (t_ >= 0 && t_ < SEQ) ? ld8(raw + ((size_t)b * SEQ + t_) * 2080 + ch) : (u32x4){0u, 0u, 0u, 0u}; } \
    if (tid < 64) { const int st_ = (c_) * 64 + tid, t_ = dir ? (SEQ - 1 - st_) : st_; const size_t tok_ = (size_t)b * SEQ + t_; pgi = raw[tok_ * 2080 + 2048 + dir * 8 + head]; pgf = raw[tok_ * 2080 + 2064 + dir * 8 + head]; } } while (0)
  ML_PREFETCH(0);
  __syncthreads();
  for (int c = 0; c < SEQ / 64; ++c) {
    {
#pragma unroll
      for (int i = 0; i < 4; ++i) {
        float prv[8], cur[8], nxt[8];
        { const u32x4 a = dir ? px[3 - i] : px[i], bq = dir ? px[4 - i] : px[i + 1], cq = dir ? px[5 - i] : px[i + 2]; unpack8(a, prv); unpack8(bq, cur); unpack8(cq, nxt); }
        float xcv[8], q[8], k[8], v[8];
#pragma unroll
        for (int j4 = 0; j4 < 2; ++j4) {
          const f32x4 w0 = *(const f32x4*)(Wl_ + cvi * 12 + j4 * 4), w1 = *(const f32x4*)(Wl_ + 192 + cvi * 12 + j4 * 4), w2 = *(const f32x4*)(Wl_ + 384 + cvi * 12 + j4 * 4), bb = *(const f32x4*)(Wl_ + 576 + cvi * 12 + j4 * 4);
#pragma unroll
          for (int j = 0; j < 4; ++j) xcv[j4 * 4 + j] = siluf_(bb[j] + w0[j] * prv[j4 * 4 + j] + w1[j] * cur[j4 * 4 + j] + w2[j] * nxt[j4 * 4 + j]);
        }
#pragma unroll
        for (int bl = 0; bl < 2; ++bl) {
          f32x4 aq = (f32x4){0.f, 0.f, 0.f, 0.f}, ak = aq, av = aq;
#pragma unroll
          for (int cc = 0; cc < 4; ++cc) {
            const int wi = cvi * 36 + bl * 16 + cc * 4;
            aq += *(const f32x4*)(Wl_ + 768 + wi) * xcv[bl * 4 + cc]; ak += *(const f32x4*)(Wl_ + 768 + 576 + wi) * xcv[bl * 4 + cc]; av += *(const f32x4*)(Wl_ + 768 + 1152 + wi) * cur[bl * 4 + cc];
          }
#pragma unroll
          for (int d = 0; d < 4; ++d) { q[bl * 4 + d] = aq[d]; k[bl * 4 + d] = ak[d]; v[bl * 4 + d] = av[d]; }
        }
        const int s = tg * 4 + i;
        *(u32x4*)(G.Qs() + s * G.QP + cvi * 8) = pack8(q);
        *(u32x4*)(G.Ks() + s * G.QP + cvi * 8) = pack8(k);
        if ((cvi >> 3) == half) *(u32x4*)(G.Vs() + s * G.VP + (cvi & 7) * 8) = pack8(v);
        __builtin_amdgcn_sched_barrier(0);
      } }
    if (tid < 64) {
      const int s = tid;
      const float li = bf2f(pgi) + ib;
      const float fx = bf2f(pgf) + fb;
      const float lf = fminf(fx, 0.f) - __logf(1.0f + __expf(-fabsf(fx)));
      const float bc = wave_incl_sum(lf, s);
      const float cc = li - bc;
      const float pm = fmaxf(wave_incl_max(cc, s), mprev);
      const float pml = __shfl(pm, 63), bl = __shfl(bc, 63);
      G.P()[s] = -pm; G.Qv()[s] = -cc; G.I()[s] = mprev - pm; G.Wl()[s] = cc - pml; G.Mt()[s] = bc + pm; if (s == 0) G.gl()[0] = mprev - pml;
      mprev = bl + pml;
    }
    if (c + 1 < SEQ / 64) ML_PREFETCH(c + 1);
    __syncthreads();
    f32x4 y[5];
    G.compute_y(y);
#pragma unroll
    for (int j = 0; j < 4; ++j) {
      const float den = __shfl(y[4][j], G.lane & 48);
      const int s = G.w * 16 + G.fq * 4 + j, st = c * 64 + s, t = dir ? (SEQ - 1 - st) : st;
      const float dn = 1.0f / fmaxf(fabsf(den), __expf(-G.Mt()[s]));
#pragma unroll
      for (int vb = 0; vb < 4; ++vb) H[((size_t)b * SEQ + t) * 1024 + head * 128 + half * 64 + vb * 16 + G.fr] = f2bf(y[vb][j] * dn);
    }
    G.update();
  }
#undef ML_PREFETCH
}

DI void s5_item(const Ctx& c, int item, char* smem) {
  const Params& p = c.p; (void)p;
  constexpr int T = 16, XP = 136, BP = 132;
  const int dir = item >> 7, b = (item >> 3) & 15, gq = item & 7;
  const int tid = TIDX, lane = tid & 63, wave = tid >> 6, fr = lane & 15, fq = lane >> 4;
  const int g = gq * 4 + wave;
  float* BUw = (float*)smem + wave * (T * BP);
  bf16_t* Xw = (bf16_t*)(smem + 4 * T * BP * 4) + wave * (T * XP);
  const bf16_t* U = (const bf16_t*)(p.ws + OFF_S5U);
  bf16_t* Y = (bf16_t*)(p.ws + OFF_S5Y) + (size_t)dir * NTOK * 512;
  const float dtv = expf(p.s5_log_dt[dir * 32 + g]);
  float abr, abi;
  { const float ar = fminf(p.s5_A_re[(dir * 32 + g) * 64 + lane], -1e-4f), ai = p.s5_A_im[(dir * 32 + g) * 64 + lane];
    const float mag = expf(dtv * ar); abr = mag * cosf(dtv * ai); abi = mag * sinf(dtv * ai); }
  bf16x8 bf_[8];
#pragma unroll
  for (int q = 0; q < 4; ++q) {
    const int pp = q * 16 + fr;
    const float ar = fminf(p.s5_A_re[(dir * 32 + g) * 64 + pp], -1e-4f), ai = p.s5_A_im[(dir * 32 + g) * 64 + pp];
    const float mag = expf(dtv * ar), br_ = mag * cosf(dtv * ai), bi_ = mag * sinf(dtv * ai), den = ar * ar + ai * ai;
    const float f_r = ((br_ - 1.0f) * ar + bi_ * ai) / den, f_i = (bi_ * ar - (br_ - 1.0f) * ai) / den;
    float vr[8], vi[8];
#pragma unroll
    for (int jj = 0; jj < 8; ++jj) {
      float bre = 0.f, bim = 0.f;
      if (fq < 2) { bre = p.s5_B_re[(g * 64 + pp) * 16 + fq * 8 + jj]; bim = p.s5_B_im[(g * 64 + pp) * 16 + fq * 8 + jj]; }
      vr[jj] = f_r * bre - f_i * bim; vi[jj] = f_r * bim + f_i * bre;
    }
    bf_[q] = __builtin_bit_cast(bf16x8, pack8(vr)); bf_[4 + q] = __builtin_bit_cast(bf16x8, pack8(vi));
  }
  bf16x8 cf[4];
#pragma unroll
  for (int ks = 0; ks < 4; ++ks) {
    float cv[8];
#pragma unroll
    for (int jj = 0; jj < 8; ++jj) { const int k = ks * 32 + fq * 8 + jj; const size_t base = ((size_t)(dir * 32 + g) * 16 + fr) * 64; cv[jj] = k < 64 ? p.s5_C_re[base + k] : -p.s5_C_im[base + k - 64]; }
    cf[ks] = __builtin_bit_cast(bf16x8, pack8(cv));
  }
  float xr = 0.f, xi = 0.f;
  u32x4 pu;
#define S5_PREFETCH(c0_) do { const int st_ = (c0_) + fr, t_ = dir ? (SEQ - 1 - st_) : st_; \
    pu = (fq < 2) ? ld8(U + ((size_t)b * SEQ + t_) * 512 + g * 16 + fq * 8) : (u32x4){0u, 0u, 0u, 0u}; } while (0)
  S5_PREFETCH(0);
  for (int c0 = 0; c0 < SEQ; c0 += T) {
    const bf16x8 ua = __builtin_bit_cast(bf16x8, pu);
    if (c0 + T < SEQ) S5_PREFETCH(c0 + T);
    asm volatile("" ::: "memory");
#pragma unroll
    for (int nb = 0; nb < 8; ++nb) {
      f32x4 bu = MFMA16(ua, bf_[nb], ((f32x4){0.f, 0.f, 0.f, 0.f}));
#pragma unroll
      for (int j = 0; j < 4; ++j) BUw[(fq * 4 + j) * BP + nb * 16 + fr] = bu[j];
    }
    asm volatile("" ::: "memory");
#pragma unroll
    for (int s = 0; s < T; ++s) {
      const float bur = BUw[s * BP + lane], bui = BUw[s * BP + 64 + lane];
      const float nr = abr * xr - abi * xi + bur, ni = abr * xi + abi * xr + bui;
      xr = nr; xi = ni;
      const unsigned pk = pack2(xr, xi);
      Xw[s * XP + lane] = (bf16_t)(pk & 0xffffu); Xw[s * XP + 64 + lane] = (bf16_t)(pk >> 16);
    }
    asm volatile("" ::: "memory");
    f32x4 y = (f32x4){0.f, 0.f, 0.f, 0.f};
#pragma unroll
    for (int ks = 0; ks < 4; ++ks) { const bf16x8 xa = *(const bf16x8*)(Xw + fr * XP + ks * 32 + fq * 8); y = MFMA16(xa, cf[ks], y); }
#pragma unroll
    for (int j = 0; j < 4; ++j) { const int st = c0 + fq * 4 + j, t = dir ? (SEQ - 1 - st) : st; Y[((size_t)b * SEQ + t) * 512 + g * 16 + fr] = f2bf(y[j]); }
  }
#undef S5_PREFETCH
}

DI void phase_post0(const Ctx& c) {
  const Params& p = c.p; (void)p;
  const int lane = TIDX & 63, wid = TIDX >> 6;
  const int gw = blockIdx.x * 4 + wid, nw = gridDim.x * 4;
  {
    bf16_t* E0 = (bf16_t*)(p.ws + OFF_R1); const bf16_t* E1 = E0 + (size_t)NTOK * 512; const bf16_t* Ab = E1 + (size_t)NTOK * 512;
    const bf16_t* G = (const bf16_t*)(p.ws + OFF_XN); const bf16_t* RKV = (const bf16_t*)(p.ws + OFF_RKV);
    for (int tok = gw; tok < NTOK; tok += nw) {
      const int c = lane * 8;
      float y0[8], y1[8], r[8], k[8], v[8], a[8], g[8], o[8];
      unpack8(ld8(E0 + (size_t)tok * 512 + c), y0); unpack8(ld8(E1 + (size_t)tok * 512 + c), y1);
      unpack8(ld8(RKV + (size_t)tok * 1536 + c), r); unpack8(ld8(RKV + (size_t)tok * 1536 + 512 + c), k); unpack8(ld8(RKV + (size_t)tok * 1536 + 1024 + c), v);
      unpack8(ld8(Ab + (size_t)tok * 512 + c), a); unpack8(ld8(G + (size_t)tok * 512 + c), g);
      float sy = 0.f, sb = 0.f;
#pragma unroll
      for (int j = 0; j < 8; ++j) { y0[j] += y1[j]; sy += y0[j]; const float k2 = k[j] * (1.0f + (a[j] - 1.0f) * p.rw_k_a[c + j]); sb += r[j] * k2 * p.rw_r_k[c + j]; }
      const float mean = sum8(sy) * (1.0f / 64.0f); sb = sum8(sb);
      float sv = 0.f;
#pragma unroll
      for (int j = 0; j < 8; ++j) { y0[j] -= mean; sv += y0[j] * y0[j]; }
      const float rs = rsqrtf(sum8(sv) * (1.0f / 64.0f) + 64e-5f);
#pragma unroll
      for (int j = 0; j < 8; ++j) o[j] = (y0[j] * rs * p.rw_ln_w[c + j] + sb * v[j]) * g[j];
      *(u32x4*)(E0 + (size_t)tok * 512 + c) = pack8(o);
    }
  }
  {
    bf16_t* raw = (bf16_t*)(p.ws + OFF_R2);
    const bf16_t* Y0 = (const bf16_t*)p.out; const bf16_t* Y1 = Y0 + (size_t)NTOK * 1024;
    const float* cw = p.mb_conv_w; const float* cb = p.mb_conv_b;
    for (int u = gw; u < NTOK; u += nw) {
      const int tp = u >> 1, gq = u & 1, col = gq * 512 + lane * 8, head = col >> 6, tok0 = tp * 2, t0 = tok0 & (SEQ - 1);
      bf16_t* zp = raw + (size_t)tok0 * 2592 + col;
      const bf16_t* rp = zp + 1024;
      u32x4 R[4], Yq[2][2], Zq[2];
#pragma unroll
      for (int j = 0; j < 4; ++j) { const int tj = t0 - 1 + j; R[j] = (tj >= 0 && tj < SEQ) ? ld8(rp + (j - 1) * 2592) : (u32x4){0u, 0u, 0u, 0u}; }
#pragma unroll
      for (int i = 0; i < 2; ++i) { Yq[i][0] = ld8(Y0 + (size_t)(tok0 + i) * 1024 + col); Yq[i][1] = ld8(Y1 + (size_t)(tok0 + i) * 1024 + col); Zq[i] = ld8(zp + i * 2592); }
      float w0[8], w1[8], w2[8], bb[8], nw_[8];
#pragma unroll
      for (int j = 0; j < 8; ++j) { w0[j] = cw[col + j]; w1[j] = cw[1536 + col + j]; w2[j] = cw[3072 + col + j]; bb[j] = cb[col + j]; nw_[j] = p.mb_norm_w[col + j]; }
      const float D = p.mb_D[head];
#pragma unroll
      for (int i = 0; i < 2; ++i) {
        float y0[8], y1[8], z[8], cur[8], prv[8], nxt[8], o[8];
        unpack8(Yq[i][0], y0); unpack8(Yq[i][1], y1); unpack8(Zq[i], z); unpack8(R[i], prv); unpack8(R[i + 1], cur); unpack8(R[i + 2], nxt);
        float ss = 0.f;
#pragma unroll
        for (int j = 0; j < 8; ++j) { const float xs = siluf_(bb[j] + w0[j] * prv[j] + w1[j] * cur[j] + w2[j] * nxt[j]);
          const float yy = (y0[j] + y1[j] + D * xs) * siluf_(z[j]); o[j] = yy; ss += yy * yy; }
        ss = wave_sum(ss);
        const float rs = rsqrtf(ss * (1.0f / 512.0f) + 1e-5f);
#pragma unroll
        for (int j = 0; j < 8; ++j) o[j] = o[j] * rs * nw_[j];
        *(u32x4*)(zp + i * 2592) = pack8(o);
      }
    }
  }
}

DI float gelu_tanh(float x) { const float u = 0.7978845608028654f * (x + 0.044715f * x * x * x); return 0.5f * x * (1.0f + tanhf(u)); }

DI void phase_post1(const Ctx& c) {
  const Params& p = c.p; (void)p;
  const int lane = TIDX & 63, wid = TIDX >> 6;
  const int gw = blockIdx.x * 4 + wid, nw = gridDim.x * 4;
  {
    const bf16_t* U = (const bf16_t*)(p.ws + OFF_S5U); const bf16_t* Y0 = (const bf16_t*)(p.ws + OFF_S5Y); const bf16_t* Y1 = Y0 + (size_t)NTOK * 512;
    bf16_t* YG = (bf16_t*)(p.ws + OFF_YG);
    for (int tok = gw; tok < NTOK; tok += nw) {
      const int col = lane * 8; float u[8], a[8], c[8], o[8];
      unpack8(ld8(U + (size_t)tok * 512 + col), u); unpack8(ld8(Y0 + (size_t)tok * 512 + col), a); unpack8(ld8(Y1 + (size_t)tok * 512 + col), c);
#pragma unroll
      for (int j = 0; j < 8; ++j) o[j] = gelu_tanh(p.s5_D[col + j] * u[j] + a[j] + c[j]);
      *(u32x4*)(YG + (size_t)tok * 512 + col) = pack8(o);
    }
  }
  {
    bf16_t* raw = (bf16_t*)(p.ws + OFF_MLRAW);
    const bf16_t* HF = (const bf16_t*)(p.ws + OFF_HFB); const bf16_t* HB = HF + (size_t)NTOK * 1024;
    for (int u = gw; u < NTOK; u += nw) {
      const int tp = u >> 1, cc = (u & 1) * 512 + lane * 8, tok0 = tp * 2, t0 = tok0 & (SEQ - 1);
      bf16_t* xp = raw + (size_t)tok0 * 2080 + cc;
      u32x4 R[4], Hq[2][2], Oq[2];
#pragma unroll
      for (int j = 0; j < 4; ++j) { const int tj = t0 - 1 + j; R[j] = (tj >= 0 && tj < SEQ) ? ld8(xp + (j - 1) * 2080) : (u32x4){0u, 0u, 0u, 0u}; }
#pragma unroll
      for (int i = 0; i < 2; ++i) { Hq[i][0] = ld8(HF + (size_t)(tok0 + i) * 1024 + cc); Hq[i][1] = ld8(HB + (size_t)(tok0 + i) * 1024 + cc); Oq[i] = ld8(xp + i * 2080 + 1024); }
      float w0[8], w1[8], w2[8], bb[8], nw_[8], sk[8];
#pragma unroll
      for (int j = 0; j < 8; ++j) { w0[j] = p.ml_conv_w[cc + j]; w1[j] = p.ml_conv_w[1024 + cc + j]; w2[j] = p.ml_conv_w[2048 + cc + j]; bb[j] = p.ml_conv_b[cc + j]; nw_[j] = p.ml_norm_w[cc + j]; sk[j] = p.ml_skip[cc + j]; }
#pragma unroll
      for (int i = 0; i < 2; ++i) {
        float hf[8], hb[8], cur[8], prv[8], nxt[8], og[8], o[8];
        unpack8(Hq[i][0], hf); unpack8(Hq[i][1], hb); unpack8(R[i], prv); unpack8(R[i + 1], cur); unpack8(R[i + 2], nxt); unpack8(Oq[i], og);
        float sh = 0.f;
#pragma unroll
        for (int j = 0; j < 8; ++j) { hf[j] += hb[j]; sh += hf[j]; }
        sh = sum8(sh); sh += dpp_mov<0x140>(sh);
        const float mean = sh * (1.0f / 128.0f);
        float sv = 0.f;
#pragma unroll
        for (int j = 0; j < 8; ++j) { hf[j] -= mean; sv += hf[j] * hf[j]; }
        sv = sum8(sv); sv += dpp_mov<0x140>(sv);
        const float rs = rsqrtf(sv * (1.0f / 128.0f) + 1e-5f);
#pragma unroll
        for (int j = 0; j < 8; ++j) {
          const float xcv = siluf_(bb[j] + w0[j] * prv[j] + w1[j] * cur[j] + w2[j] * nxt[j]);
          o[j] = sigmoidf_(og[j]) * (hf[j] * rs * nw_[j]) + sk[j] * xcv;
        }
        *(u32x4*)(xp + i * 2080 + 1024) = pack8(o);
      }
    }
  }
}

DI void phase_final(const Ctx& c) {
  const Params& p = c.p; (void)p;
  const int lane = TIDX & 63, wid = TIDX >> 6;
  f32x4 g[4];
#pragma unroll
  for (int i = 0; i < 4; ++i) g[i] = *(const f32x4*)(p.norm_final + i * 256 + lane * 4);
  for (int u = blockIdx.x; u < NTOK / 8; u += gridDim.x) {
    float* xr = p.out + (size_t)(u * 8 + wid * 2) * 1024;
    f32x4 v[2][4];
#pragma unroll
    for (int r = 0; r < 2; ++r)
#pragma unroll
      for (int i = 0; i < 4; ++i) v[r][i] = *(const f32x4*)(xr + r * 1024 + i * 256 + lane * 4);
#pragma unroll
    for (int r = 0; r < 2; ++r) {
      float ss = 0.f;
#pragma unroll
      for (int i = 0; i < 4; ++i) ss += v[r][i][0] * v[r][i][0] + v[r][i][1] * v[r][i][1] + v[r][i][2] * v[r][i][2] + v[r][i][3] * v[r][i][3];
      ss = wave_sum(ss);
      const float rs = rsqrtf(ss * (1.0f / 1024.0f) + 1e-5f);
#pragma unroll
      for (int i = 0; i < 4; ++i) *(f32x4*)(xr + r * 1024 + i * 256 + lane * 4) = v[r][i] * rs * g[i];
    }
  }
}

constexpr int NPHASE = 20;
#ifdef NO_RW
#define RWK(x)
#else
#define RWK(x) x
#endif
#ifdef NO_MB
#define MBK(x)
#else
#define MBK(x) x
#endif
#ifndef ONLY_PHASE
#define ONLY_PHASE -1
#endif
#define PH(k) case k: if (ONLY_PHASE >= 0 && ONLY_PHASE != k) break;
template <int ph> DI void run_phase(const Ctx& c, char* smem) {
  const Params& p = c.p; (void)p;
  char* ws = p.ws;
  bf16_t* XN = (bf16_t*)(ws + OFF_XN);
  switch (ph) {
    PH(0) phase_prep(c, smem); break;
    PH(1) gemm_phase(smem, XN, 1024, 1 << 30, XN, 1024, (const bf16_t*)(ws + OFF_WABIN), 1024, 35,
                       EpiSplit{(bf16_t*)(ws + OFF_R1), 1792, 1792, (bf16_t*)(ws + OFF_R2), 2592, 2592}, TIDX); break;
    PH(2) phase_rw_shift(c); break;
    PH(3) phase_rw_small_gemms(c, smem); break;
    PH(4) {
      const int G = gridDim.x, bx = blockIdx.x;
      if (G >= 512) { if (bx < 256) { RWK(rwkv_item(c, bx, smem);) } else for (int u = bx - 256; u < 512; u += G - 256) { MBK(mamba_item(c, u, smem);) } }
      else { for (int u = bx; u < 256; u += G) { RWK(rwkv_item(c, u, smem);) } __syncthreads(); for (int u = bx + ((256 - bx + G - 1) / G) * G; u < 768; u += G) { MBK(mamba_item(c, u - 256, smem);) } }
    } break;
    PH(5) phase_post0(c); break;
    PH(6) gemm_phase(smem, (const bf16_t*)(ws + OFF_R1), 512, 512, (const bf16_t*)(ws + OFF_R2), 2592, (const bf16_t*)(ws + OFF_WABOUT), 1536, 8, EpiResid{p.x, p.out}, TIDX); break;
    PH(7) phase_rmsnorm(c, p.out, p.norm_mlp); break;
    PH(8) gemm_phase(smem, XN, 1024, 1 << 30, XN, 1024, (const bf16_t*)(ws + OFF_W1), 1024, 32, EpiRelu2{(bf16_t*)(ws + OFF_R1)}, TIDX); break;
    PH(9) gemm_phase(smem, (const bf16_t*)(ws + OFF_R1), 4096, 1 << 30, XN, 1024, (const bf16_t*)(ws + OFF_W2), 4096, 8, EpiResid{p.out, p.out}, TIDX); break;
    PH(10) phase_rmsnorm(c, p.out, p.norm_mix + 1024); break;
    PH(11) gemm_phase(smem, XN, 1024, 1 << 30, XN, 1024, (const bf16_t*)(ws + OFF_WCDIN), 1024, 21,
                        EpiSplit{(bf16_t*)(ws + OFF_S5U), 512, 512, (bf16_t*)(ws + OFF_MLRAW), 2080, 2080}, TIDX); break;
    PH(12) {
      const int G = gridDim.x, bx = blockIdx.x;
      if (G >= 512) { if (bx >= 256 && bx < 512) s5_item(c, bx - 256, smem); __syncthreads(); for (int u = bx; u < 512; u += G) mlstm_item(c, u, smem); }
      else { for (int u = bx; u < 512; u += G) mlstm_item(c, u, smem);
        __syncthreads();
        { int u0 = bx + ((512 - bx + G - 1) / G) * G; for (int u = u0; u < 768; u += G) s5_item(c, u - 512, smem); } }
    } break;
    PH(13) phase_post1(c); break;
    PH(14) gemm_phase(smem, (const bf16_t*)(ws + OFF_YG), 512, 1 << 30, XN, 1024, (const bf16_t*)(ws + OFF_WGLU), 512, 4,
                        EpiGlu{(const bf16_t*)(ws + OFF_YG), p.s5_glu_b, (bf16_t*)(ws + OFF_S5Y)}, TIDX); break;
    PH(15) gemm_phase(smem, (const bf16_t*)(ws + OFF_S5Y), 512, 512, (const bf16_t*)(ws + OFF_MLRAW) + 1024, 2080, (const bf16_t*)(ws + OFF_WCDOUT), 1536, 8, EpiResid{p.out, p.out}, TIDX); break;
    PH(16) phase_rmsnorm(c, p.out, p.norm_mlp + 1024); break;
    PH(17) gemm_phase(smem, XN, 1024, 1 << 30, XN, 1024, (const bf16_t*)(ws + OFF_W1) + 4096ull * 1024, 1024, 32, EpiRelu2{(bf16_t*)(ws + OFF_R1)}, TIDX); break;
    PH(18) gemm_phase(smem, (const bf16_t*)(ws + OFF_R1), 4096, 1 << 30, XN, 1024, (const bf16_t*)(ws + OFF_W2) + 4096ull * 1024, 4096, 8, EpiResid{p.out, p.out}, TIDX); break;
    PH(19) phase_final(c); break;
    default: break;
  }
}

DI void grid_barrier(const Ctx& c, unsigned idx) {
  const Params& p = c.p; (void)p;
  asm volatile("s_waitcnt vmcnt(0)" ::: "memory");
  __syncthreads();
  if (TIDX == 0) {
    unsigned* bar = (unsigned*)(p.ws + OFF_BAR);
    const unsigned G = gridDim.x, grp = blockIdx.x & 7u;
    const unsigned gsz = (G >> 3) + ((grp < (G & 7u)) ? 1u : 0u);
    const unsigned ngrp = G < 8u ? G : 8u;
    __builtin_amdgcn_fence(__ATOMIC_RELEASE, "agent");
    asm volatile("s_waitcnt vmcnt(0)" ::: "memory");
    const unsigned old = __hip_atomic_fetch_add(bar + 64 * (1 + grp), 1u, __ATOMIC_RELAXED, __HIP_MEMORY_SCOPE_AGENT);
    if (old + 1u == idx * gsz) {
      __builtin_amdgcn_fence(__ATOMIC_ACQ_REL, "agent");
      asm volatile("s_waitcnt vmcnt(0)" ::: "memory");
      const unsigned og = __hip_atomic_fetch_add(bar, 1u, __ATOMIC_RELAXED, __HIP_MEMORY_SCOPE_AGENT);
      if (og + 1u == idx * ngrp) {
        for (unsigned g_ = 0; g_ < ngrp; ++g_) __hip_atomic_store(bar + 64 * (9 + g_), idx, __ATOMIC_RELAXED, __HIP_MEMORY_SCOPE_AGENT);
      }
    }
    while (__hip_atomic_load(bar + 64 * (9 + grp), __ATOMIC_RELAXED, __HIP_MEMORY_SCOPE_AGENT) < idx) __builtin_amdgcn_s_sleep(1);
    __builtin_amdgcn_fence(__ATOMIC_ACQUIRE, "agent");
    asm volatile("s_waitcnt vmcnt(0)" ::: "memory");
  }
  __syncthreads();
}

template <int PHI> DI void run_from(const Ctx& c, char* smem, int ph0, int ph1) {
  const Params& p = c.p; (void)p;
  if constexpr (PHI < NPHASE) {
    if (ph0 <= PHI && PHI < ph1) {
      run_phase<PHI>(c, smem);
      if (PHI + 1 < ph1) {
        if constexpr (PHI == 0) { __syncthreads(); cg::this_grid().sync(); }
        else grid_barrier(c, (unsigned)PHI);
      }
    }
    run_from<PHI + 1>(c, smem, ph0, ph1);
  }
}

__global__ void __launch_bounds__(256, 2) mega(Params p, int ph0, int ph1) {
  extern __shared__ __attribute__((aligned(16))) char smem[];
  const Ctx c{p, __builtin_amdgcn_readfirstlane((int)(__builtin_amdgcn_workitem_id_x() >> 6))};
  run_from<0>(c, smem, ph0, ph1);
}

#ifndef ONE_LAUNCH
#define ONE_LAUNCH 1
#endif

extern "C" void kernel_launch(void* const* d_in, const int* in_sizes, int n_in, void* d_out, int out_size, void* d_ws, size_t ws_size,
                              hipStream_t stream) {
  static int grid_blocks = 0;
  if (!grid_blocks) {
    hipFuncSetAttribute((const void*)mega, hipFuncAttributeMaxDynamicSharedMemorySize, LDS_BYTES);
    int dev = 0, cus = 0, per_cu = 0;
    hipGetDevice(&dev);
    hipDeviceGetAttribute(&cus, hipDeviceAttributeMultiprocessorCount, dev);
    hipOccupancyMaxActiveBlocksPerMultiprocessor(&per_cu, mega, 256, LDS_BYTES);
    if (per_cu > 2) per_cu = 2;
    if (per_cu < 1) per_cu = 1;
    grid_blocks = cus * per_cu;
  }
  Params p{};
  const float** pf = (const float**)&p;
  for (int i = 0; i < 45; ++i) pf[i] = (const float*)d_in[i];
  p.out = (float*)d_out;
  p.ws = (char*)d_ws;
#if ONE_LAUNCH
  int ph0 = 0, ph1 = NPHASE;
  void* args[] = {&p, &ph0, &ph1};
  hipError_t e = hipLaunchCooperativeKernel((const void*)mega, dim3(grid_blocks), dim3(256), args, LDS_BYTES, stream);
  if (e != hipSuccess) fprintf(stderr, "cooperative launch failed: %s (grid %d)\n", hipGetErrorString(e), grid_blocks);
#else
  for (int ph = 0; ph < NPHASE; ++ph) hipLaunchKernelGGL(mega, dim3(grid_blocks), dim3(256), LDS_BYTES, stream, p, ph, ph + 1);
#endif
}
```

```cpp
#include <hip/hip_runtime.h>
#include <hip/hip_cooperative_groups.h>
#include <stdint.h>
#include <cstdio>
namespace cg = cooperative_groups;

typedef unsigned short bf16_t;
typedef short bf16x8 __attribute__((ext_vector_type(8)));
typedef float f32x4 __attribute__((ext_vector_type(4)));
typedef unsigned u32x4 __attribute__((ext_vector_type(4)));
typedef unsigned u32x2 __attribute__((ext_vector_type(2)));

#define DI __device__ __forceinline__
#define LANEID() ((int)__builtin_amdgcn_mbcnt_hi(~0u, __builtin_amdgcn_mbcnt_lo(~0u, 0u)))
#define TIDX (c.wid * 64 + LANEID())
#define MFMA16(a, b, c) __builtin_amdgcn_mfma_f32_16x16x32_bf16((a), (b), (c), 0, 0, 0)

constexpr int NTOK = 32768, SEQ = 2048;
constexpr size_t MiB = 1ull << 20;
constexpr size_t OFF_WABIN = 0;
constexpr size_t OFF_WABOUT = OFF_WABIN + 4480ull * 1024 * 2;
constexpr size_t OFF_W1 = OFF_WABOUT + 1024ull * 1536 * 2;
constexpr size_t OFF_W2 = OFF_W1 + 2ull * 4096 * 1024 * 2;
constexpr size_t OFF_WCDIN = OFF_W2 + 2ull * 4096 * 1024 * 2;
constexpr size_t OFF_WCDOUT = OFF_WCDIN + 2688ull * 1024 * 2;
constexpr size_t OFF_WGLU = OFF_WCDOUT + 1024ull * 1536 * 2;
constexpr size_t OFF_WG2 = OFF_WGLU + 512ull * 512 * 2;
constexpr size_t OFF_WW2 = OFF_WG2 + 512ull * 128 * 2;
constexpr size_t OFF_WA2 = OFF_WW2 + 2ull * 512 * 64 * 2;
constexpr size_t OFF_WEND = OFF_WA2 + 512ull * 64 * 2;
static_assert(OFF_WEND <= 56 * MiB, "weights region");
constexpr size_t OFF_XN = 56 * MiB;
constexpr size_t OFF_R1 = 120 * MiB;
constexpr size_t OFF_R2 = 232 * MiB;
constexpr size_t OFF_RKV = 394 * MiB;
constexpr size_t OFF_SM = 490 * MiB;
constexpr size_t OFF_S5U = 120 * MiB;
constexpr size_t OFF_MLRAW = 152 * MiB;
constexpr size_t OFF_S5Y = 282 * MiB;
constexpr size_t OFF_HFB = 346 * MiB;
constexpr size_t OFF_YG = 474 * MiB;
constexpr size_t OFF_BAR = 510 * MiB;
constexpr int LDS_BYTES = 79872;

struct Params {
  const float *x, *norm_mix, *norm_mlp, *norm_final, *mlp_w1, *mlp_w2, *ab_w_in, *ab_w_out, *rw_mu, *rw_w0, *rw_w2, *rw_a0,
      *rw_a2, *rw_g2, *rw_k_k, *rw_k_a, *rw_r_k, *rw_ln_w, *mb_conv_w, *mb_conv_b, *mb_dt_bias, *mb_A_log, *mb_D, *mb_norm_w,
      *cd_w_in, *cd_w_out, *s5_A_re, *s5_A_im, *s5_log_dt, *s5_B_re, *s5_B_im, *s5_C_re, *s5_C_im, *s5_D, *s5_glu_w, *s5_glu_b,
      *ml_conv_w, *ml_conv_b, *ml_wq, *ml_wk, *ml_wv, *ml_i_b, *ml_f_b, *ml_norm_w, *ml_skip;
  float* out;
  char* ws;
};
struct Ctx { const Params& p; int wid; };

DI float bf2f(bf16_t v) { return __uint_as_float(((unsigned)v) << 16); }
typedef float f32x2c __attribute__((ext_vector_type(2)));
typedef __bf16 bf16x2c __attribute__((ext_vector_type(2)));
DI unsigned pack2(float lo, float hi) { const f32x2c v = {lo, hi}; return __builtin_bit_cast(unsigned, __builtin_convertvector(v, bf16x2c)); }
DI bf16_t f2bf(float x) { return (bf16_t)(pack2(x, x) & 0xffffu); }
DI void unpack8(u32x4 w, float* f) {
#pragma unroll
  for (int i = 0; i < 4; ++i) { f[2 * i] = __uint_as_float(w[i] << 16); f[2 * i + 1] = __uint_as_float(w[i] & 0xffff0000u); }
}
DI u32x4 pack8(const float* f) { u32x4 w; w.x = pack2(f[0], f[1]); w.y = pack2(f[2], f[3]); w.z = pack2(f[4], f[5]); w.w = pack2(f[6], f[7]); return w; }
DI u32x4 ld8(const bf16_t* p) { return *(const u32x4*)p; }
template <int CTRL> DI float dpp_mov(float v) { return __int_as_float(__builtin_amdgcn_update_dpp(0, __float_as_int(v), CTRL, 0xF, 0xF, true)); }
DI float sum8(float v) { v += dpp_mov<0xB1>(v); v += dpp_mov<0x4E>(v); v += dpp_mov<0x141>(v); return v; }
DI float wave_sum(float v) {
  v = sum8(v); v += dpp_mov<0x140>(v);
  v += __shfl_xor(v, 16); v += __shfl_xor(v, 32);
  return v;
}
DI float sigmoidf_(float x) { return __builtin_amdgcn_rcpf(1.0f + __expf(-x)); }
DI float siluf_(float x) { return x * __builtin_amdgcn_rcpf(1.0f + __expf(-x)); }
DI float softplusf_(float x) { return x > 20.f ? x : log1pf(expf(x)); }
template <int CTRL, int ROWMASK> DI float dpp_id(float idv, float v) { return __int_as_float(__builtin_amdgcn_update_dpp(__float_as_int(idv), __float_as_int(v), CTRL, ROWMASK, 0xF, false)); }
DI float wave_incl_sum(float v, int lane) {
  (void)lane;
  v += dpp_id<0x111, 0xF>(0.f, v); v += dpp_id<0x112, 0xF>(0.f, v); v += dpp_id<0x114, 0xF>(0.f, v); v += dpp_id<0x118, 0xF>(0.f, v);
  v += dpp_id<0x142, 0xA>(0.f, v); v += dpp_id<0x143, 0xC>(0.f, v);
  return v;
}
DI float wave_incl_max(float v, int lane) {
  (void)lane;
  const float ninf = -3.0e38f;
  v = fmaxf(v, dpp_id<0x111, 0xF>(ninf, v)); v = fmaxf(v, dpp_id<0x112, 0xF>(ninf, v)); v = fmaxf(v, dpp_id<0x114, 0xF>(ninf, v)); v = fmaxf(v, dpp_id<0x118, 0xF>(ninf, v));
  v = fmaxf(v, dpp_id<0x142, 0xA>(ninf, v)); v = fmaxf(v, dpp_id<0x143, 0xC>(ninf, v));
  return v;
}

DI bool get_tdesc(const Ctx& c, int i, const float*& src, bf16_t*& dst, int& K, int& Nsrc, int& Npad) {
  const Params& p = c.p; (void)p;
  char* ws = p.ws;
  switch (i) {
    case 0: src = p.ab_w_in; dst = (bf16_t*)(ws + OFF_WABIN); K = 1024; Nsrc = 4384; Npad = 4480; return true;
    case 1: src = p.ab_w_out; dst = (bf16_t*)(ws + OFF_WABOUT); K = 1536; Nsrc = 1024; Npad = 1024; return true;
    case 2: src = p.mlp_w1; dst = (bf16_t*)(ws + OFF_W1); K = 1024; Nsrc = 4096; Npad = 4096; return true;
    case 3: src = p.mlp_w1 + 1024ull * 4096; dst = (bf16_t*)(ws + OFF_W1) + 4096ull * 1024; K = 1024; Nsrc = 4096; Npad = 4096; return true;
    case 4: src = p.mlp_w2; dst = (bf16_t*)(ws + OFF_W2); K = 4096; Nsrc = 1024; Npad = 1024; return true;
    case 5: src = p.mlp_w2 + 4096ull * 1024; dst = (bf16_t*)(ws + OFF_W2) + 4096ull * 1024; K = 4096; Nsrc = 1024; Npad = 1024; return true;
    case 6: src = p.cd_w_in; dst = (bf16_t*)(ws + OFF_WCDIN); K = 1024; Nsrc = 2592; Npad = 2688; return true;
    case 7: src = p.cd_w_out; dst = (bf16_t*)(ws + OFF_WCDOUT); K = 1536; Nsrc = 1024; Npad = 1024; return true;
    case 8: src = p.s5_glu_w; dst = (bf16_t*)(ws + OFF_WGLU); K = 512; Nsrc = 512; Npad = 512; return true;
    case 9: src = p.rw_g2; dst = (bf16_t*)(ws + OFF_WG2); K = 128; Nsrc = 512; Npad = 512; return true;
    case 10: src = p.rw_w2; dst = (bf16_t*)(ws + OFF_WW2); K = 64; Nsrc = 512; Npad = 512; return true;
    case 11: src = p.rw_w2 + 64 * 512; dst = (bf16_t*)(ws + OFF_WW2) + 512 * 64; K = 64; Nsrc = 512; Npad = 512; return true;
    case 12: src = p.rw_a2; dst = (bf16_t*)(ws + OFF_WA2); K = 64; Nsrc = 512; Npad = 512; return true;
    default: return false;
  }
}

DI void phase_rmsnorm(const Ctx& c, const float* src, const float* w) {
  const Params& p = c.p; (void)p;
  bf16_t* xn = (bf16_t*)(p.ws + OFF_XN);
  const int lane = TIDX & 63, wid = TIDX >> 6;
  f32x4 g[4];
#pragma unroll
  for (int i = 0; i < 4; ++i) g[i] = *(const f32x4*)(w + i * 256 + lane * 4);
  for (int u = blockIdx.x; u < NTOK / 8; u += gridDim.x) {
    const int row = u * 8 + wid * 2;
    const float* xr = src + (size_t)row * 1024;
    f32x4 v[2][4];
#pragma unroll
    for (int r = 0; r < 2; ++r)
#pragma unroll
      for (int i = 0; i < 4; ++i) v[r][i] = *(const f32x4*)(xr + r * 1024 + i * 256 + lane * 4);
#pragma unroll
    for (int r = 0; r < 2; ++r) {
      float ss = 0.f;
#pragma unroll
      for (int i = 0; i < 4; ++i) ss += v[r][i][0] * v[r][i][0] + v[r][i][1] * v[r][i][1] + v[r][i][2] * v[r][i][2] + v[r][i][3] * v[r][i][3];
      ss = wave_sum(ss);
      const float rs = rsqrtf(ss * (1.0f / 1024.0f) + 1e-5f);
      bf16_t* o = xn + (size_t)(row + r) * 1024;
#pragma unroll
      for (int i = 0; i < 4; ++i) { u32x2 q; q.x = pack2(v[r][i][0] * rs * g[i][0], v[r][i][1] * rs * g[i][1]); q.y = pack2(v[r][i][2] * rs * g[i][2], v[r][i][3] * rs * g[i][3]); *(u32x2*)(o + i * 256 + lane * 4) = q; }
    }
  }
}

DI void phase_prep(const Ctx& c, char* smem) {
  const Params& p = c.p; (void)p;
  if (blockIdx.x == 0 && TIDX == 0) { for (int i_ = 0; i_ < 17; ++i_) __hip_atomic_store((unsigned*)(p.ws + OFF_BAR) + 64 * i_, 0u, __ATOMIC_RELAXED, __HIP_MEMORY_SCOPE_AGENT); }
  float* tile = (float*)smem;
  const int tid = TIDX;
  int ntr = 0;
  for (int i = 0; i < 13; ++i) { const float* s; bf16_t* d; int K, Ns, Np; get_tdesc(c, i, s, d, K, Ns, Np); ntr += (K / 64) * (Np / 64); }
  for (int u = blockIdx.x; u < ntr; u += gridDim.x) {
    const float* src = nullptr; bf16_t* dst = nullptr; int K = 64, Ns = 0, Np = 64, r = u;
    for (int mi = 0; mi < 13; ++mi) { get_tdesc(c, mi, src, dst, K, Ns, Np); const int nt = (K / 64) * (Np / 64); if (r < nt) break; r -= nt; }
    const int nkb = K / 64, kb = r % nkb, nb = r / nkb;
    f32x4 ld_[4];
#pragma unroll
    for (int i = 0; i < 4; ++i) { const int k = i * 16 + (tid >> 4), gn = nb * 64 + (tid & 15) * 4; ld_[i] = gn < Ns ? *(const f32x4*)(src + (size_t)(kb * 64 + k) * Ns + gn) : (f32x4){0.f, 0.f, 0.f, 0.f}; }
    __syncthreads();
#pragma unroll
    for (int i = 0; i < 4; ++i) { const int k = i * 16 + (tid >> 4), n4 = (tid & 15) * 4;
#pragma unroll
      for (int j = 0; j < 4; ++j) tile[k * 65 + n4 + j] = ld_[i][j]; }
    __syncthreads();
    const int n = tid >> 2, ks = (tid & 3) * 16; float f[16];
#pragma unroll
    for (int j = 0; j < 16; ++j) f[j] = tile[(ks + j) * 65 + n];
    bf16_t* o = dst + (size_t)(nb * 64 + n) * K + kb * 64 + ks;
    *(u32x4*)o = pack8(f); *(u32x4*)(o + 8) = pack8(f + 8);
  }
  phase_rmsnorm(c, p.x, p.norm_mix);
}

template <class Epi>
DI void gemm_tile(char* smem, const bf16_t* __restrict__ A0, int lda0, int ksplit, const bf16_t* __restrict__ A1, int lda1,
                  const bf16_t* __restrict__ Bt, int K, int row0, int col0, const Epi& epi, int tid) {
  constexpr int BK = 32, PITCH = 40, BUF = (256 + 128) * PITCH;
  bf16_t* sbase = (bf16_t*)smem;
  const int lane = tid & 63, wid = tid >> 6, wr = wid >> 1, wc = wid & 1, fr = lane & 15, fq = lane >> 4;
  f32x4 acc[8][4];
#pragma unroll
  for (int m = 0; m < 8; ++m)
#pragma unroll
    for (int n = 0; n < 4; ++n) acc[m][n] = (f32x4){0.f, 0.f, 0.f, 0.f};
  u32x4 ra[2][4], rb[2][2];
  const int nk = K / BK;
  const int sr = tid >> 2, scv = tid & 3;
#define GLOAD(S, kt) do { const int k0_ = (kt) * BK; const bf16_t* Ab_; int lda_, kk_; \
    if (k0_ < ksplit) { Ab_ = A0; lda_ = lda0; kk_ = k0_; } else { Ab_ = A1; lda_ = lda1; kk_ = k0_ - ksplit; } \
    _Pragma("unroll") for (int i_ = 0; i_ < 4; ++i_) ra[S][i_] = *(const u32x4*)(Ab_ + (size_t)(row0 + sr + i_ * 64) * lda_ + kk_ + scv * 8); \
    _Pragma("unroll") for (int i_ = 0; i_ < 2; ++i_) rb[S][i_] = *(const u32x4*)(Bt + (size_t)(col0 + sr + i_ * 64) * K + k0_ + scv * 8); } while (0)
#define LWRITE(S, buf) do { bf16_t* sA_ = sbase + (buf) * BUF; bf16_t* sB_ = sA_ + 256 * PITCH; \
    _Pragma("unroll") for (int i_ = 0; i_ < 4; ++i_) *(u32x4*)(sA_ + (sr + i_ * 64) * PITCH + scv * 8) = ra[S][i_]; \
    _Pragma("unroll") for (int i_ = 0; i_ < 2; ++i_) *(u32x4*)(sB_ + (sr + i_ * 64) * PITCH + scv * 8) = rb[S][i_]; } while (0)
#define COMPUTE(buf) do { const bf16_t* sA_ = sbase + (buf) * BUF; const bf16_t* sB_ = sA_ + 256 * PITCH; \
    bf16x8 bfr[4]; \
    _Pragma("unroll") for (int n = 0; n < 4; ++n) bfr[n] = *(const bf16x8*)(sB_ + (wc * 64 + n * 16 + fr) * PITCH + fq * 8); \
    bf16x8 af[8]; \
    _Pragma("unroll") for (int m = 0; m < 8; ++m) af[m] = *(const bf16x8*)(sA_ + (wr * 128 + m * 16 + fr) * PITCH + fq * 8); \
    __builtin_amdgcn_s_setprio(1); \
    _Pragma("unroll") for (int m = 0; m < 8; ++m) { \
      _Pragma("unroll") for (int n = 0; n < 4; ++n) acc[m][n] = MFMA16(bfr[n], af[m], acc[m][n]); } \
    __builtin_amdgcn_s_setprio(0); } while (0)
  __syncthreads();
  {
    const int last = nk - 1;
    GLOAD(0, 0);
    __builtin_amdgcn_sched_barrier(0);
    GLOAD(1, 1);
    __builtin_amdgcn_sched_barrier(0);
    LWRITE(0, 0);
    __builtin_amdgcn_sched_barrier(0);
    GLOAD(0, (2 < last ? 2 : last));
    __builtin_amdgcn_sched_barrier(0);
    __syncthreads();
    for (int kt = 0; kt < nk; kt += 2) {
      LWRITE(1, 1);
      __builtin_amdgcn_sched_barrier(0);
      GLOAD(1, (kt + 3 < last ? kt + 3 : last));
      __builtin_amdgcn_sched_barrier(0);
      COMPUTE(0);
      __syncthreads();
      LWRITE(0, 0);
      __builtin_amdgcn_sched_barrier(0);
      GLOAD(0, (kt + 4 < last ? kt + 4 : last));
      __builtin_amdgcn_sched_barrier(0);
      COMPUTE(1);
      __syncthreads();
    }
  }
#undef GLOAD
#undef LWRITE
#undef COMPUTE
#pragma unroll
  for (int m = 0; m < 8; ++m)
#pragma unroll
    for (int n = 0; n < 4; ++n) epi(row0 + wr * 128 + m * 16 + fr, col0 + wc * 64 + n * 16 + fq * 4, acc[m][n]);
}

DI void st_bf16x4(bf16_t* o, f32x4 v) { u32x2 q; q.x = pack2(v[0], v[1]); q.y = pack2(v[2], v[3]); *(u32x2*)o = q; }

struct EpiSplit {
  bf16_t* o0; int ld0, n0; bf16_t* o1; int ld1, n1;
  DI void operator()(int row, int col, f32x4 v) const {
    if (col < n0) st_bf16x4(o0 + (size_t)row * ld0 + col, v);
    else { const int c = col - n0; if (c < n1) st_bf16x4(o1 + (size_t)row * ld1 + c, v); }
  }
};
struct EpiSmall { int mode; const float* b0; bf16_t* o;
  DI void operator()(int row, int col, f32x4 v) const { f32x4 r;
    if (mode == 2) r = v; else { for (int j = 0; j < 4; ++j) r[j] = sigmoidf_(b0[col + j] + v[j]); if (mode == 0) r *= 0.60653066f; }
    st_bf16x4(o + (size_t)row * 512 + col, r); } };
struct EpiStore { bf16_t* o; int ld;
  DI void operator()(int row, int col, f32x4 v) const { st_bf16x4(o + (size_t)row * ld + col, v); } };
struct EpiResid { const float* res; float* o;
  DI void operator()(int row, int col, f32x4 v) const { const f32x4 r = *(const f32x4*)(res + (size_t)row * 1024 + col); *(f32x4*)(o + (size_t)row * 1024 + col) = r + v; } };
struct EpiRelu2 { bf16_t* o;
  DI void operator()(int row, int col, f32x4 v) const { f32x4 r; for (int j = 0; j < 4; ++j) { const float t = fmaxf(v[j], 0.f); r[j] = t * t; } st_bf16x4(o + (size_t)row * 4096 + col, r); } };
struct EpiGlu { const bf16_t* y; const float* b; bf16_t* o;
  DI void operator()(int row, int col, f32x4 v) const { const u32x2 q = *(const u32x2*)(y + (size_t)row * 512 + col); f32x4 r;
    const float y0 = __uint_as_float(q.x << 16), y1 = __uint_as_float(q.x & 0xffff0000u), y2 = __uint_as_float(q.y << 16), y3 = __uint_as_float(q.y & 0xffff0000u);
    r[0] = y0 * sigmoidf_(v[0] + b[col]); r[1] = y1 * sigmoidf_(v[1] + b[col + 1]); r[2] = y2 * sigmoidf_(v[2] + b[col + 2]); r[3] = y3 * sigmoidf_(v[3] + b[col + 3]);
    st_bf16x4(o + (size_t)row * 512 + col, r); } };

template <class Epi>
DI void gemm_phase(char* smem, const bf16_t* A0, int lda0, int ksplit, const bf16_t* A1, int lda1, const bf16_t* Bt, int K, int nN, const Epi& epi, int tid) {
  const int G = gridDim.x;
  if ((G & 7) == 0) {
    const int x = blockIdx.x & 7, l = blockIdx.x >> 3, L = G >> 3, per = 8 * nN, tot = 2 * per;
    for (int q = l; q < tot; q += L) { const int rgl = q / per, rem = q % per, ct = rem >> 3, rt = (x * 2 + rgl) * 8 + (rem & 7);
      gemm_tile(smem, A0, lda0, ksplit, A1, lda1, Bt, K, rt * 256, ct * 128, epi, tid); }
  } else {
    const int ntiles = (NTOK / 256) * nN;
    for (int u = blockIdx.x; u < ntiles; u += G) { const int rt = u / nN, ct = u % nN; gemm_tile(smem, A0, lda0, ksplit, A1, lda1, Bt, K, rt * 256, ct * 128, epi, tid); }
  }
}

DI void phase_rw_shift(const Ctx& c) {
  const Params& p = c.p; (void)p;
  const bf16_t* raw = (const bf16_t*)(p.ws + OFF_R1);
  bf16_t* rkv = (bf16_t*)(p.ws + OFF_RKV); bf16_t* sm = (bf16_t*)(p.ws + OFF_SM);
  const float* mu = p.rw_mu;
  const int gtid = blockIdx.x * 256 + TIDX, gstride = gridDim.x * 256;
  for (int u = gtid; u < (NTOK / 4) * 224; u += gstride) {
    const int tq = u / 224, cv = u - tq * 224, col = cv * 8, tok0 = tq * 4, s0 = tok0 & (SEQ - 1);
    const bf16_t* rp = raw + (size_t)tok0 * 1792 + col;
    u32x4 R[6];
#pragma unroll
    for (int j = 0; j < 6; ++j) { const int sj = s0 - 1 + j; R[j] = (sj >= 0 && sj < SEQ) ? ld8(rp + (j - 1) * 1792) : (u32x4){0u, 0u, 0u, 0u}; }
    float m0[8], m1[8];
#pragma unroll
    for (int j = 0; j < 8; ++j) { m0[j] = mu[col + j]; m1[j] = mu[1792 + col + j]; }
#pragma unroll
    for (int i = 0; i < 4; ++i) {
      float prv[8], cur[8], nxt[8], o[8];
      unpack8(R[i], prv); unpack8(R[i + 1], cur); unpack8(R[i + 2], nxt);
#pragma unroll
      for (int j = 0; j < 8; ++j) o[j] = cur[j] + m0[j] * (prv[j] - cur[j]) + m1[j] * (nxt[j] - cur[j]);
      const size_t tok = (size_t)tok0 + i;
      if (col < 1536) *(u32x4*)(rkv + tok * 1536 + col) = pack8(o);
      else if (col < 1600) { for (int j = 0; j < 8; ++j) o[j] = tanhf(o[j]); *(u32x4*)(sm + tok * 256 + (col - 1536)) = pack8(o); }
      else if (col < 1664) *(u32x4*)(sm + tok * 256 + 64 + (col - 1600)) = pack8(o);
      else { for (int j = 0; j < 8; ++j) o[j] = sigmoidf_(o[j]); *(u32x4*)(sm + tok * 256 + 128 + (col - 1664)) = pack8(o); }
    }
  }
  const bf16_t* mraw = (const bf16_t*)(p.ws + OFF_R2); bf16_t* BC = (bf16_t*)(p.ws + OFF_XN + 32 * MiB);
  const float* cw = p.mb_conv_w; const float* cb = p.mb_conv_b;
  for (int u = gtid; u < (NTOK / 4) * 64; u += gstride) {
    const int tq = u >> 6, cv = u & 63, xc = 1024 + cv * 8, tok0 = tq * 4, s0 = tok0 & (SEQ - 1);
    const bf16_t* rp = mraw + (size_t)tok0 * 2592 + 1024 + xc;
    u32x4 R[6];
#pragma unroll
    for (int j = 0; j < 6; ++j) { const int sj = s0 - 1 + j; R[j] = (sj >= 0 && sj < SEQ) ? ld8(rp + (j - 1) * 2592) : (u32x4){0u, 0u, 0u, 0u}; }
    float w0[8], w1[8], w2[8], bb[8];
#pragma unroll
    for (int j = 0; j < 8; ++j) { w0[j] = cw[xc + j]; w1[j] = cw[1536 + xc + j]; w2[j] = cw[3072 + xc + j]; bb[j] = cb[xc + j]; }
#pragma unroll
    for (int i = 0; i < 4; ++i) {
      float prv[8], cur[8], nxt[8], o[8];
      unpack8(R[i], prv); unpack8(R[i + 1], cur); unpack8(R[i + 2], nxt);
#pragma unroll
      for (int j = 0; j < 8; ++j) o[j] = siluf_(bb[j] + w0[j] * prv[j] + w1[j] * cur[j] + w2[j] * nxt[j]);
      *(u32x4*)(BC + ((size_t)tok0 + i) * 512 + cv * 8) = pack8(o);
    }
  }
}

DI void phase_rw_small_gemms(const Ctx& c, char* smem) {
  const Params& p = c.p; (void)p;
  const int tid = TIDX;
  const bf16_t* sm = (const bf16_t*)(p.ws + OFF_SM);
  bf16_t* E0 = (bf16_t*)(p.ws + OFF_R1); bf16_t* E1 = E0 + (size_t)NTOK * 512; bf16_t* Ab = E1 + (size_t)NTOK * 512;
  bf16_t* G = (bf16_t*)(p.ws + OFF_XN);
  const bf16_t* W2 = (const bf16_t*)(p.ws + OFF_WW2); const bf16_t* A2 = (const bf16_t*)(p.ws + OFF_WA2); const bf16_t* G2 = (const bf16_t*)(p.ws + OFF_WG2);
  gemm_phase(smem, sm, 256, 1 << 30, sm, 256, W2, 64, 4, EpiSmall{0, p.rw_w0, E0}, tid);
  gemm_phase(smem, sm, 256, 1 << 30, sm, 256, W2 + 512 * 64, 64, 4, EpiSmall{0, p.rw_w0 + 512, E1}, tid);
  gemm_phase(smem, sm + 64, 256, 1 << 30, sm, 256, A2, 64, 4, EpiSmall{1, p.rw_a0, Ab}, tid);
  gemm_phase(smem, sm + 128, 256, 1 << 30, sm, 256, G2, 128, 4, EpiSmall{2, p.rw_a0, G}, tid);
}

typedef float f32x2 __attribute__((ext_vector_type(2)));
DI void rwkv_item(const Ctx& c, int item, char* smem) {
  const Params& p = c.p; (void)p;
  constexpr int T = 32;
  const int dir = item >> 7, b = (item >> 3) & 15, h = item & 7;
  const int tid = TIDX, lane = tid & 63, wave = tid >> 6, rp = tid >> 3, kq = tid & 7;
  float* op = (float*)smem;
  float* yo = op + T * 6 * 64;
  const bf16_t* RKV = (const bf16_t*)(p.ws + OFF_RKV);
  bf16_t* E0 = (bf16_t*)(p.ws + OFF_R1); bf16_t* Ed = E0 + (size_t)dir * NTOK * 512; const bf16_t* Ab = E0 + (size_t)2 * NTOK * 512;
  const float kkw = p.rw_k_k[h * 64 + lane], kaw = p.rw_k_a[h * 64 + lane];
  f32x2 S0[4], S1[4];
#pragma unroll
  for (int j = 0; j < 4; ++j) { S0[j] = (f32x2){0.f, 0.f}; S1[j] = (f32x2){0.f, 0.f}; }
  bf16_t pr[8], pk[8], pv[8], pa[8], pe[8];
#define RW_PREFETCH(c0_) do { _Pragma("unroll") for (int i = 0; i < 8; ++i) { const int st_ = (c0_) + wave * 8 + i, t_ = dir ? (SEQ - 1 - st_) : st_; const size_t tok_ = (size_t)b * SEQ + t_; \
    pr[i] = RKV[tok_ * 1536 + h * 64 + lane]; pk[i] = RKV[tok_ * 1536 + 512 + h * 64 + lane]; pv[i] = RKV[tok_ * 1536 + 1024 + h * 64 + lane]; \
    pa[i] = Ab[tok_ * 512 + h * 64 + lane]; pe[i] = Ed[tok_ * 512 + h * 64 + lane]; } } while (0)
  RW_PREFETCH(0);
  for (int c0 = 0; c0 < SEQ; c0 += T) {
    __syncthreads();
#pragma unroll
    for (int i = 0; i < 8; ++i) {
      const int s = wave * 8 + i;
      const float r = bf2f(pr[i]), k = bf2f(pk[i]), v = bf2f(pv[i]), a = bf2f(pa[i]), e = bf2f(pe[i]);
      float kk = k * kkw; const float ss = wave_sum(kk * kk); kk *= rsqrtf(fmaxf(ss, 1e-12f));
      float* o = op + s * 384;
      o[lane] = __expf(-e); o[64 + lane] = k * (1.0f + (a - 1.0f) * kaw); o[128 + lane] = -kk; o[192 + lane] = kk * a; o[256 + lane] = r; o[320 + lane] = v;
    }
    __syncthreads();
    if (c0 + T < SEQ) RW_PREFETCH(c0 + T);
#pragma unroll 4
    for (int s = 0; s < T; ++s) {
      const float* o = op + s * 384 + kq * 8;
      const f32x4 a0 = *(const f32x4*)(o + 128), a1 = *(const f32x4*)(o + 132);
      const f32x2 av[4] = {(f32x2){a0[0], a0[1]}, (f32x2){a0[2], a0[3]}, (f32x2){a1[0], a1[1]}, (f32x2){a1[2], a1[3]}};
      f32x2 t0 = S0[0] * av[0], t1 = S1[0] * av[0];
#pragma unroll
      for (int j = 1; j < 4; ++j) { t0 += S0[j] * av[j]; t1 += S1[j] * av[j]; }
      float sa0 = t0[0] + t0[1], sa1 = t1[0] + t1[1];
      sa0 = sum8(sa0); sa1 = sum8(sa1);
      const f32x2 vv = *(const f32x2*)(op + s * 384 + 320 + rp * 2);
      const f32x4 w0 = *(const f32x4*)(o), w1 = *(const f32x4*)(o + 4), k0 = *(const f32x4*)(o + 64), k1 = *(const f32x4*)(o + 68);
      const f32x4 b0 = *(const f32x4*)(o + 192), b1 = *(const f32x4*)(o + 196), r0 = *(const f32x4*)(o + 256), r1 = *(const f32x4*)(o + 260);
      const f32x2 wv[4] = {(f32x2){w0[0], w0[1]}, (f32x2){w0[2], w0[3]}, (f32x2){w1[0], w1[1]}, (f32x2){w1[2], w1[3]}};
      const f32x2 kv[4] = {(f32x2){k0[0], k0[1]}, (f32x2){k0[2], k0[3]}, (f32x2){k1[0], k1[1]}, (f32x2){k1[2], k1[3]}};
      const f32x2 bv[4] = {(f32x2){b0[0], b0[1]}, (f32x2){b0[2], b0[3]}, (f32x2){b1[0], b1[1]}, (f32x2){b1[2], b1[3]}};
      const f32x2 rv[4] = {(f32x2){r0[0], r0[1]}, (f32x2){r0[2], r0[3]}, (f32x2){r1[0], r1[1]}, (f32x2){r1[2], r1[3]}};
      f32x2 y0 = (f32x2){0.f, 0.f}, y1 = (f32x2){0.f, 0.f};
#pragma unroll
      for (int j = 0; j < 4; ++j) {
        S0[j] = S0[j] * wv[j] + bv[j] * sa0 + kv[j] * vv[0];
        S1[j] = S1[j] * wv[j] + bv[j] * sa1 + kv[j] * vv[1];
        y0 += S0[j] * rv[j]; y1 += S1[j] * rv[j];
      }
      float ya = y0[0] + y0[1], yb = y1[0] + y1[1];
      ya = sum8(ya); yb = sum8(yb);
      if (kq == 0) *(f32x2*)(yo + s * 64 + rp * 2) = (f32x2){ya, yb};
    }
    __syncthreads();
#pragma unroll
    for (int i = 0; i < 8; ++i) { const int idx = tid + i * 256, s = idx >> 6, kx = idx & 63, st = c0 + s, t = dir ? (SEQ - 1 - st) : st; Ed[((size_t)b * SEQ + t) * 512 + h * 64 + kx] = f2bf(yo[idx]); }
  }
#undef RW_PREFETCH
}

template <int DV>
struct Gla {
  static constexpr int NVB = DV / 16, QP = 136, VP = DV + 8, MP = QP;
  static constexpr int BYTES = (64 * QP * 2 + 64 * VP + DV * QP) * 2 + 6 * 64 * 4;
  char* sm;
  DI bf16_t* Qs() const { return (bf16_t*)sm; }
  DI bf16_t* Ks() const { return (bf16_t*)sm + 64 * QP; }
  DI bf16_t* Vs() const { return (bf16_t*)sm + 128 * QP; }
  DI bf16_t* St() const { return (bf16_t*)sm + 128 * QP + 64 * VP; }
  DI bf16_t* Ms() const { return (bf16_t*)sm; }
  DI float* P() const { return (float*)((bf16_t*)sm + 128 * QP + 64 * VP + DV * QP); }
  DI float* Qv() const { return P() + 64; }
  DI float* I() const { return P() + 128; }
  DI float* Wl() const { return P() + 192; }
  DI float* Mt() const { return P() + 256; }
  DI float* gl() const { return P() + 320; }
  f32x4 acc[NVB][2];
  int lane, w, fr, fq;
  DI void init(char* smem, int tid_) {
    sm = smem;
    lane = tid_ & 63; w = tid_ >> 6; fr = lane & 15; fq = lane >> 4;
    for (int i = tid_; i < DV * QP / 2; i += 256) ((unsigned*)St())[i] = 0u;
#pragma unroll
    for (int vb = 0; vb < NVB; ++vb) { acc[vb][0] = (f32x4){0.f, 0.f, 0.f, 0.f}; acc[vb][1] = (f32x4){0.f, 0.f, 0.f, 0.f}; }
  }
  DI bf16x8 gather(const bf16_t* base, int pitch, int r0, int col) const { bf16x8 r;
#pragma unroll
    for (int jj = 0; jj < 8; ++jj) r[jj] = (short)base[(r0 + jj) * pitch + col];
    return r; }
  DI void compute_y(f32x4 (&y)[NVB]) {
    bf16x8 qa[4];
#pragma unroll
    for (int ks = 0; ks < 4; ++ks) qa[ks] = *(const bf16x8*)(Qs() + (w * 16 + fr) * QP + ks * 32 + fq * 8);
#pragma unroll
    for (int nb = 0; nb < 4; ++nb) {
      f32x4 g = (f32x4){0.f, 0.f, 0.f, 0.f};
      if (nb <= w) {
#pragma unroll
        for (int ks = 0; ks < 4; ++ks) { const bf16x8 kb = *(const bf16x8*)(Ks() + (nb * 16 + fr) * QP + ks * 32 + fq * 8); g = MFMA16(qa[ks], kb, g); }
      }
      const int s = nb * 16 + fr; const float qs = Qv()[s];
#pragma unroll
      for (int j = 0; j < 4; ++j) { const int t = w * 16 + fq * 4 + j; const float m = (s <= t) ? g[j] * __expf(P()[t] - qs) : 0.f; Ms()[t * MP + s] = f2bf(m); }
    }
    __syncthreads();
#pragma unroll
    for (int vb = 0; vb < NVB; ++vb) y[vb] = (f32x4){0.f, 0.f, 0.f, 0.f};
#pragma unroll
    for (int ks = 0; ks < 4; ++ks)
      {
#pragma unroll
        for (int vb = 0; vb < NVB; ++vb) { const bf16x8 sb = *(const bf16x8*)(St() + (vb * 16 + fr) * QP + ks * 32 + fq * 8); y[vb] = MFMA16(qa[ks], sb, y[vb]); } __builtin_amdgcn_sched_barrier(0); }
    float sc[4];
#pragma unroll
    for (int j = 0; j < 4; ++j) sc[j] = __expf(I()[w * 16 + fq * 4 + j]);
#pragma unroll
    for (int vb = 0; vb < NVB; ++vb)
#pragma unroll
      for (int j = 0; j < 4; ++j) y[vb][j] *= sc[j];
#pragma unroll
    for (int k2 = 0; k2 < 2; ++k2) {
      if (k2 * 32 <= w * 16 + 15) {
        const bf16x8 ma = *(const bf16x8*)(Ms() + (w * 16 + fr) * MP + k2 * 32 + fq * 8);
#pragma unroll
        for (int vb = 0; vb < NVB; ++vb) { const bf16x8 vf = gather(Vs(), VP, k2 * 32 + fq * 8, vb * 16 + fr); y[vb] = MFMA16(ma, vf, y[vb]); __builtin_amdgcn_sched_barrier(0); }
      }
    }
  }
  DI void update() {
    __syncthreads();
    const float g = __expf(gl()[0]);
#pragma unroll
    for (int vb = 0; vb < NVB; ++vb) { acc[vb][0] *= g; acc[vb][1] *= g; }
#pragma unroll
    for (int k2 = 0; k2 < 2; ++k2) {
      const int s0 = k2 * 32 + fq * 8;
      float wsc[8];
#pragma unroll
      for (int jj = 0; jj < 8; ++jj) wsc[jj] = __expf(Wl()[s0 + jj]);
      const bf16x8 kb0 = gather(Ks(), QP, s0, (2 * w) * 16 + fr), kb1 = gather(Ks(), QP, s0, (2 * w + 1) * 16 + fr);
#pragma unroll
      for (int vb = 0; vb < NVB; ++vb) {
        bf16x8 va;
#pragma unroll
        for (int jj = 0; jj < 8; ++jj) va[jj] = (short)f2bf(bf2f(Vs()[(s0 + jj) * VP + vb * 16 + fr]) * wsc[jj]);
        acc[vb][0] = MFMA16(va, kb0, acc[vb][0]); acc[vb][1] = MFMA16(va, kb1, acc[vb][1]);
        __builtin_amdgcn_sched_barrier(0);
      }
    }
#pragma unroll
    for (int vb = 0; vb < NVB; ++vb)
#pragma unroll
      for (int nn = 0; nn < 2; ++nn)
#pragma unroll
        for (int j = 0; j < 4; ++j) St()[(vb * 16 + fq * 4 + j) * QP + (2 * w + nn) * 16 + fr] = f2bf(acc[vb][nn][j]);
    __syncthreads();
  }
};

DI void mamba_item(const Ctx& c, int item, char* smem) {
  const Params& p = c.p; (void)p;
  const int dir = item >> 8, b = (item >> 4) & 15, head = item & 15, gq = head >> 3;
  const int tid = TIDX;
  Gla<64> G; G.init(smem, tid);
  const bf16_t* raw = (const bf16_t*)(p.ws + OFF_R2);
  const bf16_t* BC = (const bf16_t*)(p.ws + OFF_XN + 32 * MiB);
  bf16_t* Y = (bf16_t*)p.out + (size_t)dir * NTOK * 1024;
  const float Aneg = -expf(p.mb_A_log[dir * 16 + head]), dtb = p.mb_dt_bias[dir * 16 + head];
  const int cvi = tid & 7, tg = tid >> 3, xc = head * 64 + cvi * 8;
  u32x4 px[4]; bf16_t pdt[2] = {0, 0}; bf16_t pdts = 0;
#define MB_LOADBC(c_) do { \
    _Pragma("unroll") for (int i = 0; i < 8; ++i) { const int v_ = tid + i * 256, s_ = v_ >> 5, cv_ = v_ & 31, st_ = (c_) * 64 + s_, t_ = dir ? (SEQ - 1 - st_) : st_; \
      pbc[i] = ld8(BC + ((size_t)b * SEQ + t_) * 512 + (cv_ < 16 ? 256 + gq * 128 + cv_ * 8 : gq * 128 + (cv_ - 16) * 8)); } } while (0)
#define MB_PREFETCH(c_) do { \
    { const int tb_ = dir ? (SEQ - 1 - ((c_) * 64 + tg * 2 + 1)) : ((c_) * 64 + tg * 2); \
      _Pragma("unroll") for (int j = 0; j < 4; ++j) { const int t_ = tb_ - 1 + j; px[j] = (t_ >= 0 && t_ < SEQ) ? ld8(raw + ((size_t)b * SEQ + t_) * 2592 + 1024 + xc) : (u32x4){0u, 0u, 0u, 0u}; } \
      pdt[0] = raw[((size_t)b * SEQ + tb_) * 2592 + 2560 + dir * 16 + head]; pdt[1] = raw[((size_t)b * SEQ + tb_ + 1) * 2592 + 2560 + dir * 16 + head]; } \
    if (tid < 64) { const int st_ = (c_) * 64 + tid, t_ = dir ? (SEQ - 1 - st_) : st_; pdts = raw[((size_t)b * SEQ + t_) * 2592 + 2560 + dir * 16 + head]; } } while (0)
  MB_PREFETCH(0);
  for (int c = 0; c < SEQ / 64; ++c) {
    u32x4 pbc[8];
    MB_LOADBC(c);
    { asm volatile("" ::: "memory");
      float cw0[8], cw1[8], cw2[8], cbv[8];
#pragma unroll
      for (int j = 0; j < 8; ++j) { cw0[j] = p.mb_conv_w[xc + j]; cw1[j] = p.mb_conv_w[1536 + xc + j]; cw2[j] = p.mb_conv_w[3072 + xc + j]; cbv[j] = p.mb_conv_b[xc + j]; }
      float R[4][8];
#pragma unroll
      for (int j = 0; j < 4; ++j) unpack8(px[j], R[j]);
#pragma unroll
      for (int i = 0; i < 2; ++i) {
        const int pi = dir ? (1 - i) : i;
        const float dt = softplusf_(bf2f(pdt[dir ? (1 - i) : i]) + dtb);
        float o[8];
#pragma unroll
        for (int j = 0; j < 8; ++j) o[j] = dt * siluf_(cbv[j] + cw0[j] * R[pi][j] + cw1[j] * R[pi + 1][j] + cw2[j] * R[pi + 2][j]);
        *(u32x4*)(G.Vs() + (tg * 2 + i) * G.VP + cvi * 8) = pack8(o);
      } }
    if (tid < 64) {
      const int s = tid;
      const float dt = softplusf_(bf2f(pdts) + dtb);
      const float cs = wave_incl_sum(dt * Aneg, s); const float csl = __shfl(cs, 63);
      G.P()[s] = cs; G.Qv()[s] = cs; G.I()[s] = cs; G.Wl()[s] = csl - cs; if (s == 0) G.gl()[0] = csl;
    }
#pragma unroll
    for (int i = 0; i < 8; ++i) { const int v = tid + i * 256, s = v >> 5, cv = v & 31; *(u32x4*)((cv < 16 ? G.Qs() : G.Ks()) + s * G.QP + (cv & 15) * 8) = pbc[i]; }
    if (c + 1 < SEQ / 64) MB_PREFETCH(c + 1);
    __syncthreads();
    f32x4 y[4];
    G.compute_y(y);
#pragma unroll
    for (int vb = 0; vb < 4; ++vb)
#pragma unroll
      for (int j = 0; j < 4; ++j) { const int s = G.w * 16 + G.fq * 4 + j, st = c * 64 + s, t = dir ? (SEQ - 1 - st) : st; Y[((size_t)b * SEQ + t) * 1024 + head * 64 + vb * 16 + G.fr] = f2bf(y[vb][j]); }
    G.update();
  }
#undef MB_PREFETCH
#undef MB_LOADBC
}

DI void mlstm_item(const Ctx& c, int item, char* smem) {
  const Params& p = c.p; (void)p;
  const int half = item & 1, head = (item >> 1) & 7, b = (item >> 4) & 15, dir = item >> 8;
  const int tid = TIDX;
  Gla<80> G; G.init(smem, tid);
  float* Wl_ = (float*)(smem + Gla<80>::BYTES);
  for (int i = tid; i < 128; i += 256) { const int ch = head * 128 + i, li = (i >> 3) * 12 + (i & 7); Wl_[li] = p.ml_conv_w[ch]; Wl_[192 + li] = p.ml_conv_w[1024 + ch]; Wl_[384 + li] = p.ml_conv_w[2048 + ch]; Wl_[576 + li] = p.ml_conv_b[ch]; }
  for (int i = tid; i < 512; i += 256) { const int li = (i >> 5) * 36 + (i & 31); Wl_[768 + li] = p.ml_wq[head * 512 + i]; Wl_[768 + 576 + li] = p.ml_wk[head * 512 + i] * 0.08838834764831845f; Wl_[768 + 1152 + li] = p.ml_wv[head * 512 + i]; }
  if (tid < 64) { for (int j = 0; j < 16; ++j) G.Vs()[tid * G.VP + 64 + j] = (j == 0) ? (bf16_t)0x3f80 : (bf16_t)0; }
  const bf16_t* raw = (const bf16_t*)(p.ws + OFF_MLRAW);
  bf16_t* H = (bf16_t*)(p.ws + OFF_HFB) + (size_t)dir * NTOK * 1024;
  const float ib = p.ml_i_b[dir * 8 + head], fb = p.ml_f_b[dir * 8 + head];
  const int cvi = tid & 15, tg = tid >> 4, ch = head * 128 + cvi * 8;
  float mprev = 0.f;
  u32x4 px[6]; bf16_t pgi = 0, pgf = 0;
#define ML_PREFETCH(c_) do { const int tb_ = dir ? (SEQ - 1 - ((c_) * 64 + tg * 4 + 3)) : ((c_) * 64 + tg * 4); \
    _Pragma("unroll") for (int j = 0; j < 6; ++j) { const int t_ = tb_ - 1 + j; px[j] = (t_ >= 0 && t_ < SEQ) ? ld8(raw + ((size_t)b * SEQ + t_) * 2080 + ch) : (u32x4){0u, 0u, 0u, 0u}; } \
    if (tid < 64) { const int st_ = (c_) * 64 + tid, t_ = dir ? (SEQ - 1 - st_) : st_; const size_t tok_ = (size_t)b * SEQ + t_; pgi = raw[tok_ * 2080 + 2048 + dir * 8 + head]; pgf = raw[tok_ * 2080 + 2064 + dir * 8 + head]; } } while (0)
  ML_PREFETCH(0);
  __syncthreads();
  for (int c = 0; c < SEQ / 64; ++c) {
    {
#pragma unroll
      for (int i = 0; i < 4; ++i) {
        float prv[8], cur[8], nxt[8];
        { const u32x4 a = dir ? px[3 - i] : px[i], bq = dir ? px[4 - i] : px[i + 1], cq = dir ? px[5 - i] : px[i + 2]; unpack8(a, prv); unpack8(bq, cur); unpack8(cq, nxt); }
        float xcv[8], q[8], k[8], v[8];
#pragma unroll
        for (int j4 = 0; j4 < 2; ++j4) {
          const f32x4 w0 = *(const f32x4*)(Wl_ + cvi * 12 + j4 * 4), w1 = *(const f32x4*)(Wl_ + 192 + cvi * 12 + j4 * 4), w2 = *(const f32x4*)(Wl_ + 384 + cvi * 12 + j4 * 4), bb = *(const f32x4*)(Wl_ + 576 + cvi * 12 + j4 * 4);
#pragma unroll
          for (int j = 0; j < 4; ++j) xcv[j4 * 4 + j] = siluf_(bb[j] + w0[j] * prv[j4 * 4 + j] + w1[j] * cur[j4 * 4 + j] + w2[j] * nxt[j4 * 4 + j]);
        }
#pragma unroll
        for (int bl = 0; bl < 2; ++bl) {
          f32x4 aq = (f32x4){0.f, 0.f, 0.f, 0.f}, ak = aq, av = aq;
#pragma unroll
          for (int cc = 0; cc < 4; ++cc) {
            const int wi = cvi * 36 + bl * 16 + cc * 4;
            aq += *(const f32x4*)(Wl_ + 768 + wi) * xcv[bl * 4 + cc]; ak += *(const f32x4*)(Wl_ + 768 + 576 + wi) * xcv[bl * 4 + cc]; av += *(const f32x4*)(Wl_ + 768 + 1152 + wi) * cur[bl * 4 + cc];
          }
#pragma unroll
          for (int d = 0; d < 4; ++d) { q[bl * 4 + d] = aq[d]; k[bl * 4 + d] = ak[d]; v[bl * 4 + d] = av[d]; }
        }
        const int s = tg * 4 + i;
        *(u32x4*)(G.Qs() + s * G.QP + cvi * 8) = pack8(q);
        *(u32x4*)(G.Ks() + s * G.QP + cvi * 8) = pack8(k);
        if ((cvi >> 3) == half) *(u32x4*)(G.Vs() + s * G.VP + (cvi & 7) * 8) = pack8(v);
        __builtin_amdgcn_sched_barrier(0);
      } }
    if (tid < 64) {
      const int s = tid;
      const float li = bf2f(pgi) + ib;
      const float fx = bf2f(pgf) + fb;
      const float lf = fminf(fx, 0.f) - __logf(1.0f + __expf(-fabsf(fx)));
      const float bc = wave_incl_sum(lf, s);
      const float cc = li - bc;
      const float pm = fmaxf(wave_incl_max(cc, s), mprev);
      const float pml = __shfl(pm, 63), bl = __shfl(bc, 63);
      G.P()[s] = -pm; G.Qv()[s] = -cc; G.I()[s] = mprev - pm; G.Wl()[s] = cc - pml; G.Mt()[s] = bc + pm; if (s == 0) G.gl()[0] = mprev - pml;
      mprev = bl + pml;
    }
    if (c + 1 < SEQ / 64) ML_PREFETCH(c + 1);
    __syncthreads();
    f32x4 y[5];
    G.compute_y(y);
#pragma unroll
    for (int j = 0; j < 4; ++j) {
      const float den = __shfl(y[4][j], G.lane & 48);
      const int s = G.w * 16 + G.fq * 4 + j, st = c * 64 + s, t = dir ? (SEQ - 1 - st) : st;
      const float dn = 1.0f / fmaxf(fabsf(den), __expf(-G.Mt()[s]));
#pragma unroll
      for (int vb = 0; vb < 4; ++vb) H[((size_t)b * SEQ + t) * 1024 + head * 128 + half * 64 + vb * 16 + G.fr] = f2bf(y[vb][j] * dn);
    }
    G.update();
  }
#undef ML_PREFETCH
}

DI void s5_item(const Ctx& c, int item, char* smem) {
  const Params& p = c.p; (void)p;
  constexpr int T = 16, XP = 136, BP = 132;
  const int dir = item >> 7, b = (item >> 3) & 15, gq = item & 7;
  const int tid = TIDX, lane = tid & 63, wave = tid >> 6, fr = lane & 15, fq = lane >> 4;
  const int g = gq * 4 + wave;
  float* BUw = (float*)smem + wave * (T * BP);
  bf16_t* Xw = (bf16_t*)(smem + 4 * T * BP * 4) + wave * (T * XP);
  const bf16_t* U = (const bf16_t*)(p.ws + OFF_S5U);
  bf16_t* Y = (bf16_t*)(p.ws + OFF_S5Y) + (size_t)dir * NTOK * 512;
  const float dtv = expf(p.s5_log_dt[dir * 32 + g]);
  float abr, abi;
  { const float ar = fminf(p.s5_A_re[(dir * 32 + g) * 64 + lane], -1e-4f), ai = p.s5_A_im[(dir * 32 + g) * 64 + lane];
    const float mag = expf(dtv * ar); abr = mag * cosf(dtv * ai); abi = mag * sinf(dtv * ai); }
  bf16x8 bf_[8];
#pragma unroll
  for (int q = 0; q < 4; ++q) {
    const int pp = q * 16 + fr;
    const float ar = fminf(p.s5_A_re[(dir * 32 + g) * 64 + pp], -1e-4f), ai = p.s5_A_im[(dir * 32 + g) * 64 + pp];
    const float mag = expf(dtv * ar), br_ = mag * cosf(dtv * ai), bi_ = mag * sinf(dtv * ai), den = ar * ar + ai * ai;
    const float f_r = ((br_ - 1.0f) * ar + bi_ * ai) / den, f_i = (bi_ * ar - (br_ - 1.0f) * ai) / den;
    float vr[8], vi[8];
#pragma unroll
    for (int jj = 0; jj < 8; ++jj) {
      float bre = 0.f, bim = 0.f;
      if (fq < 2) { bre = p.s5_B_re[(g * 64 + pp) * 16 + fq * 8 + jj]; bim = p.s5_B_im[(g * 64 + pp) * 16 + fq * 8 + jj]; }
      vr[jj] = f_r * bre - f_i * bim; vi[jj] = f_r * bim + f_i * bre;
    }
    bf_[q] = __builtin_bit_cast(bf16x8, pack8(vr)); bf_[4 + q] = __builtin_bit_cast(bf16x8, pack8(vi));
  }
  bf16x8 cf[4];
#pragma unroll
  for (int ks = 0; ks < 4; ++ks) {
    float cv[8];
#pragma unroll
    for (int jj = 0; jj < 8; ++jj) { const int k = ks * 32 + fq * 8 + jj; const size_t base = ((size_t)(dir * 32 + g) * 16 + fr) * 64; cv[jj] = k < 64 ? p.s5_C_re[base + k] : -p.s5_C_im[base + k - 64]; }
    cf[ks] = __builtin_bit_cast(bf16x8, pack8(cv));
  }
  float xr = 0.f, xi = 0.f;
  u32x4 pu;
#define S5_PREFETCH(c0_) do { const int st_ = (c0_) + fr, t_ = dir ? (SEQ - 1 - st_) : st_; \
    pu = (fq < 2) ? ld8(U + ((size_t)b * SEQ + t_) * 512 + g * 16 + fq * 8) : (u32x4){0u, 0u, 0u, 0u}; } while (0)
  S5_PREFETCH(0);
  for (int c0 = 0; c0 < SEQ; c0 += T) {
    const bf16x8 ua = __builtin_bit_cast(bf16x8, pu);
    if (c0 + T < SEQ) S5_PREFETCH(c0 + T);
    asm volatile("" ::: "memory");
#pragma unroll
    for (int nb = 0; nb < 8; ++nb) {
      f32x4 bu = MFMA16(ua, bf_[nb], ((f32x4){0.f, 0.f, 0.f, 0.f}));
#pragma unroll
      for (int j = 0; j < 4; ++j) BUw[(fq * 4 + j) * BP + nb * 16 + fr] = bu[j];
    }
    asm volatile("" ::: "memory");
#pragma unroll
    for (int s = 0; s < T; ++s) {
      const float bur = BUw[s * BP + lane], bui = BUw[s * BP + 64 + lane];
      const float nr = abr * xr - abi * xi + bur, ni = abr * xi + abi * xr + bui;
      xr = nr; xi = ni;
      const unsigned pk = pack2(xr, xi);
      Xw[s * XP + lane] = (bf16_t)(pk & 0xffffu); Xw[s * XP + 64 + lane] = (bf16_t)(pk >> 16);
    }
    asm volatile("" ::: "memory");
    f32x4 y = (f32x4){0.f, 0.f, 0.f, 0.f};
#pragma unroll
    for (int ks = 0; ks < 4; ++ks) { const bf16x8 xa = *(const bf16x8*)(Xw + fr * XP + ks * 32 + fq * 8); y = MFMA16(xa, cf[ks], y); }
#pragma unroll
    for (int j = 0; j < 4; ++j) { const int st = c0 + fq * 4 + j, t = dir ? (SEQ - 1 - st) : st; Y[((size_t)b * SEQ + t) * 512 + g * 16 + fr] = f2bf(y[j]); }
  }
#undef S5_PREFETCH
}

DI void phase_post0(const Ctx& c) {
  const Params& p = c.p; (void)p;
  const int lane = TIDX & 63, wid = TIDX >> 6;
  const int gw = blockIdx.x * 4 + wid, nw = gridDim.x * 4;
  {
    bf16_t* E0 = (bf16_t*)(p.ws + OFF_R1); const bf16_t* E1 = E0 + (size_t)NTOK * 512; const bf16_t* Ab = E1 + (size_t)NTOK * 512;
    const bf16_t* G = (const bf16_t*)(p.ws + OFF_XN); const bf16_t* RKV = (const bf16_t*)(p.ws + OFF_RKV);
    for (int tok = gw; tok < NTOK; tok += nw) {
      const int c = lane * 8;
      float y0[8], y1[8], r[8], k[8], v[8], a[8], g[8], o[8];
      unpack8(ld8(E0 + (size_t)tok * 512 + c), y0); unpack8(ld8(E1 + (size_t)tok * 512 + c), y1);
      unpack8(ld8(RKV + (size_t)tok * 1536 + c), r); unpack8(ld8(RKV + (size_t)tok * 1536 + 512 + c), k); unpack8(ld8(RKV + (size_t)tok * 1536 + 1024 + c), v);
      unpack8(ld8(Ab + (size_t)tok * 512 + c), a); unpack8(ld8(G + (size_t)tok * 512 + c), g);
      float sy = 0.f, sb = 0.f;
#pragma unroll
      for (int j = 0; j < 8; ++j) { y0[j] += y1[j]; sy += y0[j]; const float k2 = k[j] * (1.0f + (a[j] - 1.0f) * p.rw_k_a[c + j]); sb += r[j] * k2 * p.rw_r_k[c + j]; }
      const float mean = sum8(sy) * (1.0f / 64.0f); sb = sum8(sb);
      float sv = 0.f;
#pragma unroll
      for (int j = 0; j < 8; ++j) { y0[j] -= mean; sv += y0[j] * y0[j]; }
      const float rs = rsqrtf(sum8(sv) * (1.0f / 64.0f) + 64e-5f);
#pragma unroll
      for (int j = 0; j < 8; ++j) o[j] = (y0[j] * rs * p.rw_ln_w[c + j] + sb * v[j]) * g[j];
      *(u32x4*)(E0 + (size_t)tok * 512 + c) = pack8(o);
    }
  }
  {
    bf16_t* raw = (bf16_t*)(p.ws + OFF_R2);
    const bf16_t* Y0 = (const bf16_t*)p.out; const bf16_t* Y1 = Y0 + (size_t)NTOK * 1024;
    const float* cw = p.mb_conv_w; const float* cb = p.mb_conv_b;
    for (int u = gw; u < NTOK; u += nw) {
      const int tp = u >> 1, gq = u & 1, col = gq * 512 + lane * 8, head = col >> 6, tok0 = tp * 2, t0 = tok0 & (SEQ - 1);
      bf16_t* zp = raw + (size_t)tok0 * 2592 + col;
      const bf16_t* rp = zp + 1024;
      u32x4 R[4], Yq[2][2], Zq[2];
#pragma unroll
      for (int j = 0; j < 4; ++j) { const int tj = t0 - 1 + j; R[j] = (tj >= 0 && tj < SEQ) ? ld8(rp + (j - 1) * 2592) : (u32x4){0u, 0u, 0u, 0u}; }
#pragma unroll
      for (int i = 0; i < 2; ++i) { Yq[i][0] = ld8(Y0 + (size_t)(tok0 + i) * 1024 + col); Yq[i][1] = ld8(Y1 + (size_t)(tok0 + i) * 1024 + col); Zq[i] = ld8(zp + i * 2592); }
      float w0[8], w1[8], w2[8], bb[8], nw_[8];
#pragma unroll
      for (int j = 0; j < 8; ++j) { w0[j] = cw[col + j]; w1[j] = cw[1536 + col + j]; w2[j] = cw[3072 + col + j]; bb[j] = cb[col + j]; nw_[j] = p.mb_norm_w[col + j]; }
      const float D = p.mb_D[head];
#pragma unroll
      for (int i = 0; i < 2; ++i) {
        float y0[8], y1[8], z[8], cur[8], prv[8], nxt[8], o[8];
        unpack8(Yq[i][0], y0); unpack8(Yq[i][1], y1); unpack8(Zq[i], z); unpack8(R[i], prv); unpack8(R[i + 1], cur); unpack8(R[i + 2], nxt);
        float ss = 0.f;
#pragma unroll
        for (int j = 0; j < 8; ++j) { const float xs = siluf_(bb[j] + w0[j] * prv[j] + w1[j] * cur[j] + w2[j] * nxt[j]);
          const float yy = (y0[j] + y1[j] + D * xs) * siluf_(z[j]); o[j] = yy; ss += yy * yy; }
        ss = wave_sum(ss);
        const float rs = rsqrtf(ss * (1.0f / 512.0f) + 1e-5f);
#pragma unroll
        for (int j = 0; j < 8; ++j) o[j] = o[j] * rs * nw_[j];
        *(u32x4*)(zp + i * 2592) = pack8(o);
      }
    }
  }
}

DI float gelu_tanh(float x) { const float u = 0.7978845608028654f * (x + 0.044715f * x * x * x); return 0.5f * x * (1.0f + tanhf(u)); }

DI void phase_post1(const Ctx& c) {
  const Params& p = c.p; (void)p;
  const int lane = TIDX & 63, wid = TIDX >> 6;
  const int gw = blockIdx.x * 4 + wid, nw = gridDim.x * 4;
  {
    const bf16_t* U = (const bf16_t*)(p.ws + OFF_S5U); const bf16_t* Y0 = (const bf16_t*)(p.ws + OFF_S5Y); const bf16_t* Y1 = Y0 + (size_t)NTOK * 512;
    bf16_t* YG = (bf16_t*)(p.ws + OFF_YG);
    for (int tok = gw; tok < NTOK; tok += nw) {
      const int col = lane * 8; float u[8], a[8], c[8], o[8];
      unpack8(ld8(U + (size_t)tok * 512 + col), u); unpack8(ld8(Y0 + (size_t)tok * 512 + col), a); unpack8(ld8(Y1 + (size_t)tok * 512 + col), c);
#pragma unroll
      for (int j = 0; j < 8; ++j) o[j] = gelu_tanh(p.s5_D[col + j] * u[j] + a[j] + c[j]);
      *(u32x4*)(YG + (size_t)tok * 512 + col) = pack8(o);
    }
  }
  {
    bf16_t* raw = (bf16_t*)(p.ws + OFF_MLRAW);
    const bf16_t* HF = (const bf16_t*)(p.ws + OFF_HFB); const bf16_t* HB = HF + (size_t)NTOK * 1024;
    for (int u = gw; u < NTOK; u += nw) {
      const int tp = u >> 1, cc = (u & 1) * 512 + lane * 8, tok0 = tp * 2, t0 = tok0 & (SEQ - 1);
      bf16_t* xp = raw + (size_t)tok0 * 2080 + cc;
      u32x4 R[4], Hq[2][2], Oq[2];
#pragma unroll
      for (int j = 0; j < 4; ++j) { const int tj = t0 - 1 + j; R[j] = (tj >= 0 && tj < SEQ) ? ld8(xp + (j - 1) * 2080) : (u32x4){0u, 0u, 0u, 0u}; }
#pragma unroll
      for (int i = 0; i < 2; ++i) { Hq[i][0] = ld8(HF + (size_t)(tok0 + i) * 1024 + cc); Hq[i][1] = ld8(HB + (size_t)(tok0 + i) * 1024 + cc); Oq[i] = ld8(xp + i * 2080 + 1024); }
      float w0[8], w1[8], w2[8], bb[8], nw_[8], sk[8];
#pragma unroll
      for (int j = 0; j < 8; ++j) { w0[j] = p.ml_conv_w[cc + j]; w1[j] = p.ml_conv_w[1024 + cc + j]; w2[j] = p.ml_conv_w[2048 + cc + j]; bb[j] = p.ml_conv_b[cc + j]; nw_[j] = p.ml_norm_w[cc + j]; sk[j] = p.ml_skip[cc + j]; }
#pragma unroll
      for (int i = 0; i < 2; ++i) {
        float hf[8], hb[8], cur[8], prv[8], nxt[8], og[8], o[8];
        unpack8(Hq[i][0], hf); unpack8(Hq[i][1], hb); unpack8(R[i], prv); unpack8(R[i + 1], cur); unpack8(R[i + 2], nxt); unpack8(Oq[i], og);
        float sh = 0.f;
#pragma unroll
        for (int j = 0; j < 8; ++j) { hf[j] += hb[j]; sh += hf[j]; }
        sh = sum8(sh); sh += dpp_mov<0x140>(sh);
        const float mean = sh * (1.0f / 128.0f);
        float sv = 0.f;
#pragma unroll
        for (int j = 0; j < 8; ++j) { hf[j] -= mean; sv += hf[j] * hf[j]; }
        sv = sum8(sv); sv += dpp_mov<0x140>(sv);
        const float rs = rsqrtf(sv * (1.0f / 128.0f) + 1e-5f);
#pragma unroll
        for (int j = 0; j < 8; ++j) {
          const float xcv = siluf_(bb[j] + w0[j] * prv[j] + w1[j] * cur[j] + w2[j] * nxt[j]);
          o[j] = sigmoidf_(og[j]) * (hf[j] * rs * nw_[j]) + sk[j] * xcv;
        }
        *(u32x4*)(xp + i * 2080 + 1024) = pack8(o);
      }
    }
  }
}

DI void phase_final(const Ctx& c) {
  const Params& p = c.p; (void)p;
  const int lane = TIDX & 63, wid = TIDX >> 6;
  f32x4 g[4];
#pragma unroll
  for (int i = 0; i < 4; ++i) g[i] = *(const f32x4*)(p.norm_final + i * 256 + lane * 4);
  for (int u = blockIdx.x; u < NTOK / 8; u += gridDim.x) {
    float* xr = p.out + (size_t)(u * 8 + wid * 2) * 1024;
    f32x4 v[2][4];
#pragma unroll
    for (int r = 0; r < 2; ++r)
#pragma unroll
      for (int i = 0; i < 4; ++i) v[r][i] = *(const f32x4*)(xr + r * 1024 + i * 256 + lane * 4);
#pragma unroll
    for (int r = 0; r < 2; ++r) {
      float ss = 0.f;
#pragma unroll
      for (int i = 0; i < 4; ++i) ss += v[r][i][0] * v[r][i][0] + v[r][i][1] * v[r][i][1] + v[r][i][2] * v[r][i][2] + v[r][i][3] * v[r][i][3];
      ss = wave_sum(ss);
      const float rs = rsqrtf(ss * (1.0f / 1024.0f) + 1e-5f);
#pragma unroll
      for (int i = 0; i < 4; ++i) *(f32x4*)(xr + r * 1024 + i * 256 + lane * 4) = v[r][i] * rs * g[i];
    }
  }
}

constexpr int NPHASE = 20;
#ifdef NO_RW
#define RWK(x)
#else
#define RWK(x) x
#endif
#ifdef NO_MB
#define MBK(x)
#else
#define MBK(x) x
#endif
#ifndef ONLY_PHASE
#define ONLY_PHASE -1
#endif
#define PH(k) case k: if (ONLY_PHASE >= 0 && ONLY_PHASE != k) break;
template <int ph> DI void run_phase(const Ctx& c, char* smem) {
  const Params& p = c.p; (void)p;
  char* ws = p.ws;
  bf16_t* XN = (bf16_t*)(ws + OFF_XN);
  switch (ph) {
    PH(0) phase_prep(c, smem); break;
    PH(1) gemm_phase(smem, XN, 1024, 1 << 30, XN, 1024, (const bf16_t*)(ws + OFF_WABIN), 1024, 35,
                       EpiSplit{(bf16_t*)(ws + OFF_R1), 1792, 1792, (bf16_t*)(ws + OFF_R2), 2592, 2592}, TIDX); break;
    PH(2) phase_rw_shift(c); break;
    PH(3) phase_rw_small_gemms(c, smem); break;
    PH(4) {
      const int G = gridDim.x, bx = blockIdx.x;
      if (G >= 512) { if (bx < 256) { RWK(rwkv_item(c, bx, smem);) } else for (int u = bx - 256; u < 512; u += G - 256) { MBK(mamba_item(c, u, smem);) } }
      else { for (int u = bx; u < 256; u += G) { RWK(rwkv_item(c, u, smem);) } __syncthreads(); for (int u = bx + ((256 - bx + G - 1) / G) * G; u < 768; u += G) { MBK(mamba_item(c, u - 256, smem);) } }
    } break;
    PH(5) phase_post0(c); break;
    PH(6) gemm_phase(smem, (const bf16_t*)(ws + OFF_R1), 512, 512, (const bf16_t*)(ws + OFF_R2), 2592, (const bf16_t*)(ws + OFF_WABOUT), 1536, 8, EpiResid{p.x, p.out}, TIDX); break;
    PH(7) phase_rmsnorm(c, p.out, p.norm_mlp); break;
    PH(8) gemm_phase(smem, XN, 1024, 1 << 30, XN, 1024, (const bf16_t*)(ws + OFF_W1), 1024, 32, EpiRelu2{(bf16_t*)(ws + OFF_R1)}, TIDX); break;
    PH(9) gemm_phase(smem, (const bf16_t*)(ws + OFF_R1), 4096, 1 << 30, XN, 1024, (const bf16_t*)(ws + OFF_W2), 4096, 8, EpiResid{p.out, p.out}, TIDX); break;
    PH(10) phase_rmsnorm(c, p.out, p.norm_mix + 1024); break;
    PH(11) gemm_phase(smem, XN, 1024, 1 << 30, XN, 1024, (const bf16_t*)(ws + OFF_WCDIN), 1024, 21,
                        EpiSplit{(bf16_t*)(ws + OFF_S5U), 512, 512, (bf16_t*)(ws + OFF_MLRAW), 2080, 2080}, TIDX); break;
    PH(12) {
      const int G = gridDim.x, bx = blockIdx.x;
      if (G >= 512) { if (bx >= 256 && bx < 512) s5_item(c, bx - 256, smem); __syncthreads(); for (int u = bx; u < 512; u += G) mlstm_item(c, u, smem); }
      else { for (int u = bx; u < 512; u += G) mlstm_item(c, u, smem);
        __syncthreads();
        { int u0 = bx + ((512 - bx + G - 1) / G) * G; for (int u = u0; u < 768; u += G) s5_item(c, u - 512, smem); } }
    } break;
    PH(13) phase_post1(c); break;
    PH(14) gemm_phase(smem, (const bf16_t*)(ws + OFF_YG), 512, 1 << 30, XN, 1024, (const bf16_t*)(ws + OFF_WGLU), 512, 4,
                        EpiGlu{(const bf16_t*)(ws + OFF_YG), p.s5_glu_b, (bf16_t*)(ws + OFF_S5Y)}, TIDX); break;
    PH(15) gemm_phase(smem, (const bf16_t*)(ws + OFF_S5Y), 512, 512, (const bf16_t*)(ws + OFF_MLRAW) + 1024, 2080, (const bf16_t*)(ws + OFF_WCDOUT), 1536, 8, EpiResid{p.out, p.out}, TIDX); break;
    PH(16) phase_rmsnorm(c, p.out, p.norm_mlp + 1024); break;
    PH(17) gemm_phase(smem, XN, 1024, 1 << 30, XN, 1024, (const bf16_t*)(ws + OFF_W1) + 4096ull * 1024, 1024, 32, EpiRelu2{(bf16_t*)(ws + OFF_R1)}, TIDX); break;
    PH(18) gemm_phase(smem, (const bf16_t*)(ws + OFF_R1), 4096, 1 << 30, XN, 1024, (const bf16_t*)(ws + OFF_W2) + 4096ull * 1024, 4096, 8, EpiResid{p.out, p.out}, TIDX); break;
    PH(19) phase_final(c); break;
    default: break;
  }
}

DI void grid_barrier(const Ctx& c, unsigned idx) {
  const Params& p = c.p; (void)p;
  asm volatile("s_waitcnt vmcnt(0)" ::: "memory");
  __syncthreads();
  if (TIDX == 0) {
    unsigned* bar = (unsigned*)(p.ws + OFF_BAR);
    const unsigned G = gridDim.x, grp = blockIdx.x & 7u;
    const unsigned gsz = (G >> 3) + ((grp < (G & 7u)) ? 1u : 0u);
    const unsigned ngrp = G < 8u ? G : 8u;
    __builtin_amdgcn_fence(__ATOMIC_RELEASE, "agent");
    asm volatile("s_waitcnt vmcnt(0)" ::: "memory");
    const unsigned old = __hip_atomic_fetch_add(bar + 64 * (1 + grp), 1u, __ATOMIC_RELAXED, __HIP_MEMORY_SCOPE_AGENT);
    if (old + 1u == idx * gsz) {
      __builtin_amdgcn_fence(__ATOMIC_ACQ_REL, "agent");
      asm volatile("s_waitcnt vmcnt(0)" ::: "memory");
      const unsigned og = __hip_atomic_fetch_add(bar, 1u, __ATOMIC_RELAXED, __HIP_MEMORY_SCOPE_AGENT);
      if (og + 1u == idx * ngrp) {
        for (unsigned g_ = 0; g_ < ngrp; ++g_) __hip_atomic_store(bar + 64 * (9 + g_), idx, __ATOMIC_RELAXED, __HIP_MEMORY_SCOPE_AGENT);
      }
    }
    while (__hip_atomic_load(bar + 64 * (9 + grp), __ATOMIC_RELAXED, __HIP_MEMORY_SCOPE_AGENT) < idx) __builtin_amdgcn_s_sleep(1);
    __builtin_amdgcn_fence(__ATOMIC_ACQUIRE, "agent");
    asm volatile("s_waitcnt vmcnt(0)" ::: "memory");
  }
  __syncthreads();
}

template <int PHI> DI void run_from(const Ctx& c, char* smem, int ph0, int ph1) {
  const Params& p = c.p; (void)p;
  if constexpr (PHI < NPHASE) {
    if (ph0 <= PHI && PHI < ph1) {
      run_phase<PHI>(c, smem);
      if (PHI + 1 < ph1) {
        if constexpr (PHI == 0) { __syncthreads(); cg::this_grid().sync(); }
        else grid_barrier(c, (unsigned)PHI);
      }
    }
    run_from<PHI + 1>(c, smem, ph0, ph1);
  }
}

__global__ void __launch_bounds__(256, 2) mega(Params p, int ph0, int ph1) {
  extern __shared__ __attribute__((aligned(16))) char smem[];
  const Ctx c{p, __builtin_amdgcn_readfirstlane((int)(__builtin_amdgcn_workitem_id_x() >> 6))};
  run_from<0>(c, smem, ph0, ph1);
}

#ifndef ONE_LAUNCH
#define ONE_LAUNCH 1
#endif

extern "C" void kernel_launch(void* const* d_in, const int* in_sizes, int n_in, void* d_out, int out_size, void* d_ws, size_t ws_size,
                              hipStream_t stream) {
  static int grid_blocks = 0;
  if (!grid_blocks) {
    hipFuncSetAttribute((const void*)mega, hipFuncAttributeMaxDynamicSharedMemorySize, LDS_BYTES);
    int dev = 0, cus = 0, per_cu = 0;
    hipGetDevice(&dev);
    hipDeviceGetAttribute(&cus, hipDeviceAttributeMultiprocessorCount, dev);
    hipOccupancyMaxActiveBlocksPerMultiprocessor(&per_cu, mega, 256, LDS_BYTES);
    if (per_cu > 2) per_cu = 2;
    if (per_cu < 1) per_cu = 1;
    grid_blocks = cus * per_cu;
  }
  Params p{};
  const float** pf = (const float**)&p;
  for (int i = 0; i < 45; ++i) pf[i] = (const float*)d_in[i];
  p.out = (float*)d_out;
  p.ws = (char*)d_ws;
#if ONE_LAUNCH
  int ph0 = 0, ph1 = NPHASE;
  void* args[] = {&p, &ph0, &ph1};
  hipError_t e = hipLaunchCooperativeKernel((const void*)mega, dim3(grid_blocks), dim3(256), args, LDS_BYTES, stream);
  if (e != hipSuccess) fprintf(stderr, "cooperative launch failed: %s (grid %d)\n", hipGetErrorString(e), grid_blocks);
#else
  for (int ph = 0; ph < NPHASE; ++ph) hipLaunchKernelGGL(mega, dim3(grid_blocks), dim3(256), LDS_BYTES, stream, p, ph, ph + 1);
#endif
}
```

```cpp
#include <hip/hip_runtime.h>
#include <hip/hip_cooperative_groups.h>
#include <stdint.h>
#include <cstdio>
namespace cg = cooperative_groups;

typedef unsigned short bf16_t;
typedef short bf16x8 __attribute__((ext_vector_type(8)));
typedef float f32x4 __attribute__((ext_vector_type(4)));
typedef unsigned u32x4 __attribute__((ext_vector_type(4)));
typedef unsigned u32x2 __attribute__((ext_vector_type(2)));

#define DI __device__ __forceinline__
#define LANEID() ((int)__builtin_amdgcn_mbcnt_hi(~0u, __builtin_amdgcn_mbcnt_lo(~0u, 0u)))
#define TIDX (c.wid * 64 + LANEID())
#define MFMA16(a, b, c) __builtin_amdgcn_mfma_f32_16x16x32_bf16((a), (b), (c), 0, 0, 0)

constexpr int NTOK = 32768, SEQ = 2048;
constexpr size_t MiB = 1ull << 20;
constexpr size_t OFF_WABIN = 0;
constexpr size_t OFF_WABOUT = OFF_WABIN + 4480ull * 1024 * 2;
constexpr size_t OFF_W1 = OFF_WABOUT + 1024ull * 1536 * 2;
constexpr size_t OFF_W2 = OFF_W1 + 2ull * 4096 * 1024 * 2;
constexpr size_t OFF_WCDIN = OFF_W2 + 2ull * 4096 * 1024 * 2;
constexpr size_t OFF_WCDOUT = OFF_WCDIN + 2688ull * 1024 * 2;
constexpr size_t OFF_WGLU = OFF_WCDOUT + 1024ull * 1536 * 2;
constexpr size_t OFF_WG2 = OFF_WGLU + 512ull * 512 * 2;
constexpr size_t OFF_WW2 = OFF_WG2 + 512ull * 128 * 2;
constexpr size_t OFF_WA2 = OFF_WW2 + 2ull * 512 * 64 * 2;
constexpr size_t OFF_WEND = OFF_WA2 + 512ull * 64 * 2;
static_assert(OFF_WEND <= 56 * MiB, "weights region");
constexpr size_t OFF_XN = 56 * MiB;
constexpr size_t OFF_R1 = 120 * MiB;
constexpr size_t OFF_R2 = 232 * MiB;
constexpr size_t OFF_RKV = 394 * MiB;
constexpr size_t OFF_SM = 490 * MiB;
constexpr size_t OFF_S5U = 120 * MiB;
constexpr size_t OFF_MLRAW = 152 * MiB;
constexpr size_t OFF_S5Y = 282 * MiB;
constexpr size_t OFF_HFB = 346 * MiB;
constexpr size_t OFF_YG = 474 * MiB;
constexpr size_t OFF_BAR = 510 * MiB;
constexpr int LDS_BYTES = 79872;

struct Params {
  const float *x, *norm_mix, *norm_mlp, *norm_final, *mlp_w1, *mlp_w2, *ab_w_in, *ab_w_out, *rw_mu, *rw_w0, *rw_w2, *rw_a0,
      *rw_a2, *rw_g2, *rw_k_k, *rw_k_a, *rw_r_k, *rw_ln_w, *mb_conv_w, *mb_conv_b, *mb_dt_bias, *mb_A_log, *mb_D, *mb_norm_w,
      *cd_w_in, *cd_w_out, *s5_A_re, *s5_A_im, *s5_log_dt, *s5_B_re, *s5_B_im, *s5_C_re, *s5_C_im, *s5_D, *s5_glu_w, *s5_glu_b,
      *ml_conv_w, *ml_conv_b, *ml_wq, *ml_wk, *ml_wv, *ml_i_b, *ml_f_b, *ml_norm_w, *ml_skip;
  float* out;
  char* ws;
};
struct Ctx { const Params& p; int wid; };

DI float bf2f(bf16_t v) { return __uint_as_float(((unsigned)v) << 16); }
typedef float f32x2c __attribute__((ext_vector_type(2)));
typedef __bf16 bf16x2c __attribute__((ext_vector_type(2)));
DI unsigned pack2(float lo, float hi) { const f32x2c v = {lo, hi}; return __builtin_bit_cast(unsigned, __builtin_convertvector(v, bf16x2c)); }
DI bf16_t f2bf(float x) { return (bf16_t)(pack2(x, x) & 0xffffu); }
DI void unpack8(u32x4 w, float* f) {
#pragma unroll
  for (int i = 0; i < 4; ++i) { f[2 * i] = __uint_as_float(w[i] << 16); f[2 * i + 1] = __uint_as_float(w[i] & 0xffff0000u); }
}
DI u32x4 pack8(const float* f) { u32x4 w; w.x = pack2(f[0], f[1]); w.y = pack2(f[2], f[3]); w.z = pack2(f[4], f[5]); w.w = pack2(f[6], f[7]); return w; }
DI u32x4 ld8(const bf16_t* p) { return *(const u32x4*)p; }
template <int CTRL> DI float dpp_mov(float v) { return __int_as_float(__builtin_amdgcn_update_dpp(0, __float_as_int(v), CTRL, 0xF, 0xF, true)); }
DI float sum8(float v) { v += dpp_mov<0xB1>(v); v += dpp_mov<0x4E>(v); v += dpp_mov<0x141>(v); return v; }
DI float wave_sum(float v) {
  v = sum8(v); v += dpp_mov<0x140>(v);
  v += __shfl_xor(v, 16); v += __shfl_xor(v, 32);
  return v;
}
DI float sigmoidf_(float x) { return __builtin_amdgcn_rcpf(1.0f + __expf(-x)); }
DI float siluf_(float x) { return x * __builtin_amdgcn_rcpf(1.0f + __expf(-x)); }
DI float softplusf_(float x) { return x > 20.f ? x : log1pf(expf(x)); }
template <int CTRL, int ROWMASK> DI float dpp_id(float idv, float v) { return __int_as_float(__builtin_amdgcn_update_dpp(__float_as_int(idv), __float_as_int(v), CTRL, ROWMASK, 0xF, false)); }
DI float wave_incl_sum(float v, int lane) {
  (void)lane;
  v += dpp_id<0x111, 0xF>(0.f, v); v += dpp_id<0x112, 0xF>(0.f, v); v += dpp_id<0x114, 0xF>(0.f, v); v += dpp_id<0x118, 0xF>(0.f, v);
  v += dpp_id<0x142, 0xA>(0.f, v); v += dpp_id<0x143, 0xC>(0.f, v);
  return v;
}
DI float wave_incl_max(float v, int lane) {
  (void)lane;
  const float ninf = -3.0e38f;
  v = fmaxf(v, dpp_id<0x111, 0xF>(ninf, v)); v = fmaxf(v, dpp_id<0x112, 0xF>(ninf, v)); v = fmaxf(v, dpp_id<0x114, 0xF>(ninf, v)); v = fmaxf(v, dpp_id<0x118, 0xF>(ninf, v));
  v = fmaxf(v, dpp_id<0x142, 0xA>(ninf, v)); v = fmaxf(v, dpp_id<0x143, 0xC>(ninf, v));
  return v;
}

DI bool get_tdesc(const Ctx& c, int i, const float*& src, bf16_t*& dst, int& K, int& Nsrc, int& Npad) {
  const Params& p = c.p; (void)p;
  char* ws = p.ws;
  switch (i) {
    case 0: src = p.ab_w_in; dst = (bf16_t*)(ws + OFF_WABIN); K = 1024; Nsrc = 4384; Npad = 4480; return true;
    case 1: src = p.ab_w_out; dst = (bf16_t*)(ws + OFF_WABOUT); K = 1536; Nsrc = 1024; Npad = 1024; return true;
    case 2: src = p.mlp_w1; dst = (bf16_t*)(ws + OFF_W1); K = 1024; Nsrc = 4096; Npad = 4096; return true;
    case 3: src = p.mlp_w1 + 1024ull * 4096; dst = (bf16_t*)(ws + OFF_W1) + 4096ull * 1024; K = 1024; Nsrc = 4096; Npad = 4096; return true;
    case 4: src = p.mlp_w2; dst = (bf16_t*)(ws + OFF_W2); K = 4096; Nsrc = 1024; Npad = 1024; return true;
    case 5: src = p.mlp_w2 + 4096ull * 1024; dst = (bf16_t*)(ws + OFF_W2) + 4096ull * 1024; K = 4096; Nsrc = 1024; Npad = 1024; return true;
    case 6: src = p.cd_w_in; dst = (bf16_t*)(ws + OFF_WCDIN); K = 1024; Nsrc = 2592; Npad = 2688; return true;
    case 7: src = p.cd_w_out; dst = (bf16_t*)(ws + OFF_WCDOUT); K = 1536; Nsrc = 1024; Npad = 1024; return true;
    case 8: src = p.s5_glu_w; dst = (bf16_t*)(ws + OFF_WGLU); K = 512; Nsrc = 512; Npad = 512; return true;
    case 9: src = p.rw_g2; dst = (bf16_t*)(ws + OFF_WG2); K = 128; Nsrc = 512; Npad = 512; return true;
    case 10: src = p.rw_w2; dst = (bf16_t*)(ws + OFF_WW2); K = 64; Nsrc = 512; Npad = 512; return true;
    case 11: src = p.rw_w2 + 64 * 512; dst = (bf16_t*)(ws + OFF_WW2) + 512 * 64; K = 64; Nsrc = 512; Npad = 512; return true;
    case 12: src = p.rw_a2; dst = (bf16_t*)(ws + OFF_WA2); K = 64; Nsrc = 512; Npad = 512; return true;
    default: return false;
  }
}

DI void phase_rmsnorm(const Ctx& c, const float* src, const float* w) {
  const Params& p = c.p; (void)p;
  bf16_t* xn = (bf16_t*)(p.ws + OFF_XN);
  const int lane = TIDX & 63, wid = TIDX >> 6;
  f32x4 g[4];
#pragma unroll
  for (int i = 0; i < 4; ++i) g[i] = *(const f32x4*)(w + i * 256 + lane * 4);
  for (int u = blockIdx.x; u < NTOK / 8; u += gridDim.x) {
    const int row = u * 8 + wid * 2;
    const float* xr = src + (size_t)row * 1024;
    f32x4 v[2][4];
#pragma unroll
    for (int r = 0; r < 2; ++r)
#pragma unroll
      for (int i = 0; i < 4; ++i) v[r][i] = *(const f32x4*)(xr + r * 1024 + i * 256 + lane * 4);
#pragma unroll
    for (int r = 0; r < 2; ++r) {
      float ss = 0.f;
#pragma unroll
      for (int i = 0; i < 4; ++i) ss += v[r][i][0] * v[r][i][0] + v[r][i][1] * v[r][i][1] + v[r][i][2] * v[r][i][2] + v[r][i][3] * v[r][i][3];
      ss = wave_sum(ss);
      const float rs = rsqrtf(ss * (1.0f / 1024.0f) + 1e-5f);
      bf16_t* o = xn + (size_t)(row + r) * 1024;
#pragma unroll
      for (int i = 0; i < 4; ++i) { u32x2 q; q.x = pack2(v[r][i][0] * rs * g[i][0], v[r][i][1] * rs * g[i][1]); q.y = pack2(v[r][i][2] * rs * g[i][2], v[r][i][3] * rs * g[i][3]); *(u32x2*)(o + i * 256 + lane * 4) = q; }
    }
  }
}

DI void phase_prep(const Ctx& c, char* smem) {
  const Params& p = c.p; (void)p;
  if (blockIdx.x == 0 && TIDX == 0) { for (int i_ = 0; i_ < 17; ++i_) __hip_atomic_store((unsigned*)(p.ws + OFF_BAR) + 64 * i_, 0u, __ATOMIC_RELAXED, __HIP_MEMORY_SCOPE_AGENT); }
  float* tile = (float*)smem;
  const int tid = TIDX;
  int ntr = 0;
  for (int i = 0; i < 13; ++i) { const float* s; bf16_t* d; int K, Ns, Np; get_tdesc(c, i, s, d, K, Ns, Np); ntr += (K / 64) * (Np / 64); }
  for (int u = blockIdx.x; u < ntr; u += gridDim.x) {
    const float* src = nullptr; bf16_t* dst = nullptr; int K = 64, Ns = 0, Np = 64, r = u;
    for (int mi = 0; mi < 13; ++mi) { get_tdesc(c, mi, src, dst, K, Ns, Np); const int nt = (K / 64) * (Np / 64); if (r < nt) break; r -= nt; }
    const int nkb = K / 64, kb = r % nkb, nb = r / nkb;
    f32x4 ld_[4];
#pragma unroll
    for (int i = 0; i < 4; ++i) { const int k = i * 16 + (tid >> 4), gn = nb * 64 + (tid & 15) * 4; ld_[i] = gn < Ns ? *(const f32x4*)(src + (size_t)(kb * 64 + k) * Ns + gn) : (f32x4){0.f, 0.f, 0.f, 0.f}; }
    __syncthreads();
#pragma unroll
    for (int i = 0; i < 4; ++i) { const int k = i * 16 + (tid >> 4), n4 = (tid & 15) * 4;
#pragma unroll
      for (int j = 0; j < 4; ++j) tile[k * 65 + n4 + j] = ld_[i][j]; }
    __syncthreads();
    const int n = tid >> 2, ks = (tid & 3) * 16; float f[16];
#pragma unroll
    for (int j = 0; j < 16; ++j) f[j] = tile[(ks + j) * 65 + n];
    bf16_t* o = dst + (size_t)(nb * 64 + n) * K + kb * 64 + ks;
    *(u32x4*)o = pack8(f); *(u32x4*)(o + 8) = pack8(f + 8);
  }
  phase_rmsnorm(c, p.x, p.norm_mix);
}

template <class Epi>
DI void gemm_tile(char* smem, const bf16_t* __restrict__ A0, int lda0, int ksplit, const bf16_t* __restrict__ A1, int lda1,
                  const bf16_t* __restrict__ Bt, int K, int row0, int col0, const Epi& epi, int tid) {
  constexpr int BK = 32, PITCH = 40, BUF = (256 + 128) * PITCH;
  bf16_t* sbase = (bf16_t*)smem;
  const int lane = tid & 63, wid = tid >> 6, wr = wid >> 1, wc = wid & 1, fr = lane & 15, fq = lane >> 4;
  f32x4 acc[8][4];
#pragma unroll
  for (int m = 0; m < 8; ++m)
#pragma unroll
    for (int n = 0; n < 4; ++n) acc[m][n] = (f32x4){0.f, 0.f, 0.f, 0.f};
  u32x4 ra[2][4], rb[2][2];
  const int nk = K / BK;
  const int sr = tid >> 2, scv = tid & 3;
#define GLOAD(S, kt) do { const int k0_ = (kt) * BK; const bf16_t* Ab_; int lda_, kk_; \
    if (k0_ < ksplit) { Ab_ = A0; lda_ = lda0; kk_ = k0_; } else { Ab_ = A1; lda_ = lda1; kk_ = k0_ - ksplit; } \
    _Pragma("unroll") for (int i_ = 0; i_ < 4; ++i_) ra[S][i_] = *(const u32x4*)(Ab_ + (size_t)(row0 + sr + i_ * 64) * lda_ + kk_ + scv * 8); \
    _Pragma("unroll") for (int i_ = 0; i_ < 2; ++i_) rb[S][i_] = *(const u32x4*)(Bt + (size_t)(col0 + sr + i_ * 64) * K + k0_ + scv * 8); } while (0)
#define LWRITE(S, buf) do { bf16_t* sA_ = sbase + (buf) * BUF; bf16_t* sB_ = sA_ + 256 * PITCH; \
    _Pragma("unroll") for (int i_ = 0; i_ < 4; ++i_) *(u32x4*)(sA_ + (sr + i_ * 64) * PITCH + scv * 8) = ra[S][i_]; \
    _Pragma("unroll") for (int i_ = 0; i_ < 2; ++i_) *(u32x4*)(sB_ + (sr + i_ * 64) * PITCH + scv * 8) = rb[S][i_]; } while (0)
#define COMPUTE(buf) do { const bf16_t* sA_ = sbase + (buf) * BUF; const bf16_t* sB_ = sA_ + 256 * PITCH; \
    bf16x8 bfr[4]; \
    _Pragma("unroll") for (int n = 0; n < 4; ++n) bfr[n] = *(const bf16x8*)(sB_ + (wc * 64 + n * 16 + fr) * PITCH + fq * 8); \
    bf16x8 af[8]; \
    _Pragma("unroll") for (int m = 0; m < 8; ++m) af[m] = *(const bf16x8*)(sA_ + (wr * 128 + m * 16 + fr) * PITCH + fq * 8); \
    __builtin_amdgcn_s_setprio(1); \
    _Pragma("unroll") for (int m = 0; m < 8; ++m) { \
      _Pragma("unroll") for (int n = 0; n < 4; ++n) acc[m][n] = MFMA16(bfr[n], af[m], acc[m][n]); } \
    __builtin_amdgcn_s_setprio(0); } while (0)
  __syncthreads();
  {
    const int last = nk - 1;
    GLOAD(0, 0);
    __builtin_amdgcn_sched_barrier(0);
    GLOAD(1, 1);
    __builtin_amdgcn_sched_barrier(0);
    LWRITE(0, 0);
    __builtin_amdgcn_sched_barrier(0);
    GLOAD(0, (2 < last ? 2 : last));
    __builtin_amdgcn_sched_barrier(0);
    __syncthreads();
    for (int kt = 0; kt < nk; kt += 2) {
      LWRITE(1, 1);
      __builtin_amdgcn_sched_barrier(0);
      GLOAD(1, (kt + 3 < last ? kt + 3 : last));
      __builtin_amdgcn_sched_barrier(0);
      COMPUTE(0);
      __syncthreads();
      LWRITE(0, 0);
      __builtin_amdgcn_sched_barrier(0);
      GLOAD(0, (kt + 4 < last ? kt + 4 : last));
      __builtin_amdgcn_sched_barrier(0);
      COMPUTE(1);
      __syncthreads();
    }
  }
#undef GLOAD
#undef LWRITE
#undef COMPUTE
#pragma unroll
  for (int m = 0; m < 8; ++m)
#pragma unroll
    for (int n = 0; n < 4; ++n) epi(row0 + wr * 128 + m * 16 + fr, col0 + wc * 64 + n * 16 + fq * 4, acc[m][n]);
}

DI void st_bf16x4(bf16_t* o, f32x4 v) { u32x2 q; q.x = pack2(v[0], v[1]); q.y = pack2(v[2], v[3]); *(u32x2*)o = q; }

struct EpiSplit {
  bf16_t* o0; int ld0, n0; bf16_t* o1; int ld1, n1;
  DI void operator()(int row, int col, f32x4 v) const {
    if (col < n0) st_bf16x4(o0 + (size_t)row * ld0 + col, v);
    else { const int c = col - n0; if (c < n1) st_bf16x4(o1 + (size_t)row * ld1 + c, v); }
  }
};
struct EpiSmall { int mode; const float* b0; bf16_t* o;
  DI void operator()(int row, int col, f32x4 v) const { f32x4 r;
    if (mode == 2) r = v; else { for (int j = 0; j < 4; ++j) r[j] = sigmoidf_(b0[col + j] + v[j]); if (mode == 0) r *= 0.60653066f; }
    st_bf16x4(o + (size_t)row * 512 + col, r); } };
struct EpiStore { bf16_t* o; int ld;
  DI void operator()(int row, int col, f32x4 v) const { st_bf16x4(o + (size_t)row * ld + col, v); } };
struct EpiResid { const float* res; float* o;
  DI void operator()(int row, int col, f32x4 v) const { const f32x4 r = *(const f32x4*)(res + (size_t)row * 1024 + col); *(f32x4*)(o + (size_t)row * 1024 + col) = r + v; } };
struct EpiRelu2 { bf16_t* o;
  DI void operator()(int row, int col, f32x4 v) const { f32x4 r; for (int j = 0; j < 4; ++j) { const float t = fmaxf(v[j], 0.f); r[j] = t * t; } st_bf16x4(o + (size_t)row * 4096 + col, r); } };
struct EpiGlu { const bf16_t* y; const float* b; bf16_t* o;
  DI void operator()(int row, int col, f32x4 v) const { const u32x2 q = *(const u32x2*)(y + (size_t)row * 512 + col); f32x4 r;
    const float y0 = __uint_as_float(q.x << 16), y1 = __uint_as_float(q.x & 0xffff0000u), y2 = __uint_as_float(q.y << 16), y3 = __uint_as_float(q.y & 0xffff0000u);
    r[0] = y0 * sigmoidf_(v[0] + b[col]); r[1] = y1 * sigmoidf_(v[1] + b[col + 1]); r[2] = y2 * sigmoidf_(v[2] + b[col + 2]); r[3] = y3 * sigmoidf_(v[3] + b[col + 3]);
    st_bf16x4(o + (size_t)row * 512 + col, r); } };

template <class Epi>
DI void gemm_phase(char* smem, const bf16_t* A0, int lda0, int ksplit, const bf16_t* A1, int lda1, const bf16_t* Bt, int K, int nN, const Epi& epi, int tid) {
  const int G = gridDim.x;
  if ((G & 7) == 0) {
    const int x = blockIdx.x & 7, l = blockIdx.x >> 3, L = G >> 3, per = 8 * nN, tot = 2 * per;
    for (int q = l; q < tot; q += L) { const int rgl = q / per, rem = q % per, ct = rem >> 3, rt = (x * 2 + rgl) * 8 + (rem & 7);
      gemm_tile(smem, A0, lda0, ksplit, A1, lda1, Bt, K, rt * 256, ct * 128, epi, tid); }
  } else {
    const int ntiles = (NTOK / 256) * nN;
    for (int u = blockIdx.x; u < ntiles; u += G) { const int rt = u / nN, ct = u % nN; gemm_tile(smem, A0, lda0, ksplit, A1, lda1, Bt, K, rt * 256, ct * 128, epi, tid); }
  }
}

DI void phase_rw_shift(const Ctx& c) {
  const Params& p = c.p; (void)p;
  const bf16_t* raw = (const bf16_t*)(p.ws + OFF_R1);
  bf16_t* rkv = (bf16_t*)(p.ws + OFF_RKV); bf16_t* sm = (bf16_t*)(p.ws + OFF_SM);
  const float* mu = p.rw_mu;
  const int gtid = blockIdx.x * 256 + TIDX, gstride = gridDim.x * 256;
  for (int u = gtid; u < (NTOK / 4) * 224; u += gstride) {
    const int tq = u / 224, cv = u - tq * 224, col = cv * 8, tok0 = tq * 4, s0 = tok0 & (SEQ - 1);
    const bf16_t* rp = raw + (size_t)tok0 * 1792 + col;
    u32x4 R[6];
#pragma unroll
    for (int j = 0; j < 6; ++j) { const int sj = s0 - 1 + j; R[j] = (sj >= 0 && sj < SEQ) ? ld8(rp + (j - 1) * 1792) : (u32x4){0u, 0u, 0u, 0u}; }
    float m0[8], m1[8];
#pragma unroll
    for (int j = 0; j < 8; ++j) { m0[j] = mu[col + j]; m1[j] = mu[1792 + col + j]; }
#pragma unroll
    for (int i = 0; i < 4; ++i) {
      float prv[8], cur[8], nxt[8], o[8];
      unpack8(R[i], prv); unpack8(R[i + 1], cur); unpack8(R[i + 2], nxt);
#pragma unroll
      for (int j = 0; j < 8; ++j) o[j] = cur[j] + m0[j] * (prv[j] - cur[j]) + m1[j] * (nxt[j] - cur[j]);
      const size_t tok = (size_t)tok0 + i;
      if (col < 1536) *(u32x4*)(rkv + tok * 1536 + col) = pack8(o);
      else if (col < 1600) { for (int j = 0; j < 8; ++j) o[j] = tanhf(o[j]); *(u32x4*)(sm + tok * 256 + (col - 1536)) = pack8(o); }
      else if (col < 1664) *(u32x4*)(sm + tok * 256 + 64 + (col - 1600)) = pack8(o);
      else { for (int j = 0; j < 8; ++j) o[j] = sigmoidf_(o[j]); *(u32x4*)(sm + tok * 256 + 128 + (col - 1664)) = pack8(o); }
    }
  }
  const bf16_t* mraw = (const bf16_t*)(p.ws + OFF_R2); bf16_t* BC = (bf16_t*)(p.ws + OFF_XN + 32 * MiB);
  const float* cw = p.mb_conv_w; const float* cb = p.mb_conv_b;
  for (int u = gtid; u < (NTOK / 4) * 64; u += gstride) {
    const int tq = u >> 6, cv = u & 63, xc = 1024 + cv * 8, tok0 = tq * 4, s0 = tok0 & (SEQ - 1);
    const bf16_t* rp = mraw + (size_t)tok0 * 2592 + 1024 + xc;
    u32x4 R[6];
#pragma unroll
    for (int j = 0; j < 6; ++j) { const int sj = s0 - 1 + j; R[j] = (sj >= 0 && sj < SEQ) ? ld8(rp + (j - 1) * 2592) : (u32x4){0u, 0u, 0u, 0u}; }
    float w0[8], w1[8], w2[8], bb[8];
#pragma unroll
    for (int j = 0; j < 8; ++j) { w0[j] = cw[xc + j]; w1[j] = cw[1536 + xc + j]; w2[j] = cw[3072 + xc + j]; bb[j] = cb[xc + j]; }
#pragma unroll
    for (int i = 0; i < 4; ++i) {
      float prv[8], cur[8], nxt[8], o[8];
      unpack8(R[i], prv); unpack8(R[i + 1], cur); unpack8(R[i + 2], nxt);
#pragma unroll
      for (int j = 0; j < 8; ++j) o[j] = siluf_(bb[j] + w0[j] * prv[j] + w1[j] * cur[j] + w2[j] * nxt[j]);
      *(u32x4*)(BC + ((size_t)tok0 + i) * 512 + cv * 8) = pack8(o);
    }
  }
}

DI void phase_rw_small_gemms(const Ctx& c, char* smem) {
  const Params& p = c.p; (void)p;
  const int tid = TIDX;
  const bf16_t* sm = (const bf16_t*)(p.ws + OFF_SM);
  bf16_t* E0 = (bf16_t*)(p.ws + OFF_R1); bf16_t* E1 = E0 + (size_t)NTOK * 512; bf16_t* Ab = E1 + (size_t)NTOK * 512;
  bf16_t* G = (bf16_t*)(p.ws + OFF_XN);
  const bf16_t* W2 = (const bf16_t*)(p.ws + OFF_WW2); const bf16_t* A2 = (const bf16_t*)(p.ws + OFF_WA2); const bf16_t* G2 = (const bf16_t*)(p.ws + OFF_WG2);
  gemm_phase(smem, sm, 256, 1 << 30, sm, 256, W2, 64, 4, EpiSmall{0, p.rw_w0, E0}, tid);
  gemm_phase(smem, sm, 256, 1 << 30, sm, 256, W2 + 512 * 64, 64, 4, EpiSmall{0, p.rw_w0 + 512, E1}, tid);
  gemm_phase(smem, sm + 64, 256, 1 << 30, sm, 256, A2, 64, 4, EpiSmall{1, p.rw_a0, Ab}, tid);
  gemm_phase(smem, sm + 128, 256, 1 << 30, sm, 256, G2, 128, 4, EpiSmall{2, p.rw_a0, G}, tid);
}

typedef float f32x2 __attribute__((ext_vector_type(2)));
DI void rwkv_item(const Ctx& c, int item, char* smem) {
  const Params& p = c.p; (void)p;
  constexpr int T = 32;
  const int dir = item >> 7, b = (item >> 3) & 15, h = item & 7;
  const int tid = TIDX, lane = tid & 63, wave = tid >> 6, rp = tid >> 3, kq = tid & 7;
  float* op = (float*)smem;
  float* yo = op + T * 6 * 64;
  const bf16_t* RKV = (const bf16_t*)(p.ws + OFF_RKV);
  bf16_t* E0 = (bf16_t*)(p.ws + OFF_R1); bf16_t* Ed = E0 + (size_t)dir * NTOK * 512; const bf16_t* Ab = E0 + (size_t)2 * NTOK * 512;
  const float kkw = p.rw_k_k[h * 64 + lane], kaw = p.rw_k_a[h * 64 + lane];
  f32x2 S0[4], S1[4];
#pragma unroll
  for (int j = 0; j < 4; ++j) { S0[j] = (f32x2){0.f, 0.f}; S1[j] = (f32x2){0.f, 0.f}; }
  bf16_t pr[8], pk[8], pv[8], pa[8], pe[8];
#define RW_PREFETCH(c0_) do { _Pragma("unroll") for (int i = 0; i < 8; ++i) { const int st_ = (c0_) + wave * 8 + i, t_ = dir ? (SEQ - 1 - st_) : st_; const size_t tok_ = (size_t)b * SEQ + t_; \
    pr[i] = RKV[tok_ * 1536 + h * 64 + lane]; pk[i] = RKV[tok_ * 1536 + 512 + h * 64 + lane]; pv[i] = RKV[tok_ * 1536 + 1024 + h * 64 + lane]; \
    pa[i] = Ab[tok_ * 512 + h * 64 + lane]; pe[i] = Ed[tok_ * 512 + h * 64 + lane]; } } while (0)
  RW_PREFETCH(0);
  for (int c0 = 0; c0 < SEQ; c0 += T) {
    __syncthreads();
#pragma unroll
    for (int i = 0; i < 8; ++i) {
      const int s = wave * 8 + i;
      const float r = bf2f(pr[i]), k = bf2f(pk[i]), v = bf2f(pv[i]), a = bf2f(pa[i]), e = bf2f(pe[i]);
      float kk = k * kkw; const float ss = wave_sum(kk * kk); kk *= rsqrtf(fmaxf(ss, 1e-12f));
      float* o = op + s * 384;
      o[lane] = __expf(-e); o[64 + lane] = k * (1.0f + (a - 1.0f) * kaw); o[128 + lane] = -kk; o[192 + lane] = kk * a; o[256 + lane] = r; o[320 + lane] = v;
    }
    __syncthreads();
    if (c0 + T < SEQ) RW_PREFETCH(c0 + T);
#pragma unroll 4
    for (int s = 0; s < T; ++s) {
      const float* o = op + s * 384 + kq * 8;
      const f32x4 a0 = *(const f32x4*)(o + 128), a1 = *(const f32x4*)(o + 132);
      const f32x2 av[4] = {(f32x2){a0[0], a0[1]}, (f32x2){a0[2], a0[3]}, (f32x2){a1[0], a1[1]}, (f32x2){a1[2], a1[3]}};
      f32x2 t0 = S0[0] * av[0], t1 = S1[0] * av[0];
#pragma unroll
      for (int j = 1; j < 4; ++j) { t0 += S0[j] * av[j]; t1 += S1[j] * av[j]; }
      float sa0 = t0[0] + t0[1], sa1 = t1[0] + t1[1];
      sa0 = sum8(sa0); sa1 = sum8(sa1);
      const f32x2 vv = *(const f32x2*)(op + s * 384 + 320 + rp * 2);
      const f32x4 w0 = *(const f32x4*)(o), w1 = *(const f32x4*)(o + 4), k0 = *(const f32x4*)(o + 64), k1 = *(const f32x4*)(o + 68);
      const f32x4 b0 = *(const f32x4*)(o + 192), b1 = *(const f32x4*)(o + 196), r0 = *(const f32x4*)(o + 256), r1 = *(const f32x4*)(o + 260);
      const f32x2 wv[4] = {(f32x2){w0[0], w0[1]}, (f32x2){w0[2], w0[3]}, (f32x2){w1[0], w1[1]}, (f32x2){w1[2], w1[3]}};
      const f32x2 kv[4] = {(f32x2){k0[0], k0[1]}, (f32x2){k0[2], k0[3]}, (f32x2){k1[0], k1[1]}, (f32x2){k1[2], k1[3]}};
      const f32x2 bv[4] = {(f32x2){b0[0], b0[1]}, (f32x2){b0[2], b0[3]}, (f32x2){b1[0], b1[1]}, (f32x2){b1[2], b1[3]}};
      const f32x2 rv[4] = {(f32x2){r0[0], r0[1]}, (f32x2){r0[2], r0[3]}, (f32x2){r1[0], r1[1]}, (f32x2){r1[2], r1[3]}};
      f32x2 y0 = (f32x2){0.f, 0.f}, y1 = (f32x2){0.f, 0.f};
#pragma unroll
      for (int j = 0; j < 4; ++j) {
        S0[j] = S0[j] * wv[j] + bv[j] * sa0 + kv[j] * vv[0];
        S1[j] = S1[j] * wv[j] + bv[j] * sa1 + kv[j] * vv[1];
        y0 += S0[j] * rv[j]; y1 += S1[j] * rv[j];
      }
      float ya = y0[0] + y0[1], yb = y1[0] + y1[1];
      ya = sum8(ya); yb = sum8(yb);
      if (kq == 0) *(f32x2*)(yo + s * 64 + rp * 2) = (f32x2){ya, yb};
    }
    __syncthreads();
#pragma unroll
    for (int i = 0; i < 8; ++i) { const int idx = tid + i * 256, s = idx >> 6, kx = idx & 63, st = c0 + s, t = dir ? (SEQ - 1 - st) : st; Ed[((size_t)b * SEQ + t) * 512 + h * 64 + kx] = f2bf(yo[idx]); }
  }
#undef RW_PREFETCH
}

template <int DV>
struct Gla {
  static constexpr int NVB = DV / 16, QP = 136, VP = DV + 8, MP = QP;
  static constexpr int BYTES = (64 * QP * 2 + 64 * VP + DV * QP) * 2 + 6 * 64 * 4;
  char* sm;
  DI bf16_t* Qs() const { return (bf16_t*)sm; }
  DI bf16_t* Ks() const { return (bf16_t*)sm + 64 * QP; }
  DI bf16_t* Vs() const { return (bf16_t*)sm + 128 * QP; }
  DI bf16_t* St() const { return (bf16_t*)sm + 128 * QP + 64 * VP; }
  DI bf16_t* Ms() const { return (bf16_t*)sm; }
  DI float* P() const { return (float*)((bf16_t*)sm + 128 * QP + 64 * VP + DV * QP); }
  DI float* Qv() const { return P() + 64; }
  DI float* I() const { return P() + 128; }
  DI float* Wl() const { return P() + 192; }
  DI float* Mt() const { return P() + 256; }
  DI float* gl() const { return P() + 320; }
  f32x4 acc[NVB][2];
  int lane, w, fr, fq;
  DI void init(char* smem, int tid_) {
    sm = smem;
    lane = tid_ & 63; w = tid_ >> 6; fr = lane & 15; fq = lane >> 4;
    for (int i = tid_; i < DV * QP / 2; i += 256) ((unsigned*)St())[i] = 0u;
#pragma unroll
    for (int vb = 0; vb < NVB; ++vb) { acc[vb][0] = (f32x4){0.f, 0.f, 0.f, 0.f}; acc[vb][1] = (f32x4){0.f, 0.f, 0.f, 0.f}; }
  }
  DI bf16x8 gather(const bf16_t* base, int pitch, int r0, int col) const { bf16x8 r;
#pragma unroll
    for (int jj = 0; jj < 8; ++jj) r[jj] = (short)base[(r0 + jj) * pitch + col];
    return r; }
  DI void compute_y(f32x4 (&y)[NVB]) {
    bf16x8 qa[4];
#pragma unroll
    for (int ks = 0; ks < 4; ++ks) qa[ks] = *(const bf16x8*)(Qs() + (w * 16 + fr) * QP + ks * 32 + fq * 8);
#pragma unroll
    for (int nb = 0; nb < 4; ++nb) {
      f32x4 g = (f32x4){0.f, 0.f, 0.f, 0.f};
      if (nb <= w) {
#pragma unroll
        for (int ks = 0; ks < 4; ++ks) { const bf16x8 kb = *(const bf16x8*)(Ks() + (nb * 16 + fr) * QP + ks * 32 + fq * 8); g = MFMA16(qa[ks], kb, g); }
      }
      const int s = nb * 16 + fr; const float qs = Qv()[s];
#pragma unroll
      for (int j = 0; j < 4; ++j) { const int t = w * 16 + fq * 4 + j; const float m = (s <= t) ? g[j] * __expf(P()[t] - qs) : 0.f; Ms()[t * MP + s] = f2bf(m); }
    }
    __syncthreads();
#pragma unroll
    for (int vb = 0; vb < NVB; ++vb) y[vb] = (f32x4){0.f, 0.f, 0.f, 0.f};
#pragma unroll
    for (int ks = 0; ks < 4; ++ks)
      {
#pragma unroll
        for (int vb = 0; vb < NVB; ++vb) { const bf16x8 sb = *(const bf16x8*)(St() + (vb * 16 + fr) * QP + ks * 32 + fq * 8); y[vb] = MFMA16(qa[ks], sb, y[vb]); } __builtin_amdgcn_sched_barrier(0); }
    float sc[4];
#pragma unroll
    for (int j = 0; j < 4; ++j) sc[j] = __expf(I()[w * 16 + fq * 4 + j]);
#pragma unroll
    for (int vb = 0; vb < NVB; ++vb)
#pragma unroll
      for (int j = 0; j < 4; ++j) y[vb][j] *= sc[j];
#pragma unroll
    for (int k2 = 0; k2 < 2; ++k2) {
      if (k2 * 32 <= w * 16 + 15) {
        const bf16x8 ma = *(const bf16x8*)(Ms() + (w * 16 + fr) * MP + k2 * 32 + fq * 8);
#pragma unroll
        for (int vb = 0; vb < NVB; ++vb) { const bf16x8 vf = gather(Vs(), VP, k2 * 32 + fq * 8, vb * 16 + fr); y[vb] = MFMA16(ma, vf, y[vb]); __builtin_amdgcn_sched_barrier(0); }
      }
    }
  }
  DI void update() {
    __syncthreads();
    const float g = __expf(gl()[0]);
#pragma unroll
    for (int vb = 0; vb < NVB; ++vb) { acc[vb][0] *= g; acc[vb][1] *= g; }
#pragma unroll
    for (int k2 = 0; k2 < 2; ++k2) {
      const int s0 = k2 * 32 + fq * 8;
      float wsc[8];
#pragma unroll
      for (int jj = 0; jj < 8; ++jj) wsc[jj] = __expf(Wl()[s0 + jj]);
      const bf16x8 kb0 = gather(Ks(), QP, s0, (2 * w) * 16 + fr), kb1 = gather(Ks(), QP, s0, (2 * w + 1) * 16 + fr);
#pragma unroll
      for (int vb = 0; vb < NVB; ++vb) {
        bf16x8 va;
#pragma unroll
        for (int jj = 0; jj < 8; ++jj) va[jj] = (short)f2bf(bf2f(Vs()[(s0 + jj) * VP + vb * 16 + fr]) * wsc[jj]);
        acc[vb][0] = MFMA16(va, kb0, acc[vb][0]); acc[vb][1] = MFMA16(va, kb1, acc[vb][1]);
        __builtin_amdgcn_sched_barrier(0);
      }
    }
#pragma unroll
    for (int vb = 0; vb < NVB; ++vb)
#pragma unroll
      for (int nn = 0; nn < 2; ++nn)
#pragma unroll
        for (int j = 0; j < 4; ++j) St()[(vb * 16 + fq * 4 + j) * QP + (2 * w + nn) * 16 + fr] = f2bf(acc[vb][nn][j]);
    __syncthreads();
  }
};

DI void mamba_item(const Ctx& c, int item, char* smem) {
  const Params& p = c.p; (void)p;
  const int dir = item >> 8, b = (item >> 4) & 15, head = item & 15, gq = head >> 3;
  const int tid = TIDX;
  Gla<64> G; G.init(smem, tid);
  const bf16_t* raw = (const bf16_t*)(p.ws + OFF_R2);
  const bf16_t* BC = (const bf16_t*)(p.ws + OFF_XN + 32 * MiB);
  bf16_t* Y = (bf16_t*)p.out + (size_t)dir * NTOK * 1024;
  const float Aneg = -expf(p.mb_A_log[dir * 16 + head]), dtb = p.mb_dt_bias[dir * 16 + head];
  const int cvi = tid & 7, tg = tid >> 3, xc = head * 64 + cvi * 8;
  u32x4 px[4]; bf16_t pdt[2] = {0, 0}; bf16_t pdts = 0;
#define MB_LOADBC(c_) do { \
    _Pragma("unroll") for (int i = 0; i < 8; ++i) { const int v_ = tid + i * 256, s_ = v_ >> 5, cv_ = v_ & 31, st_ = (c_) * 64 + s_, t_ = dir ? (SEQ - 1 - st_) : st_; \
      pbc[i] = ld8(BC + ((size_t)b * SEQ + t_) * 512 + (cv_ < 16 ? 256 + gq * 128 + cv_ * 8 : gq * 128 + (cv_ - 16) * 8)); } } while (0)
#define MB_PREFETCH(c_) do { \
    { const int tb_ = dir ? (SEQ - 1 - ((c_) * 64 + tg * 2 + 1)) : ((c_) * 64 + tg * 2); \
      _Pragma("unroll") for (int j = 0; j < 4; ++j) { const int t_ = tb_ - 1 + j; px[j] = (t_ >= 0 && t_ < SEQ) ? ld8(raw + ((size_t)b * SEQ + t_) * 2592 + 1024 + xc) : (u32x4){0u, 0u, 0u, 0u}; } \
      pdt[0] = raw[((size_t)b * SEQ + tb_) * 2592 + 2560 + dir * 16 + head]; pdt[1] = raw[((size_t)b * SEQ + tb_ + 1) * 2592 + 2560 + dir * 16 + head]; } \
    if (tid < 64) { const int st_ = (c_) * 64 + tid, t_ = dir ? (SEQ - 1 - st_) : st_; pdts = raw[((size_t)b * SEQ + t_) * 2592 + 2560 + dir * 16 + head]; } } while (0)
  MB_PREFETCH(0);
  for (int c = 0; c < SEQ / 64; ++c) {
    u32x4 pbc[8];
    MB_LOADBC(c);
    { asm volatile("" ::: "memory");
      float cw0[8], cw1[8], cw2[8], cbv[8];
#pragma unroll
      for (int j = 0; j < 8; ++j) { cw0[j] = p.mb_conv_w[xc + j]; cw1[j] = p.mb_conv_w[1536 + xc + j]; cw2[j] = p.mb_conv_w[3072 + xc + j]; cbv[j] = p.mb_conv_b[xc + j]; }
      float R[4][8];
#pragma unroll
      for (int j = 0; j < 4; ++j) unpack8(px[j], R[j]);
#pragma unroll
      for (int i = 0; i < 2; ++i) {
        const int pi = dir ? (1 - i) : i;
        const float dt = softplusf_(bf2f(pdt[dir ? (1 - i) : i]) + dtb);
        float o[8];
#pragma unroll
        for (int j = 0; j < 8; ++j) o[j] = dt * siluf_(cbv[j] + cw0[j] * R[pi][j] + cw1[j] * R[pi + 1][j] + cw2[j] * R[pi + 2][j]);
        *(u32x4*)(G.Vs() + (tg * 2 + i) * G.VP + cvi * 8) = pack8(o);
      } }
    if (tid < 64) {
      const int s = tid;
      const float dt = softplusf_(bf2f(pdts) + dtb);
      const float cs = wave_incl_sum(dt * Aneg, s); const float csl = __shfl(cs, 63);
      G.P()[s] = cs; G.Qv()[s] = cs; G.I()[s] = cs; G.Wl()[s] = csl - cs; if (s == 0) G.gl()[0] = csl;
    }
#pragma unroll
    for (int i = 0; i < 8; ++i) { const int v = tid + i * 256, s = v >> 5, cv = v & 31; *(u32x4*)((cv < 16 ? G.Qs() : G.Ks()) + s * G.QP + (cv & 15) * 8) = pbc[i]; }
    if (c + 1 < SEQ / 64) MB_PREFETCH(c + 1);
    __syncthreads();
    f32x4 y[4];
    G.compute_y(y);
#pragma unroll
    for (int vb = 0; vb < 4; ++vb)
#pragma unroll
      for (int j = 0; j < 4; ++j) { const int s = G.w * 16 + G.fq * 4 + j, st = c * 64 + s, t = dir ? (SEQ - 1 - st) : st; Y[((size_t)b * SEQ + t) * 1024 + head * 64 + vb * 16 + G.fr] = f2bf(y[vb][j]); }
    G.update();
  }
#undef MB_PREFETCH
#undef MB_LOADBC
}

DI void mlstm_item(const Ctx& c, int item, char* smem) {
  const Params& p = c.p; (void)p;
  const int half = item & 1, head = (item >> 1) & 7, b = (item >> 4) & 15, dir = item >> 8;
  const int tid = TIDX;
  Gla<80> G; G.init(smem, tid);
  float* Wl_ = (float*)(smem + Gla<80>::BYTES);
  for (int i = tid; i < 128; i += 256) { const int ch = head * 128 + i, li = (i >> 3) * 12 + (i & 7); Wl_[li] = p.ml_conv_w[ch]; Wl_[192 + li] = p.ml_conv_w[1024 + ch]; Wl_[384 + li] = p.ml_conv_w[2048 + ch]; Wl_[576 + li] = p.ml_conv_b[ch]; }
  for (int i = tid; i < 512; i += 256) { const int li = (i >> 5) * 36 + (i & 31); Wl_[768 + li] = p.ml_wq[head * 512 + i]; Wl_[768 + 576 + li] = p.ml_wk[head * 512 + i] * 0.08838834764831845f; Wl_[768 + 1152 + li] = p.ml_wv[head * 512 + i]; }
  if (tid < 64) { for (int j = 0; j < 16; ++j) G.Vs()[tid * G.VP + 64 + j] = (j == 0) ? (bf16_t)0x3f80 : (bf16_t)0; }
  const bf16_t* raw = (const bf16_t*)(p.ws + OFF_MLRAW);
  bf16_t* H = (bf16_t*)(p.ws + OFF_HFB) + (size_t)dir * NTOK * 1024;
  const float ib = p.ml_i_b[dir * 8 + head], fb = p.ml_f_b[dir * 8 + head];
  const int cvi = tid & 15, tg = tid >> 4, ch = head * 128 + cvi * 8;
  float mprev = 0.f;
  u32x4 px[6]; bf16_t pgi = 0, pgf = 0;
#define ML_PREFETCH(c_) do { const int tb_ = dir ? (SEQ - 1 - ((c_) * 64 + tg * 4 + 3)) : ((c_) * 64 + tg * 4); \
    _Pragma("unroll") for (int j = 0; j < 6; ++j) { const int t_ = tb_ - 1 + j; px[j] = (t_ >= 0 && t_ < SEQ) ? ld8(raw + ((size_t)b * SEQ + t_) * 2080 + ch) : (u32x4){0u, 0u, 0u, 0u}; } \
    if (tid < 64) { const int st_ = (c_) * 64 + tid, t_ = dir ? (SEQ - 1 - st_) : st_; const size_t tok_ = (size_t)b * SEQ + t_; pgi = raw[tok_ * 2080 + 2048 + dir * 8 + head]; pgf = raw[tok_ * 2080 + 2064 + dir * 8 + head]; } } while (0)
  ML_PREFETCH(0);
  __syncthreads();
  for (int c = 0; c < SEQ / 64; ++c) {
    {
#pragma unroll
      for (int i = 0; i < 4; ++i) {
        float prv[8], cur[8], nxt[8];
        { const u32x4 a = dir ? px[3 - i] : px[i], bq = dir ? px[4 - i] : px[i + 1], cq = dir ? px[5 - i] : px[i + 2]; unpack8(a, prv); unpack8(bq, cur); unpack8(cq, nxt); }
        float xcv[8], q[8], k[8], v[8];
#pragma unroll
        for (int j4 = 0; j4 < 2; ++j4) {
          const f32x4 w0 = *(const f32x4*)(Wl_ + cvi * 12 + j4 * 4), w1 = *(const f32x4*)(Wl_ + 192 + cvi * 12 + j4 * 4), w2 = *(const f32x4*)(Wl_ + 384 + cvi * 12 + j4 * 4), bb = *(const f32x4*)(Wl_ + 576 + cvi * 12 + j4 * 4);
#pragma unroll
          for (int j = 0; j < 4; ++j) xcv[j4 * 4 + j] = siluf_(bb[j] + w0[j] * prv[j4 * 4 + j] + w1[j] * cur[j4 * 4 + j] + w2[j] * nxt[j4 * 4 + j]);
        }
#pragma unroll
        for (int bl = 0; bl < 2; ++bl) {
          f32x4 aq = (f32x4){0.f, 0.f, 0.f, 0.f}, ak = aq, av = aq;
#pragma unroll
          for (int cc = 0; cc < 4; ++cc) {
            const int wi = cvi * 36 + bl * 16 + cc * 4;
            aq += *(const f32x4*)(Wl_ + 768 + wi) * xcv[bl * 4 + cc]; ak += *(const f32x4*)(Wl_ + 768 + 576 + wi) * xcv[bl * 4 + cc]; av += *(const f32x4*)(Wl_ + 768 + 1152 + wi) * cur[bl * 4 + cc];
          }
#pragma unroll
          for (int d = 0; d < 4; ++d) { q[bl * 4 + d] = aq[d]; k[bl * 4 + d] = ak[d]; v[bl * 4 + d] = av[d]; }
        }
        const int s = tg * 4 + i;
        *(u32x4*)(G.Qs() + s * G.QP + cvi * 8) = pack8(q);
        *(u32x4*)(G.Ks() + s * G.QP + cvi * 8) = pack8(k);
        if ((cvi >> 3) == half) *(u32x4*)(G.Vs() + s * G.VP + (cvi & 7) * 8) = pack8(v);
        __builtin_amdgcn_sched_barrier(0);
      } }
    if (tid < 64) {
      const int s = tid;
      const float li = bf2f(pgi) + ib;
      const float fx = bf2f(pgf) + fb;
      const float lf = fminf(fx, 0.f) - __logf(1.0f + __expf(-fabsf(fx)));
      const float bc = wave_incl_sum(lf, s);
      const float cc = li - bc;
      const float pm = fmaxf(wave_incl_max(cc, s), mprev);
      const float pml = __shfl(pm, 63), bl = __shfl(bc, 63);
      G.P()[s] = -pm; G.Qv()[s] = -cc; G.I()[s] = mprev - pm; G.Wl()[s] = cc - pml; G.Mt()[s] = bc + pm; if (s == 0) G.gl()[0] = mprev - pml;
      mprev = bl + pml;
    }
    if (c + 1 < SEQ / 64) ML_PREFETCH(c + 1);
    __syncthreads();
    f32x4 y[5];
    G.compute_y(y);
#pragma unroll
    for (int j = 0; j < 4; ++j) {
      const float den = __shfl(y[4][j], G.lane & 48);
      const int s = G.w * 16 + G.fq * 4 + j, st = c * 64 + s, t = dir ? (SEQ - 1 - st) : st;
      const float dn = 1.0f / fmaxf(fabsf(den), __expf(-G.Mt()[s]));
#pragma unroll
      for (int vb = 0; vb < 4; ++vb) H[((size_t)b * SEQ + t) * 1024 + head * 128 + half * 64 + vb * 16 + G.fr] = f2bf(y[vb][j] * dn);
    }
    G.update();
  }
#undef ML_PREFETCH
}

DI void s5_item(const Ctx& c, int item, char* smem) {
  const Params& p = c.p; (void)p;
  constexpr int T = 16, XP = 136, BP = 132;
  const int dir = item >> 7, b = (item >> 3) & 15, gq = item & 7;
  const int tid = TIDX, lane = tid & 63, wave = tid >> 6, fr = lane & 15, fq = lane >> 4;
  const int g = gq * 4 + wave;
  float* BUw = (float*)smem + wave * (T * BP);
  bf16_t* Xw = (bf16_t*)(smem + 4 * T * BP * 4) + wave * (T * XP);
  const bf16_t* U = (const bf16_t*)(p.ws + OFF_S5U);
  bf16_t* Y = (bf16_t*)(p.ws + OFF_S5Y) + (size_t)dir * NTOK * 512;
  const float dtv = expf(p.s5_log_dt[dir * 32 + g]);
  float abr, abi;
  { const float ar = fminf(p.s5_A_re[(dir * 32 + g) * 64 + lane], -1e-4f), ai = p.s5_A_im[(dir * 32 + g) * 64 + lane];
    const float mag = expf(dtv * ar); abr = mag * cosf(dtv * ai); abi = mag * sinf(dtv * ai); }
  bf16x8 bf_[8];
#pragma unroll
  for (int q = 0; q < 4; ++q) {
    const int pp = q * 16 + fr;
    const float ar = fminf(p.s5_A_re[(dir * 32 + g) * 64 + pp], -1e-4f), ai = p.s5_A_im[(dir * 32 + g) * 64 + pp];
    const float mag = expf(dtv * ar), br_ = mag * cosf(dtv * ai), bi_ = mag * sinf(dtv * ai), den = ar * ar + ai * ai;
    const float f_r = ((br_ - 1.0f) * ar + bi_ * ai) / den, f_i = (bi_ * ar - (br_ - 1.0f) * ai) / den;
    float vr[8], vi[8];
#pragma unroll
    for (int jj = 0; jj < 8; ++jj) {
      float bre = 0.f, bim = 0.f;
      if (fq < 2) { bre = p.s5_B_re[(g * 64 + pp) * 16 + fq * 8 + jj]; bim = p.s5_B_im[(g * 64 + pp) * 16 + fq * 8 + jj]; }
      vr[jj] = f_r * bre - f_i * bim; vi[jj] = f_r * bim + f_i * bre;
    }
    bf_[q] = __builtin_bit_cast(bf16x8, pack8(vr)); bf_[4 + q] = __builtin_bit_cast(bf16x8, pack8(vi));
  }
  bf16x8 cf[4];
#pragma unroll
  for (int ks = 0; ks < 4; ++ks) {
    float cv[8];
#pragma unroll
    for (int jj = 0; jj < 8; ++jj) { const int k = ks * 32 + fq * 8 + jj; const size_t base = ((size_t)(dir * 32 + g) * 16 + fr) * 64; cv[jj] = k < 64 ? p.s5_C_re[base + k] : -p.s5_C_im[base + k - 64]; }
    cf[ks] = __builtin_bit_cast(bf16x8, pack8(cv));
  }
  float xr = 0.f, xi = 0.f;
  u32x4 pu;
#define S5_PREFETCH(c0_) do { const int st_ = (c0_) + fr, t_ = dir ? (SEQ - 1 - st_) : st_; \
    pu = (fq < 2) ? ld8(U + ((size_t)b * SEQ + t_) * 512 + g * 16 + fq * 8) : (u32x4){0u, 0u, 0u, 0u}; } while (0)
  S5_PREFETCH(0);
  for (int c0 = 0; c0 < SEQ; c0 += T) {
    const bf16x8 ua = __builtin_bit_cast(bf16x8, pu);
    if (c0 + T < SEQ) S5_PREFETCH(c0 + T);
    asm volatile("" ::: "memory");
#pragma unroll
    for (int nb = 0; nb < 8; ++nb) {
      f32x4 bu = MFMA16(ua, bf_[nb], ((f32x4){0.f, 0.f, 0.f, 0.f}));
#pragma unroll
      for (int j = 0; j < 4; ++j) BUw[(fq * 4 + j) * BP + nb * 16 + fr] = bu[j];
    }
    asm volatile("" ::: "memory");
#pragma unroll
    for (int s = 0; s < T; ++s) {
      const float bur = BUw[s * BP + lane], bui = BUw[s * BP + 64 + lane];
      const float nr = abr * xr - abi * xi + bur, ni = abr * xi + abi * xr + bui;
      xr = nr; xi = ni;
      const unsigned pk = pack2(xr, xi);
      Xw[s * XP + lane] = (bf16_t)(pk & 0xffffu); Xw[s * XP + 64 + lane] = (bf16_t)(pk >> 16);
    }
    asm volatile("" ::: "memory");
    f32x4 y = (f32x4){0.f, 0.f, 0.f, 0.f};
#pragma unroll
    for (int ks = 0; ks < 4; ++ks) { const bf16x8 xa = *(const bf16x8*)(Xw + fr * XP + ks * 32 + fq * 8); y = MFMA16(xa, cf[ks], y); }
#pragma unroll
    for (int j = 0; j < 4; ++j) { const int st = c0 + fq * 4 + j, t = dir ? (SEQ - 1 - st) : st; Y[((size_t)b * SEQ + t) * 512 + g * 16 + fr] = f2bf(y[j]); }
  }
#undef S5_PREFETCH
}

DI void phase_post0(const Ctx& c) {
  const Params& p = c.p; (void)p;
  const int lane = TIDX & 63, wid = TIDX >> 6;
  const int gw = blockIdx.x * 4 + wid, nw = gridDim.x * 4;
  {
    bf16_t* E0 = (bf16_t*)(p.ws + OFF_R1); const bf16_t* E1 = E0 + (size_t)NTOK * 512; const bf16_t* Ab = E1 + (size_t)NTOK * 512;
    const bf16_t* G = (const bf16_t*)(p.ws + OFF_XN); const bf16_t* RKV = (const bf16_t*)(p.ws + OFF_RKV);
    for (int tok = gw; tok < NTOK; tok += nw) {
      const int c = lane * 8;
      float y0[8], y1[8], r[8], k[8], v[8], a[8], g[8], o[8];
      unpack8(ld8(E0 + (size_t)tok * 512 + c), y0); unpack8(ld8(E1 + (size_t)tok * 512 + c), y1);
      unpack8(ld8(RKV + (size_t)tok * 1536 + c), r); unpack8(ld8(RKV + (size_t)tok * 1536 + 512 + c), k); unpack8(ld8(RKV + (size_t)tok * 1536 + 1024 + c), v);
      unpack8(ld8(Ab + (size_t)tok * 512 + c), a); unpack8(ld8(G + (size_t)tok * 512 + c), g);
      float sy = 0.f, sb = 0.f;
#pragma unroll
      for (int j = 0; j < 8; ++j) { y0[j] += y1[j]; sy += y0[j]; const float k2 = k[j] * (1.0f + (a[j] - 1.0f) * p.rw_k_a[c + j]); sb += r[j] * k2 * p.rw_r_k[c + j]; }
      const float mean = sum8(sy) * (1.0f / 64.0f); sb = sum8(sb);
      float sv = 0.f;
#pragma unroll
      for (int j = 0; j < 8; ++j) { y0[j] -= mean; sv += y0[j] * y0[j]; }
      const float rs = rsqrtf(sum8(sv) * (1.0f / 64.0f) + 64e-5f);
#pragma unroll
      for (int j = 0; j < 8; ++j) o[j] = (y0[j] * rs * p.rw_ln_w[c + j] + sb * v[j]) * g[j];
      *(u32x4*)(E0 + (size_t)tok * 512 + c) = pack8(o);
    }
  }
  {
    bf16_t* raw = (bf16_t*)(p.ws + OFF_R2);
    const bf16_t* Y0 = (const bf16_t*)p.out; const bf16_t* Y1 = Y0 + (size_t)NTOK * 1024;
    const float* cw = p.mb_conv_w; const float* cb = p.mb_conv_b;
    for (int u = gw; u < NTOK; u += nw) {
      const int tp = u >> 1, gq = u & 1, col = gq * 512 + lane * 8, head = col >> 6, tok0 = tp * 2, t0 = tok0 & (SEQ - 1);
      bf16_t* zp = raw + (size_t)tok0 * 2592 + col;
      const bf16_t* rp = zp + 1024;
      u32x4 R[4], Yq[2][2], Zq[2];
#pragma unroll
      for (int j = 0; j < 4; ++j) { const int tj = t0 - 1 + j; R[j] = (tj >= 0 && tj < SEQ) ? ld8(rp + (j - 1) * 2592) : (u32x4){0u, 0u, 0u, 0u}; }
#pragma unroll
      for (int i = 0; i < 2; ++i) { Yq[i][0] = ld8(Y0 + (size_t)(tok0 + i) * 1024 + col); Yq[i][1] = ld8(Y1 + (size_t)(tok0 + i) * 1024 + col); Zq[i] = ld8(zp + i * 2592); }
      float w0[8], w1[8], w2[8], bb[8], nw_[8];
#pragma unroll
      for (int j = 0; j < 8; ++j) { w0[j] = cw[col + j]; w1[j] = cw[1536 + col + j]; w2[j] = cw[3072 + col + j]; bb[j] = cb[col + j]; nw_[j] = p.mb_norm_w[col + j]; }
      const float D = p.mb_D[head];
#pragma unroll
      for (int i = 0; i < 2; ++i) {
        float y0[8], y1[8], z[8], cur[8], prv[8], nxt[8], o[8];
        unpack8(Yq[i][0], y0); unpack8(Yq[i][1], y1); unpack8(Zq[i], z); unpack8(R[i], prv); unpack8(R[i + 1], cur); unpack8(R[i + 2], nxt);
        float ss = 0.f;
#pragma unroll
        for (int j = 0; j < 8; ++j) { const float xs = siluf_(bb[j] + w0[j] * prv[j] + w1[j] * cur[j] + w2[j] * nxt[j]);
          const float yy = (y0[j] + y1[j] + D * xs) * siluf_(z[j]); o[j] = yy; ss += yy * yy; }
        ss = wave_sum(ss);
        const float rs = rsqrtf(ss * (1.0f / 512.0f) + 1e-5f);
#pragma unroll
        for (int j = 0; j < 8; ++j) o[j] = o[j] * rs * nw_[j];
        *(u32x4*)(zp + i * 2592) = pack8(o);
      }
    }
  }
}

DI float gelu_tanh(float x) { const float u = 0.7978845608028654f * (x + 0.044715f * x * x * x); return 0.5f * x * (1.0f + tanhf(u)); }

DI void phase_post1(const Ctx& c) {
  const Params& p = c.p; (void)p;
  const int lane = TIDX & 63, wid = TIDX >> 6;
  const int gw = blockIdx.x * 4 + wid, nw = gridDim.x * 4;
  {
    const bf16_t* U = (const bf16_t*)(p.ws + OFF_S5U); const bf16_t* Y0 = (const bf16_t*)(p.ws + OFF_S5Y); const bf16_t* Y1 = Y0 + (size_t)NTOK * 512;
    bf16_t* YG = (bf16_t*)(p.ws + OFF_YG);
    for (int tok = gw; tok < NTOK; tok += nw) {
      const int col = lane * 8; float u[8], a[8], c[8], o[8];
      unpack8(ld8(U + (size_t)tok * 512 + col), u); unpack8(ld8(Y0 + (size_t)tok * 512 + col), a); unpack8(ld8(Y1 + (size_t)tok * 512 + col), c);
#pragma unroll
      for (int j = 0; j < 8; ++j) o[j] = gelu_tanh(p.s5_D[col + j] * u[j] + a[j] + c[j]);
      *(u32x4*)(YG + (size_t)tok * 512 + col) = pack8(o);
    }
  }
  {
    bf16_t* raw = (bf16_t*)(p.ws + OFF_MLRAW);
    const bf16_t* HF = (const bf16_t*)(p.ws + OFF_HFB); const bf16_t* HB = HF + (size_t)NTOK * 1024;
    for (int u = gw; u < NTOK; u += nw) {
      const int tp = u >> 1, cc = (u & 1) * 512 + lane * 8, tok0 = tp * 2, t0 = tok0 & (SEQ - 1);
      bf16_t* xp = raw + (size_t)tok0 * 2080 + cc;
      u32x4 R[4], Hq[2][2], Oq[2];
#pragma unroll
      for (int j = 0; j < 4; ++j) { const int tj = t0 - 1 + j; R[j] = (tj >= 0 && tj < SEQ) ? ld8(xp + (j - 1) * 2080) : (u32x4){0u, 0u, 0u, 0u}; }
#pragma unroll
      for (int i = 0; i < 2; ++i) { Hq[i][0] = ld8(HF + (size_t)(tok0 + i) * 1024 + cc); Hq[i][1] = ld8(HB + (size_t)(tok0 + i) * 1024 + cc); Oq[i] = ld8(xp + i * 2080 + 1024); }
      float w0[8], w1[8], w2[8], bb[8], nw_[8], sk[8];
#pragma unroll
      for (int j = 0; j < 8; ++j) { w0[j] = p.ml_conv_w[cc + j]; w1[j] = p.ml_conv_w[1024 + cc + j]; w2[j] = p.ml_conv_w[2048 + cc + j]; bb[j] = p.ml_conv_b[cc + j]; nw_[j] = p.ml_norm_w[cc + j]; sk[j] = p.ml_skip[cc + j]; }
#pragma unroll
      for (int i = 0; i < 2; ++i) {
        float hf[8], hb[8], cur[8], prv[8], nxt[8], og[8], o[8];
        unpack8(Hq[i][0], hf); unpack8(Hq[i][1], hb); unpack8(R[i], prv); unpack8(R[i + 1], cur); unpack8(R[i + 2], nxt); unpack8(Oq[i], og);
        float sh = 0.f;
#pragma unroll
        for (int j = 0; j < 8; ++j) { hf[j] += hb[j]; sh += hf[j]; }
        sh = sum8(sh); sh += dpp_mov<0x140>(sh);
        const float mean = sh * (1.0f / 128.0f);
        float sv = 0.f;
#pragma unroll
        for (int j = 0; j < 8; ++j) { hf[j] -= mean; sv += hf[j] * hf[j]; }
        sv = sum8(sv); sv += dpp_mov<0x140>(sv);
        const float rs = rsqrtf(sv * (1.0f / 128.0f) + 1e-5f);
#pragma unroll
        for (int j = 0; j < 8; ++j) {
          const float xcv = siluf_(bb[j] + w0[j] * prv[j] + w1[j] * cur[j] + w2[j] * nxt[j]);
          o[j] = sigmoidf_(og[j]) * (hf[j] * rs * nw_[j]) + sk[j] * xcv;
        }
        *(u32x4*)(xp + i * 2080 + 1024) = pack8(o);
      }
    }
  }
}

DI void phase_final(const Ctx& c) {
  const Params& p = c.p; (void)p;
  const int lane = TIDX & 63, wid = TIDX >> 6;
  f32x4 g[4];
#pragma unroll
  for (int i = 0; i < 4; ++i) g[i] = *(const f32x4*)(p.norm_final + i * 256 + lane * 4);
  for (int u = blockIdx.x; u < NTOK / 8; u += gridDim.x) {
    float* xr = p.out + (size_t)(u * 8 + wid * 2) * 1024;
    f32x4 v[2][4];
#pragma unroll
    for (int r = 0; r < 2; ++r)
#pragma unroll
      for (int i = 0; i < 4; ++i) v[r][i] = *(const f32x4*)(xr + r * 1024 + i * 256 + lane * 4);
#pragma unroll
    for (int r = 0; r < 2; ++r) {
      float ss = 0.f;
#pragma unroll
      for (int i = 0; i < 4; ++i) ss += v[r][i][0] * v[r][i][0] + v[r][i][1] * v[r][i][1] + v[r][i][2] * v[r][i][2] + v[r][i][3] * v[r][i][3];
      ss = wave_sum(ss);
      const float rs = rsqrtf(ss * (1.0f / 1024.0f) + 1e-5f);
#pragma unroll
      for (int i = 0; i < 4; ++i) *(f32x4*)(xr + r * 1024 + i * 256 + lane * 4) = v[r][i] * rs * g[i];
    }
  }
}

constexpr int NPHASE = 20;
#ifdef NO_RW
#define RWK(x)
#else
#define RWK(x) x
#endif
#ifdef NO_MB
#define MBK(x)
#else
#define MBK(x) x
#endif
#ifndef ONLY_PHASE
#define ONLY_PHASE -1
#endif
#define PH(k) case k: if (ONLY_PHASE >= 0 && ONLY_PHASE != k) break;
template <int ph> DI void run_phase(const Ctx& c, char* smem) {
  const Params& p = c.p; (void)p;
  char* ws = p.ws;
  bf16_t* XN = (bf16_t*)(ws + OFF_XN);
  switch (ph) {
    PH(0) phase_prep(c, smem); break;
    PH(1) gemm_phase(smem, XN, 1024, 1 << 30, XN, 1024, (const bf16_t*)(ws + OFF_WABIN), 1024, 35,
                       EpiSplit{(bf16_t*)(ws + OFF_R1), 1792, 1792, (bf16_t*)(ws + OFF_R2), 2592, 2592}, TIDX); break;
    PH(2) phase_rw_shift(c); break;
    PH(3) phase_rw_small_gemms(c, smem); break;
    PH(4) {
      const int G = gridDim.x, bx = blockIdx.x;
      if (G >= 512) { if (bx < 256) { __builtin_amdgcn_s_setprio(3); RWK(rwkv_item(c, bx, smem);) __builtin_amdgcn_s_setprio(0); }
        else for (int u = bx - 256; u < 512; u += G - 256) { MBK(mamba_item(c, u, smem);) } }
      else { for (int u = bx; u < 256; u += G) { RWK(rwkv_item(c, u, smem);) } __syncthreads(); for (int u = bx + ((256 - bx + G - 1) / G) * G; u < 768; u += G) { MBK(mamba_item(c, u - 256, smem);) } }
    } break;
    PH(5) phase_post0(c); break;
    PH(6) gemm_phase(smem, (const bf16_t*)(ws + OFF_R1), 512, 512, (const bf16_t*)(ws + OFF_R2), 2592, (const bf16_t*)(ws + OFF_WABOUT), 1536, 8, EpiResid{p.x, p.out}, TIDX); break;
    PH(7) phase_rmsnorm(c, p.out, p.norm_mlp); break;
    PH(8) gemm_phase(smem, XN, 1024, 1 << 30, XN, 1024, (const bf16_t*)(ws + OFF_W1), 1024, 32, EpiRelu2{(bf16_t*)(ws + OFF_R1)}, TIDX); break;
    PH(9) gemm_phase(smem, (const bf16_t*)(ws + OFF_R1), 4096, 1 << 30, XN, 1024, (const bf16_t*)(ws + OFF_W2), 4096, 8, EpiResid{p.out, p.out}, TIDX); break;
    PH(10) phase_rmsnorm(c, p.out, p.norm_mix + 1024); break;
    PH(11) gemm_phase(smem, XN, 1024, 1 << 30, XN, 1024, (const bf16_t*)(ws + OFF_WCDIN), 1024, 21,
                        EpiSplit{(bf16_t*)(ws + OFF_S5U), 512, 512, (bf16_t*)(ws + OFF_MLRAW), 2080, 2080}, TIDX); break;
    PH(12) {
      const int G = gridDim.x, bx = blockIdx.x;
      if (G >= 512) { if (bx >= 256) __builtin_amdgcn_s_setprio(2);
        if (bx >= 256 && bx < 512) s5_item(c, bx - 256, smem); __syncthreads(); for (int u = bx; u < 512; u += G) mlstm_item(c, u, smem); __builtin_amdgcn_s_setprio(0); }
      else { for (int u = bx; u < 512; u += G) mlstm_item(c, u, smem);
        __syncthreads();
        { int u0 = bx + ((512 - bx + G - 1) / G) * G; for (int u = u0; u < 768; u += G) s5_item(c, u - 512, smem); } }
    } break;
    PH(13) phase_post1(c); break;
    PH(14) gemm_phase(smem, (const bf16_t*)(ws + OFF_YG), 512, 1 << 30, XN, 1024, (const bf16_t*)(ws + OFF_WGLU), 512, 4,
                        EpiGlu{(const bf16_t*)(ws + OFF_YG), p.s5_glu_b, (bf16_t*)(ws + OFF_S5Y)}, TIDX); break;
    PH(15) gemm_phase(smem, (const bf16_t*)(ws + OFF_S5Y), 512, 512, (const bf16_t*)(ws + OFF_MLRAW) + 1024, 2080, (const bf16_t*)(ws + OFF_WCDOUT), 1536, 8, EpiResid{p.out, p.out}, TIDX); break;
    PH(16) phase_rmsnorm(c, p.out, p.norm_mlp + 1024); break;
    PH(17) gemm_phase(smem, XN, 1024, 1 << 30, XN, 1024, (const bf16_t*)(ws + OFF_W1) + 4096ull * 1024, 1024, 32, EpiRelu2{(bf16_t*)(ws + OFF_R1)}, TIDX); break;
    PH(18) gemm_phase(smem, (const bf16_t*)(ws + OFF_R1), 4096, 1 << 30, XN, 1024, (const bf16_t*)(ws + OFF_W2) + 4096ull * 1024, 4096, 8, EpiResid{p.out, p.out}, TIDX); break;
    PH(19) phase_final(c); break;
    default: break;
  }
}

DI void grid_barrier(const Ctx& c, unsigned idx) {
  const Params& p = c.p; (void)p;
  asm volatile("s_waitcnt vmcnt(0)" ::: "memory");
  __syncthreads();
  if (TIDX == 0) {
    unsigned* bar = (unsigned*)(p.ws + OFF_BAR);
    const unsigned G = gridDim.x, grp = blockIdx.x & 7u;
    const unsigned gsz = (G >> 3) + ((grp < (G & 7u)) ? 1u : 0u);
    const unsigned ngrp = G < 8u ? G : 8u;
    __builtin_amdgcn_fence(__ATOMIC_RELEASE, "agent");
    asm volatile("s_waitcnt vmcnt(0)" ::: "memory");
    const unsigned old = __hip_atomic_fetch_add(bar + 64 * (1 + grp), 1u, __ATOMIC_RELAXED, __HIP_MEMORY_SCOPE_AGENT);
    if (old + 1u == idx * gsz) {
      __builtin_amdgcn_fence(__ATOMIC_ACQ_REL, "agent");
      asm volatile("s_waitcnt vmcnt(0)" ::: "memory");
      const unsigned og = __hip_atomic_fetch_add(bar, 1u, __ATOMIC_RELAXED, __HIP_MEMORY_SCOPE_AGENT);
      if (og + 1u == idx * ngrp) {
        for (unsigned g_ = 0; g_ < ngrp; ++g_) __hip_atomic_store(bar + 64 * (9 + g_), idx, __ATOMIC_RELAXED, __HIP_MEMORY_SCOPE_AGENT);
      }
    }
    while (__hip_atomic_load(bar + 64 * (9 + grp), __ATOMIC_RELAXED, __HIP_MEMORY_SCOPE_AGENT) < idx) __builtin_amdgcn_s_sleep(1);
    __builtin_amdgcn_fence(__ATOMIC_ACQUIRE, "agent");
    asm volatile("s_waitcnt vmcnt(0)" ::: "memory");
  }
  __syncthreads();
}

template <int PHI> DI void run_from(const Ctx& c, char* smem, int ph0, int ph1) {
  const Params& p = c.p; (void)p;
  if constexpr (PHI < NPHASE) {
    if (ph0 <= PHI && PHI < ph1) {
      run_phase<PHI>(c, smem);
      if (PHI + 1 < ph1) {
        if constexpr (PHI == 0) { __syncthreads(); cg::this_grid().sync(); }
        else grid_barrier(c, (unsigned)PHI);
      }
    }
    run_from<PHI + 1>(c, smem, ph0, ph1);
  }
}

__global__ void __launch_bounds__(256, 2) mega(Params p, int ph0, int ph1) {
  extern __shared__ __attribute__((aligned(16))) char smem[];
  const Ctx c{p, __builtin_amdgcn_readfirstlane((int)(__builtin_amdgcn_workitem_id_x() >> 6))};
  run_from<0>(c, smem, ph0, ph1);
}

#ifndef ONE_LAUNCH
#define ONE_LAUNCH 1
#endif

extern "C" void kernel_launch(void* const* d_in, const int* in_sizes, int n_in, void* d_out, int out_size, void* d_ws, size_t ws_size,
                              hipStream_t stream) {
  static int grid_blocks = 0;
  if (!grid_blocks) {
    hipFuncSetAttribute((const void*)mega, hipFuncAttributeMaxDynamicSharedMemorySize, LDS_BYTES);
    int dev = 0, cus = 0, per_cu = 0;
    hipGetDevice(&dev);
    hipDeviceGetAttribute(&cus, hipDeviceAttributeMultiprocessorCount, dev);
    hipOccupancyMaxActiveBlocksPerMultiprocessor(&per_cu, mega, 256, LDS_BYTES);
    if (per_cu > 2) per_cu = 2;
    if (per_cu < 1) per_cu = 1;
    grid_blocks = cus * per_cu;
  }
  Params p{};
  const float** pf = (const float**)&p;
  for (int i = 0; i < 45; ++i) pf[i] = (const float*)d_in[i];
  p.out = (float*)d_out;
  p.ws = (char*)d_ws;
#if ONE_LAUNCH
  int ph0 = 0, ph1 = NPHASE;
  void* args[] = {&p, &ph0, &ph1};
  hipError_t e = hipLaunchCooperativeKernel((const void*)mega, dim3(grid_blocks), dim3(256), args, LDS_BYTES, stream);
  if (e != hipSuccess) fprintf(stderr, "cooperative launch failed: %s (grid %d)\n", hipGetErrorString(e), grid_blocks);
#else
  for (int ph = 0; ph < NPHASE; ++ph) hipLaunchKernelGGL(mega, dim3(grid_blocks), dim3(256), LDS_BYTES, stream, p, ph, ph + 1);
#endif
}
```
